# Optimizing an MI355X kernel written in HIP

```python
import math
import jax, jax.numpy as jnp
from jax import lax
import numpy as np

D_MODEL = 1024
BATCH = 2
SEQ = 8192
DEPTH = 2

N_MIXERS = 2
RMS_EPS = 1e-6
NEG_INF = -1e30
A_HEADS = 16
A_KV_HEADS = 4
A_HEAD_DIM = D_MODEL // A_HEADS
A_WINDOW = 128
A_BLOCK = 128
A_IN = (A_HEADS + 2 * A_KV_HEADS) * A_HEAD_DIM
B_HEADS = 8
B_HEAD_DIM = D_MODEL // B_HEADS
B_CONV = 4
B_CHUNK = 64
B_IN = 4 * D_MODEL + 4 * B_HEADS
N_GROUPS = 4
EXPERTS_PER_GROUP = 8
N_EXPERTS = N_GROUPS * EXPERTS_PER_GROUP
TOP_K = 2
D_EXPERT = D_MODEL // 4

kernel_name = "hybrid_swa_gdn_hmoe_encoder"


def rmsnorm(x, g):
    xf = x.astype(jnp.float32)
    y = xf * lax.rsqrt(jnp.mean(xf * xf, axis=-1, keepdims=True) + RMS_EPS) * g.astype(jnp.float32)
    return y.astype(x.dtype)


def l2norm(x):
    return x * lax.rsqrt(jnp.sum(x * x, axis=-1, keepdims=True) + RMS_EPS)


def alibi_slopes(n_heads):
    return np.array([2.0 ** (-8.0 * (h + 1) / n_heads) for h in range(n_heads)], np.float32)


def windowed_attention(h, w_in, q_gain, k_gain, sink, w_out):
    B, S, _ = h.shape
    H, G, dh, BLK = A_HEADS, A_KV_HEADS, A_HEAD_DIM, A_BLOCK
    R = H // G
    nb = S // BLK
    proj = h @ w_in
    q, k, v = jnp.split(proj, [H * dh, (H + G) * dh], axis=-1)
    q = rmsnorm(q.reshape(B, S, H, dh), q_gain)
    k = rmsnorm(k.reshape(B, S, G, dh), k_gain)
    v = v.reshape(B, S, G, dh)
    qb = q.reshape(B, nb, BLK, G, R, dh)
    pad = ((0, 0), (BLK, BLK), (0, 0), (0, 0))
    kp = jnp.pad(k, pad).reshape(B, nb + 2, BLK, G, dh)
    vp = jnp.pad(v, pad).reshape(B, nb + 2, BLK, G, dh)
    kw = jnp.concatenate([kp[:, :-2], kp[:, 1:-1], kp[:, 2:]], axis=2)
    vw = jnp.concatenate([vp[:, :-2], vp[:, 1:-1], vp[:, 2:]], axis=2)
    scores = jnp.einsum('bnqgrd,bnkgd->bngrqk', qb, kw,
                        preferred_element_type=jnp.float32) * (dh ** -0.5)
    qi = np.arange(BLK)
    kj = np.arange(3 * BLK)
    dist = np.abs(BLK + qi[:, None] - kj[None, :]).astype(np.float32)
    s_abs = (np.arange(nb)[:, None] - 1) * BLK + kj[None, :]
    mask = (dist <= A_WINDOW)[None] & ((s_abs >= 0) & (s_abs < S))[:, None, :]
    slopes = alibi_slopes(H).reshape(G, R)
    alibi = -slopes[:, :, None, None] * dist[None, None]
    scores = jnp.where(mask[None, :, None, None], scores + alibi[None, None], NEG_INF)
    sink_b = sink.astype(jnp.float32).reshape(1, 1, G, R, 1, 1)
    m = jnp.maximum(jnp.max(scores, axis=-1, keepdims=True), sink_b)
    p = jnp.exp(scores - m)
    attn = p / (jnp.sum(p, axis=-1, keepdims=True) + jnp.exp(sink_b - m))
    out = jnp.einsum('bngrqk,bnkgd->bnqgrd', attn.astype(vw.dtype), vw)
    return out.reshape(B, S, H * dh) @ w_out


def short_conv(u, w):
    K, C = w.shape
    return lax.conv_general_dilated(u, w[:, None, :].astype(u.dtype), window_strides=(1,),
                                    padding=[(K // 2, K - 1 - K // 2)],
                                    dimension_numbers=('NWC', 'WIO', 'NWC'),
                                    feature_group_count=C)


def gated_delta_chunked(q, k, v, g, beta):
    B, H, S, dk = q.shape
    dv = v.shape[-1]
    C = B_CHUNK
    nc = S // C
    q = q * (dk ** -0.5)
    q, k, v = (t.reshape(B, H, nc, C, t.shape[-1]) for t in (q, k, v))
    g = g.reshape(B, H, nc, C)
    beta = beta.reshape(B, H, nc, C)
    gc = jnp.cumsum(g, axis=-1)
    tril = jnp.tril(jnp.ones((C, C), bool))
    strict = jnp.tril(jnp.ones((C, C), bool), -1)
    diff = gc[..., :, None] - gc[..., None, :]
    decay = jnp.where(tril, jnp.exp(jnp.where(tril, diff, 0.0)), 0.0)
    kb = k * beta[..., None]
    L = jnp.where(strict, jnp.einsum('bhnid,bhnjd->bhnij', kb, k) * decay, 0.0)
    a_mat = L + jnp.eye(C, dtype=L.dtype)
    rhs = jnp.concatenate([v * beta[..., None], kb * jnp.exp(gc)[..., None]], axis=-1)
    sol = lax.linalg.triangular_solve(a_mat, rhs, left_side=True, lower=True, unit_diagonal=True)
    u, w = sol[..., :dv], sol[..., dv:]
    intra = jnp.where(tril, jnp.einsum('bhnid,bhnjd->bhnij', q, k) * decay, 0.0)
    q_dec = q * jnp.exp(gc)[..., None]
    k_dec = k * jnp.exp(gc[..., -1:] - gc)[..., None]
    chunk_decay = jnp.exp(gc[..., -1])

    def step(state, xs):
        q_i, k_i, u_i, w_i, a_i, d_i = xs
        v_new = u_i - jnp.einsum('bhck,bhkv->bhcv', w_i, state)
        o_i = jnp.einsum('bhck,bhkv->bhcv', q_i, state) + jnp.einsum('bhcs,bhsv->bhcv', a_i, v_new)
        state = state * d_i[..., None, None] + jnp.einsum('bhck,bhcv->bhkv', k_i, v_new)
        return state, o_i

    xs = tuple(jnp.moveaxis(t, 2, 0) for t in (q_dec, k_dec, u, w, intra, chunk_decay))
    state0 = jnp.zeros((B, H, dk, dv), jnp.float32)
    _, o = lax.scan(step, state0, xs)
    return jnp.moveaxis(o, 0, 2).reshape(B, H, S, dv)


def gated_deltanet(h, w_in, conv_w, a_log, dt_bias, o_gain, w_out):
    B, S, D = h.shape
    H, dk = B_HEADS, B_HEAD_DIM
    proj = h @ w_in
    qkv, z, a, b = jnp.split(proj, [3 * D, 4 * D, 4 * D + 2 * H], axis=-1)
    qkv = jax.nn.silu(short_conv(qkv, conv_w))
    q, k, v = jnp.split(qkv, 3, axis=-1)

    def heads(t):
        return t.reshape(B, S, H, dk).transpose(0, 2, 1, 3).astype(jnp.float32)

    q, k, v = l2norm(heads(q)), l2norm(heads(k)), heads(v)
    a = a.astype(jnp.float32).reshape(B, S, 2, H).transpose(2, 0, 3, 1)
    b = b.astype(jnp.float32).reshape(B, S, 2, H).transpose(2, 0, 3, 1)
    A = jnp.exp(a_log.astype(jnp.float32))[:, None, :, None]
    g = -A * jax.nn.softplus(a + dt_bias.astype(jnp.float32)[:, None, :, None])
    beta = jax.nn.sigmoid(b)
    o_fwd = gated_delta_chunked(q, k, v, g[0], beta[0])

    def flip(t):
        return jnp.flip(t, axis=2)

    o_bwd = flip(gated_delta_chunked(flip(q), flip(k), flip(v), flip(g[1]), flip(beta[1])))
    o = (o_fwd + o_bwd).transpose(0, 2, 1, 3)
    o = rmsnorm(o, o_gain) * jax.nn.silu(z.reshape(B, S, H, dk).astype(jnp.float32))
    return o.reshape(B, S, D).astype(h.dtype) @ w_out


def hierarchical_moe(h, w_group, b_group, w_expert, b_expert, w_gate, w_up, w_down):
    B, S, D = h.shape
    t = h.reshape(B * S, D)
    g_logits = (t @ w_group).astype(jnp.float32) + b_group.astype(jnp.float32)
    g_prob, g_idx = lax.top_k(jax.nn.softmax(g_logits, axis=-1), 1)
    e_logits = ((t @ w_expert).astype(jnp.float32) + b_expert.astype(jnp.float32)
                ).reshape(-1, N_GROUPS, EXPERTS_PER_GROUP)
    e_sel = jnp.take_along_axis(e_logits, g_idx[:, :, None], axis=1)[:, 0]
    e_prob, e_idx = lax.top_k(jax.nn.softmax(e_sel, axis=-1), TOP_K)
    gate = g_prob * e_prob / jnp.sum(e_prob, axis=-1, keepdims=True)
    expert_id = g_idx * EXPERTS_PER_GROUP + e_idx
    combine = jnp.sum(jax.nn.one_hot(expert_id, N_EXPERTS, dtype=jnp.float32) * gate[..., None], axis=1)
    hid = jax.nn.silu(jnp.einsum('td,edf->tef', t, w_gate)) * jnp.einsum('td,edf->tef', t, w_up)
    hid = hid * combine[..., None].astype(hid.dtype)
    return jnp.einsum('tef,efd->td', hid, w_down).reshape(B, S, D)


def setup_inputs(seed: int = 0) -> dict:
    key = jax.random.key(seed)
    ks = jax.random.split(key, 24)
    n_a = (DEPTH + 1) // 2
    n_b = DEPTH // 2
    f32 = jnp.float32

    def nrm(k, shape, fan_in):
        return jax.random.normal(k, shape, f32) * fan_in ** -0.5

    def gain(k, shape):
        return 1.0 + 0.02 * jax.random.normal(k, shape, f32)

    dt = jnp.exp(jax.random.uniform(ks[12], (n_b, 2, B_HEADS), f32, math.log(1e-3), math.log(1e-1)))
    return {
        "x": jax.random.normal(ks[0], (BATCH, SEQ, D_MODEL), f32),
        "norm_mix": gain(ks[1], (DEPTH, D_MODEL)),
        "norm_ffn": gain(ks[2], (DEPTH, D_MODEL)),
        "attn_w_in": nrm(ks[3], (n_a, D_MODEL, A_IN), D_MODEL),
        "attn_q_gain": gain(ks[4], (n_a, A_HEAD_DIM)),
        "attn_k_gain": gain(ks[5], (n_a, A_HEAD_DIM)),
        "attn_sink": 0.5 * jax.random.normal(ks[6], (n_a, A_HEADS), f32),
        "attn_w_out": nrm(ks[7], (n_a, A_HEADS * A_HEAD_DIM, D_MODEL), A_HEADS * A_HEAD_DIM),
        "gdn_w_in": nrm(ks[8], (n_b, D_MODEL, B_IN), D_MODEL),
        "gdn_conv": nrm(ks[9], (n_b, B_CONV, 3 * D_MODEL), B_CONV),
        "gdn_a_log": jnp.log(jax.random.uniform(ks[10], (n_b, 2, B_HEADS), f32, 1.0, 16.0)),
        "gdn_dt_bias": dt + jnp.log(-jnp.expm1(-dt)),
        "gdn_o_gain": gain(ks[11], (n_b, B_HEAD_DIM)),
        "gdn_w_out": nrm(ks[13], (n_b, D_MODEL, D_MODEL), D_MODEL),
        "moe_w_group": nrm(ks[14], (DEPTH, D_MODEL, N_GROUPS), D_MODEL),
        "moe_b_group": 0.01 * jax.random.normal(ks[15], (DEPTH, N_GROUPS), f32),
        "moe_w_expert": nrm(ks[16], (DEPTH, D_MODEL, N_EXPERTS), D_MODEL),
        "moe_b_expert": 0.01 * jax.random.normal(ks[17], (DEPTH, N_EXPERTS), f32),
        "moe_w_gate": nrm(ks[18], (DEPTH, N_EXPERTS, D_MODEL, D_EXPERT), D_MODEL),
        "moe_w_up": nrm(ks[19], (DEPTH, N_EXPERTS, D_MODEL, D_EXPERT), D_MODEL),
        "moe_w_down": nrm(ks[20], (DEPTH, N_EXPERTS, D_EXPERT, D_MODEL), D_EXPERT),
    }


def reference(x, norm_mix, norm_ffn, attn_w_in, attn_q_gain, attn_k_gain, attn_sink, attn_w_out,
              gdn_w_in, gdn_conv, gdn_a_log, gdn_dt_bias, gdn_o_gain, gdn_w_out,
              moe_w_group, moe_b_group, moe_w_expert, moe_b_expert, moe_w_gate, moe_w_up, moe_w_down):
    for i in range(DEPTH):
        h = rmsnorm(x, norm_mix[i])
        j = i // N_MIXERS
        if i % N_MIXERS == 0:
            x = x + windowed_attention(h, attn_w_in[j], attn_q_gain[j], attn_k_gain[j],
                                       attn_sink[j], attn_w_out[j])
        else:
            x = x + gated_deltanet(h, gdn_w_in[j], gdn_conv[j], gdn_a_log[j], gdn_dt_bias[j],
                                   gdn_o_gain[j], gdn_w_out[j])
        h = rmsnorm(x, norm_ffn[i])
        x = x + hierarchical_moe(h, moe_w_group[i], moe_b_group[i], moe_w_expert[i], moe_b_expert[i],
                                 moe_w_gate[i], moe_w_up[i], moe_w_down[i])
    return x
```

```cpp
#include <hip/hip_runtime.h>
#include <cstdio>
#include <cstdint>

namespace {
constexpr int BATCH = 2, SEQ = 8192, DM = 1024, T = BATCH * SEQ;
constexpr int A_HEADS = 16, A_KV = 4, A_DH = 64, A_IN = 1536, A_WIN = 128;
constexpr int B_HEADS = 8, B_DK = 128, B_IN = 4128;
constexpr int NGRP = 4, EPG = 8, NEXP = 32, DEXP = 256;
constexpr float EPS = 1e-6f;

__device__ __forceinline__ float wave_sum(float v) {
#pragma unroll
    for (int o = 1; o < 64; o <<= 1) v += __shfl_xor(v, o);
    return v;
}
__device__ __forceinline__ float wave_max(float v) {
#pragma unroll
    for (int o = 1; o < 64; o <<= 1) v = fmaxf(v, __shfl_xor(v, o));
    return v;
}
__device__ __forceinline__ float silu_f(float x) { return x / (1.f + __expf(-x)); }

__global__ void k_rmsnorm(const float* __restrict__ x, const float* __restrict__ g, float* __restrict__ y, int rows) {
    const int row = blockIdx.x * 4 + (threadIdx.x >> 6), lane = threadIdx.x & 63;
    if (row >= rows) return;
    const float4* xr = (const float4*)(x + (size_t)row * DM);
    float4 v[4]; float s = 0.f;
#pragma unroll
    for (int j = 0; j < 4; ++j) { v[j] = xr[lane + 64 * j]; s += v[j].x * v[j].x + v[j].y * v[j].y + v[j].z * v[j].z + v[j].w * v[j].w; }
    s = wave_sum(s);
    const float rs = rsqrtf(s * (1.f / DM) + EPS);
    float4* yr = (float4*)(y + (size_t)row * DM);
#pragma unroll
    for (int j = 0; j < 4; ++j) { const float4 gg = ((const float4*)g)[lane + 64 * j]; float4 o; o.x = v[j].x * rs * gg.x; o.y = v[j].y * rs * gg.y; o.z = v[j].z * rs * gg.z; o.w = v[j].w * rs * gg.w; yr[lane + 64 * j] = o; }
}

__global__ void k_gemm(const float* __restrict__ A, const float* __restrict__ Bm, const float* R, float* C, int M, int N, int K, int ldb, int c0, int ldc) {
    __shared__ float As[16][65];
    __shared__ float Bs[16][64];
    const int tid = threadIdx.x, tx = tid & 15, ty = tid >> 4;
    const int m0 = blockIdx.y * 64, n0 = blockIdx.x * 64;
    float acc[4][4];
#pragma unroll
    for (int i = 0; i < 4; ++i)
#pragma unroll
        for (int j = 0; j < 4; ++j) acc[i][j] = 0.f;
    for (int k0 = 0; k0 < K; k0 += 16) {
#pragma unroll
        for (int i = 0; i < 4; ++i) { const int idx = tid + i * 256, m = idx >> 4, k = idx & 15; As[k][m] = A[(size_t)(m0 + m) * K + k0 + k]; }
#pragma unroll
        for (int i = 0; i < 4; ++i) { const int idx = tid + i * 256, k = idx >> 6, n = idx & 63; Bs[k][n] = (n0 + n < N) ? Bm[(size_t)(k0 + k) * ldb + c0 + n0 + n] : 0.f; }
        __syncthreads();
#pragma unroll
        for (int k = 0; k < 16; ++k) {
            float a[4], b[4];
#pragma unroll
            for (int i = 0; i < 4; ++i) a[i] = As[k][ty * 4 + i];
#pragma unroll
            for (int j = 0; j < 4; ++j) b[j] = Bs[k][tx * 4 + j];
#pragma unroll
            for (int i = 0; i < 4; ++i)
#pragma unroll
                for (int j = 0; j < 4; ++j) acc[i][j] += a[i] * b[j];
        }
        __syncthreads();
    }
#pragma unroll
    for (int i = 0; i < 4; ++i)
#pragma unroll
        for (int j = 0; j < 4; ++j) {
            const int m = m0 + ty * 4 + i, n = n0 + tx * 4 + j;
            if (n < N) { const size_t o = (size_t)m * ldc + n; C[o] = acc[i][j] + (R ? R[o] : 0.f); }
        }
}

__global__ void k_attn(const float* __restrict__ proj, const float* __restrict__ qg, const float* __restrict__ kg, const float* __restrict__ sink, float* __restrict__ out) {
    __shared__ float qs[64];
    __shared__ float ps[320];
    const int t = blockIdx.x >> 4, h = blockIdx.x & 15, lane = threadIdx.x;
    const int b = t / SEQ, tt = t % SEQ, g = h >> 2;
    const float slope = exp2f(-8.0f * (float)(h + 1) / (float)A_HEADS);
    const float qv = proj[(size_t)t * A_IN + h * 64 + lane];
    const float qss = wave_sum(qv * qv);
    qs[lane] = qv * rsqrtf(qss * (1.f / 64.f) + EPS) * qg[lane] * kg[lane];
    __syncthreads();
    float sc[5]; bool valid[5]; float mx = -INFINITY;
#pragma unroll
    for (int i = 0; i < 5; ++i) {
        const int j = lane + 64 * i, s = tt - A_WIN + j;
        valid[i] = (j <= 2 * A_WIN) && s >= 0 && s < SEQ;
        sc[i] = -INFINITY;
        if (valid[i]) {
            const float4* kp = (const float4*)(proj + (size_t)(b * SEQ + s) * A_IN + 1024 + g * 64);
            float kss = 0.f, dot = 0.f;
            for (int d = 0; d < 16; ++d) { const float4 kv = kp[d]; kss += kv.x * kv.x + kv.y * kv.y + kv.z * kv.z + kv.w * kv.w;
                dot += qs[4 * d] * kv.x + qs[4 * d + 1] * kv.y + qs[4 * d + 2] * kv.z + qs[4 * d + 3] * kv.w; }
            const float kn = rsqrtf(kss * (1.f / 64.f) + EPS);
            const int dist = tt > s ? tt - s : s - tt;
            sc[i] = dot * kn * 0.125f - slope * (float)dist;
            mx = fmaxf(mx, sc[i]);
        }
    }
    const float sk = sink[h];
    const float m = fmaxf(wave_max(mx), sk);
    float psum = 0.f;
#pragma unroll
    for (int i = 0; i < 5; ++i) { const float p = valid[i] ? __expf(sc[i] - m) : 0.f; ps[i * 64 + lane] = p; psum += p; }
    const float denom = wave_sum(psum) + __expf(sk - m);
    __syncthreads();
    float acc = 0.f;
    for (int j = 0; j <= 2 * A_WIN; ++j) {
        const int s = tt - A_WIN + j;
        if (s >= 0 && s < SEQ) acc += ps[j] * proj[(size_t)(b * SEQ + s) * A_IN + 1280 + g * 64 + lane];
    }
    out[(size_t)t * DM + h * 64 + lane] = acc / denom;
}

__global__ void k_moe(float* x, const float* __restrict__ gffn, const float* __restrict__ wgrp, const float* __restrict__ bgrp, const float* __restrict__ wexp, const float* __restrict__ bexp,
                      const float* __restrict__ Wg, const float* __restrict__ Wu, const float* __restrict__ Wd) {
    __shared__ float hs[DM];
    __shared__ float red[4];
    __shared__ float logit[36];
    __shared__ float hid[DEXP];
    __shared__ int eid[2];
    __shared__ float gate[2];
    const int t = blockIdx.x, tid = threadIdx.x, lane = tid & 63, w = tid >> 6;
    float4 xv = ((const float4*)(x + (size_t)t * DM))[tid];
    float s = wave_sum(xv.x * xv.x + xv.y * xv.y + xv.z * xv.z + xv.w * xv.w);
    if (lane == 0) red[w] = s;
    __syncthreads();
    const float rs = rsqrtf((red[0] + red[1] + red[2] + red[3]) * (1.f / DM) + EPS);
    { const float4 gg = ((const float4*)gffn)[tid]; hs[tid * 4 + 0] = xv.x * rs * gg.x; hs[tid * 4 + 1] = xv.y * rs * gg.y; hs[tid * 4 + 2] = xv.z * rs * gg.z; hs[tid * 4 + 3] = xv.w * rs * gg.w; }
    __syncthreads();
    for (int c = w; c < 36; c += 4) {
        float p = 0.f;
        for (int k = lane; k < DM; k += 64) p += hs[k] * (c < 4 ? wgrp[k * NGRP + c] : wexp[k * NEXP + (c - 4)]);
        p = wave_sum(p);
        if (lane == 0) logit[c] = p + (c < 4 ? bgrp[c] : bexp[c - 4]);
    }
    __syncthreads();
    if (tid == 0) {
        int gi = 0; float gm = logit[0];
        for (int i = 1; i < NGRP; ++i) if (logit[i] > gm) { gm = logit[i]; gi = i; }
        float gs = 0.f; for (int i = 0; i < NGRP; ++i) gs += __expf(logit[i] - gm);
        const float gprob = 1.f / gs;
        const float* el = logit + 4 + gi * EPG;
        int e1 = 0; float m1 = el[0];
        for (int i = 1; i < EPG; ++i) if (el[i] > m1) { m1 = el[i]; e1 = i; }
        int e2 = -1; float m2 = -INFINITY;
        for (int i = 0; i < EPG; ++i) if (i != e1 && el[i] > m2) { m2 = el[i]; e2 = i; }
        const float p1 = 1.f, p2 = __expf(m2 - m1);
        eid[0] = gi * EPG + e1; eid[1] = gi * EPG + e2;
        gate[0] = gprob * p1 / (p1 + p2); gate[1] = gprob * p2 / (p1 + p2);
    }
    __syncthreads();
    float acc[4] = {0.f, 0.f, 0.f, 0.f};
    for (int sidx = 0; sidx < 2; ++sidx) {
        const int e = eid[sidx]; const float gt = gate[sidx];
        const float* wg = Wg + (size_t)e * DM * DEXP; const float* wu = Wu + (size_t)e * DM * DEXP; const float* wd = Wd + (size_t)e * DEXP * DM;
        float sg = 0.f, su = 0.f;
        for (int k = 0; k < DM; ++k) { const float hv = hs[k]; sg += hv * wg[(size_t)k * DEXP + tid]; su += hv * wu[(size_t)k * DEXP + tid]; }
        __syncthreads();
        hid[tid] = silu_f(sg) * su * gt;
        __syncthreads();
        for (int f = 0; f < DEXP; ++f) { const float hv = hid[f];
#pragma unroll
            for (int j = 0; j < 4; ++j) acc[j] += hv * wd[(size_t)f * DM + tid + 256 * j]; }
    }
    float* xr = x + (size_t)t * DM;
#pragma unroll
    for (int j = 0; j < 4; ++j) xr[tid + 256 * j] += acc[j];
}

__global__ void k_gbeta(const float* __restrict__ zab, const float* __restrict__ a_log, const float* __restrict__ dt_bias, float* __restrict__ gb) {
    const int idx = blockIdx.x * blockDim.x + threadIdx.x;
    if (idx >= SEQ * 16) return;
    const int t = idx >> 4, c = idx & 15;
    const float a = zab[(size_t)t * 1056 + 1024 + c], bb = zab[(size_t)t * 1056 + 1040 + c];
    const float xx = a + dt_bias[c];
    const float sp = fmaxf(xx, 0.f) + log1pf(__expf(-fabsf(xx)));
    gb[(size_t)t * 32 + c] = -__expf(a_log[c]) * sp;
    gb[(size_t)t * 32 + 16 + c] = 1.f / (1.f + __expf(-bb));
}

__global__ void __launch_bounds__(128) k_scan(const float* __restrict__ pre, const float* __restrict__ convw, const float* __restrict__ gb, float* __restrict__ o) {
    constexpr int TS = 16;
    __shared__ float qs[TS][128];
    __shared__ float ks[TS][128];
    __shared__ float vs[TS][128];
    __shared__ float red[2][TS][2];
    const int h = blockIdx.x & 7, dir = blockIdx.x >> 3, j = threadIdx.x, lane = j & 63, w = j >> 6;
    float St[128];
#pragma unroll
    for (int i = 0; i < 128; ++i) St[i] = 0.f;
    float cw[3][4];
#pragma unroll
    for (int wh = 0; wh < 3; ++wh)
#pragma unroll
        for (int jj = 0; jj < 4; ++jj) cw[wh][jj] = convw[jj * 3072 + wh * 1024 + h * 128 + j];
    float* od = o + (size_t)dir * SEQ * DM;
    for (int tile = 0; tile < SEQ / TS; ++tile) {
        __syncthreads();
        for (int st = 0; st < TS; ++st) {
            const int n = tile * TS + st, t = dir ? SEQ - 1 - n : n;
            float v3[3];
#pragma unroll
            for (int wh = 0; wh < 3; ++wh) {
                float a = 0.f;
#pragma unroll
                for (int jj = 0; jj < 4; ++jj) { const int tt = t + jj - 2; if (tt >= 0 && tt < SEQ) a += cw[wh][jj] * pre[(size_t)tt * 3072 + wh * 1024 + h * 128 + j]; }
                v3[wh] = silu_f(a);
            }
            const float sq = wave_sum(v3[0] * v3[0]), sk = wave_sum(v3[1] * v3[1]);
            if (lane == 0) { red[0][st][w] = sq; red[1][st][w] = sk; }
            qs[st][j] = v3[0]; ks[st][j] = v3[1]; vs[st][j] = v3[2];
        }
        __syncthreads();
        for (int st = 0; st < TS; ++st) {
            const float qn = rsqrtf(red[0][st][0] + red[0][st][1] + EPS) * 0.08838834764831845f;
            const float kn = rsqrtf(red[1][st][0] + red[1][st][1] + EPS);
            const int n = tile * TS + st, t = dir ? SEQ - 1 - n : n;
            const float gg = gb[(size_t)t * 32 + dir * 8 + h], beta = gb[(size_t)t * 32 + 16 + dir * 8 + h];
            const float dec = __expf(gg);
            float kS = 0.f;
#pragma unroll
            for (int i = 0; i < 128; ++i) kS += ks[st][i] * St[i];
            kS *= kn * dec;
            const float vn = beta * (vs[st][j] - kS) * kn;
            float ov = 0.f;
#pragma unroll
            for (int i = 0; i < 128; ++i) { St[i] = dec * St[i] + ks[st][i] * vn; ov += qs[st][i] * St[i]; }
            od[(size_t)t * DM + h * 128 + j] = ov * qn;
        }
    }
}

__global__ void k_gdn_gate(float* of, const float* __restrict__ ob, const float* __restrict__ zab, const float* __restrict__ ogain) {
    const int idx = blockIdx.x * 4 + (threadIdx.x >> 6), lane = threadIdx.x & 63;
    const int t = idx >> 3, h = idx & 7;
    float* p = of + (size_t)t * DM + h * 128; const float* q = ob + (size_t)t * DM + h * 128;
    const float a0 = p[lane] + q[lane], a1 = p[lane + 64] + q[lane + 64];
    const float ss = wave_sum(a0 * a0 + a1 * a1);
    const float rs = rsqrtf(ss * (1.f / 128.f) + EPS);
    const float z0 = zab[(size_t)t * 1056 + h * 128 + lane], z1 = zab[(size_t)t * 1056 + h * 128 + lane + 64];
    p[lane] = a0 * rs * ogain[lane] * silu_f(z0);
    p[lane + 64] = a1 * rs * ogain[lane + 64] * silu_f(z1);
}
}

extern "C" void kernel_launch(void* const* d_in, const int* in_sizes, int n_in, void* d_out, int out_size, void* d_ws, size_t ws_size, hipStream_t stream) {
    const float* x = (const float*)d_in[0];
    const float* norm_mix = (const float*)d_in[1];
    const float* norm_ffn = (const float*)d_in[2];
    const float* attn_w_in = (const float*)d_in[3];
    const float* attn_qg = (const float*)d_in[4];
    const float* attn_kg = (const float*)d_in[5];
    const float* attn_sink = (const float*)d_in[6];
    const float* attn_w_out = (const float*)d_in[7];
    const float* gdn_w_in = (const float*)d_in[8];
    const float* gdn_conv = (const float*)d_in[9];
    const float* gdn_a_log = (const float*)d_in[10];
    const float* gdn_dt_bias = (const float*)d_in[11];
    const float* gdn_o_gain = (const float*)d_in[12];
    const float* gdn_w_out = (const float*)d_in[13];
    const float* moe_wg = (const float*)d_in[14];
    const float* moe_bg = (const float*)d_in[15];
    const float* moe_we = (const float*)d_in[16];
    const float* moe_be = (const float*)d_in[17];
    const float* moe_gate = (const float*)d_in[18];
    const float* moe_up = (const float*)d_in[19];
    const float* moe_down = (const float*)d_in[20];
    float* X = (float*)d_out;
    float* ws = (float*)d_ws;
    const size_t MiBf = (1u << 20) / 4;
    float* XN = ws;
    float* PROJ = ws + 64 * MiBf;
    float* AUX = ws + 160 * MiBf;
    float* ZAB = ws + 224 * MiBf;
    float* GB = ws + 258 * MiBf;
    const size_t need = (size_t)260 << 20;
    if (ws_size < need) { fprintf(stderr, "kernel_launch: workspace too small (%zu < %zu)\n", ws_size, need); return; }

    k_rmsnorm<<<T / 4, 256, 0, stream>>>(x, norm_mix, XN, T);
    k_gemm<<<dim3(A_IN / 64, T / 64), 256, 0, stream>>>(XN, attn_w_in, nullptr, PROJ, T, A_IN, DM, A_IN, 0, A_IN);
    k_attn<<<T * 16, 64, 0, stream>>>(PROJ, attn_qg, attn_kg, attn_sink, AUX);
    k_gemm<<<dim3(DM / 64, T / 64), 256, 0, stream>>>(AUX, attn_w_out, x, X, T, DM, DM, DM, 0, DM);
    k_moe<<<T, 256, 0, stream>>>(X, norm_ffn, moe_wg, moe_bg, moe_we, moe_be, moe_gate, moe_up, moe_down);
    k_rmsnorm<<<T / 4, 256, 0, stream>>>(X, norm_mix + DM, XN, T);
    for (int b = 0; b < BATCH; ++b) {
        const float* xn_b = XN + (size_t)b * SEQ * DM;
        k_gemm<<<dim3(3072 / 64, SEQ / 64), 256, 0, stream>>>(xn_b, gdn_w_in, nullptr, PROJ, SEQ, 3072, DM, B_IN, 0, 3072);
        k_gemm<<<dim3((1056 + 63) / 64, SEQ / 64), 256, 0, stream>>>(xn_b, gdn_w_in, nullptr, ZAB, SEQ, 1056, DM, B_IN, 3072, 1056);
        k_gbeta<<<SEQ * 16 / 256, 256, 0, stream>>>(ZAB, gdn_a_log, gdn_dt_bias, GB);
        k_scan<<<16, 128, 0, stream>>>(PROJ, gdn_conv, GB, AUX);
        k_gdn_gate<<<SEQ * 8 / 4, 256, 0, stream>>>(AUX, AUX + (size_t)SEQ * DM, ZAB, gdn_o_gain);
        float* xb = X + (size_t)b * SEQ * DM;
        k_gemm<<<dim3(DM / 64, SEQ / 64), 256, 0, stream>>>(AUX, gdn_w_out, xb, xb, SEQ, DM, DM, DM, 0, DM);
    }
    k_moe<<<T, 256, 0, stream>>>(X, norm_ffn + DM, moe_wg + DM * NGRP, moe_bg + NGRP, moe_we + DM * NEXP, moe_be + NEXP,
                                 moe_gate + (size_t)NEXP * DM * DEXP, moe_up + (size_t)NEXP * DM * DEXP, moe_down + (size_t)NEXP * DEXP * DM);
}
```

```cpp
#include <hip/hip_runtime.h>
#include <cstdio>
#include <cstdint>
namespace pg8 {
#define PG8_LAS __attribute__((address_space(3)))
typedef unsigned short bf16_t;
typedef short bf16x8 __attribute__((ext_vector_type(8)));
typedef float f32x4 __attribute__((ext_vector_type(4)));
typedef unsigned u32x4 __attribute__((ext_vector_type(4)));
constexpr int BM = 256, BK = 64, HALF = 128, HTB = HALF * BK * 2  , STAGE_BYTES = 8 * HTB, NXCD = 8, WGM = 8;

__host__ __device__ __forceinline__ int lds_byte(int r, int c) { const int st = (r >> 4) * 2 + (c >> 5), rr = r & 15, cc = c & 31, ob = rr * 64 + cc * 2; return st * 1024 + (ob ^ (((ob >> 9) & 1) << 5)); }
__host__ __device__ __forceinline__ void stage_rc(int b, int& R, int& C) { const int st = b / 1024, sb = b % 1024, swz = sb ^ (((sb >> 9) & 1) << 5); R = (st >> 1) * 16 + swz / 64; C = (st & 1) * 32 + (swz % 64) / 2; }
__host__ __device__ __forceinline__ int perm32(int rho) { const int n = rho >> 4, i = rho & 15; return 8 * (i >> 2) + 4 * n + (i & 3); }

struct Unit { int pm, pn; };
struct Gemm { const bf16_t* A; const bf16_t* Bt; int M, N, K; };

struct StaticOrder {
    int nM, nN, nwg, G, c;
    __host__ __device__ void init(int M, int N, int G_, int c_) { nM = M / BM; nN = N / BM; nwg = nM * nN; G = G_; c = c_; }
    __host__ __device__ bool next(int i, Unit& u) const {
        const long L = (long)i * G + c; if (L >= nwg) return false;
        int wgid = (int)L; { const int q = nwg / NXCD, r = nwg % NXCD, xcd = wgid % NXCD, off = wgid / NXCD; wgid = (xcd < r ? xcd * (q + 1) : r * (q + 1) + (xcd - r) * q) + off; }
        const int nig = WGM * nN, gid = wgid / nig, fm = gid * WGM, gsz = (nM - fm) < WGM ? (nM - fm) : WGM;
        u.pm = fm + ((wgid % nig) % gsz); u.pn = (wgid % nig) / gsz; return true;
    }
    __device__ __forceinline__ void a_ready(const Unit&) const {}
    __device__ __forceinline__ void done(const Unit&) const {}
};

__device__ __forceinline__ unsigned cvt_pk_bf16(float lo, float hi) { unsigned r; asm volatile("v_cvt_pk_bf16_f32 %0, %1, %2" : "=v"(r) : "v"(lo), "v"(hi)); return r; }
typedef unsigned u32x4 __attribute__((ext_vector_type(4)));
struct EpiQKV {
    static constexpr bool PERM = true, AFTER_DRAIN = false;
    bf16_t *Q, *K, *V; const float *qg, *kg; float qscale;
    __device__ __forceinline__ void operator()(const f32x4 (&acc)[2][2][4][2], const Unit& u, int wr, int wc, int fr, int fq) const {
        const int row0 = u.pm * BM + wr * 64 + fr;
        bf16_t* dst; int ld; const float* gain; float sc; bool norm;
        if (u.pn < 4) { dst = Q + (u.pn * 4 + wc) * 64; ld = 1024; gain = qg; sc = qscale; norm = true; }
        else if (u.pn == 4) { dst = K + wc * 64; ld = 256; gain = kg; sc = 1.f; norm = true; }
        else { dst = V + wc * 64; ld = 256; gain = qg; sc = 1.f; norm = false; }
        f32x4 gv[2][2];
#pragma unroll
        for (int bj = 0; bj < 2; ++bj)
#pragma unroll
            for (int n = 0; n < 2; ++n) { const f32x4 g4 = *(const f32x4*)(gain + 32 * bj + 8 * fq + 4 * n); gv[bj][n] = norm ? g4 * sc : (f32x4){1.f, 1.f, 1.f, 1.f}; }
#pragma unroll
        for (int ai = 0; ai < 2; ++ai)
#pragma unroll
            for (int m = 0; m < 4; ++m) {
                float ss = 0.f;
#pragma unroll
                for (int bj = 0; bj < 2; ++bj)
#pragma unroll
                    for (int n = 0; n < 2; ++n) { const f32x4 x = acc[ai][bj][m][n]; ss += (x[0] * x[0] + x[1] * x[1]) + (x[2] * x[2] + x[3] * x[3]); }
                ss += __shfl_xor(ss, 16); ss += __shfl_xor(ss, 32);
                const float rs = norm ? rsqrtf(ss * (1.0f / 64.0f) + 1e-6f) : 1.f;
                bf16_t* rowp = dst + (size_t)(row0 + ai * HALF + m * 16) * ld + 8 * fq;
#pragma unroll
                for (int bj = 0; bj < 2; ++bj) { const f32x4 v0 = acc[ai][bj][m][0] * rs * gv[bj][0], v1 = acc[ai][bj][m][1] * rs * gv[bj][1];
                    u32x4 w; w.x = cvt_pk_bf16(v0[0], v0[1]); w.y = cvt_pk_bf16(v0[2], v0[3]); w.z = cvt_pk_bf16(v1[0], v1[1]); w.w = cvt_pk_bf16(v1[2], v1[3]);
                    *(u32x4*)(rowp + 32 * bj) = w; }
            }
    }
};
struct EpiResF32 {
    static constexpr bool PERM = false, AFTER_DRAIN = false;
    const float* base; float* out; int ldc;
    __device__ __forceinline__ void operator()(const f32x4 (&acc)[2][2][4][2], const Unit& u, int wr, int wc, int fr, int fq) const {
        const int row0 = u.pm * BM + wr * 64 + fr, col0 = u.pn * BM + wc * 32 + 4 * fq;
#pragma unroll
        for (int ai = 0; ai < 2; ++ai)
#pragma unroll
            for (int m = 0; m < 4; ++m) { const size_t off = (size_t)(row0 + ai * HALF + m * 16) * ldc + col0;
#pragma unroll
                for (int bj = 0; bj < 2; ++bj)
#pragma unroll
                    for (int n = 0; n < 2; ++n) { const size_t o = off + bj * HALF + n * 16; const f32x4 b = *(const f32x4*)(base + o); *(f32x4*)(out + o) = b + acc[ai][bj][m][n]; } }
    }
};

constexpr int MOE_CAP = 16384;
struct MoeOrder {
    const PG8_LAS int* tab; int npn, G, c; const int* list; unsigned rowbytes;
    __device__ __forceinline__ bool next(int i, Unit& u) const {
        const int L = i * G + c; if (L >= tab[65 + 32]) return false;
        int e = 0;
        for (int j = 1; j < 32; ++j) e = (L >= tab[65 + j]) ? j : e;
        const int local = L - tab[65 + e], mt = local / npn, pnl = local - mt * npn;
        u.pm = (tab[32 + e] >> 8) + mt; u.pn = e * npn + pnl; return true;
    }
    __device__ __forceinline__ unsigned rowoff(const Unit& u, int r) const {
        const int e = u.pn >> 1, idx = u.pm * 256 - tab[32 + e] + r;
        const int tok = idx < tab[e] ? list[e * MOE_CAP + idx] : 0;
        return (unsigned)tok * rowbytes;
    }
    __device__ __forceinline__ void a_ready(const Unit&) const {}
    __device__ __forceinline__ void done(const Unit&) const {}
};
struct EpiGateUp {
    static constexpr bool PERM = true, AFTER_DRAIN = false;
    bf16_t* H; const float* glist; const PG8_LAS int* tab;
    __device__ __forceinline__ void operator()(const f32x4 (&acc)[2][2][4][2], const Unit& u, int wr, int wc, int fr, int fq) const {
        const int e = u.pn >> 1, pnl = u.pn & 1, row0 = u.pm * BM + wr * 64 + fr, li0 = row0 - tab[32 + e], cnt = tab[e];
#pragma unroll
        for (int ai = 0; ai < 2; ++ai)
#pragma unroll
            for (int m = 0; m < 4; ++m) { const int li = li0 + ai * HALF + m * 16; const float gw = li < cnt ? glist[e * MOE_CAP + li] : 0.f;
                f32x4 h[2];
#pragma unroll
                for (int n = 0; n < 2; ++n)
#pragma unroll
                    for (int i = 0; i < 4; ++i) { const float g = acc[ai][0][m][n][i], uu = acc[ai][1][m][n][i]; h[n][i] = g * __builtin_amdgcn_rcpf(1.f + __expf(-g)) * uu * gw; }
                u32x4 w; w.x = cvt_pk_bf16(h[0][0], h[0][1]); w.y = cvt_pk_bf16(h[0][2], h[0][3]); w.z = cvt_pk_bf16(h[1][0], h[1][1]); w.w = cvt_pk_bf16(h[1][2], h[1][3]);
                *(u32x4*)(H + (size_t)(row0 + ai * HALF + m * 16) * 256 + 128 * pnl + 32 * wc + 8 * fq) = w; }
    }
};
struct EpiY {
    static constexpr bool PERM = true, AFTER_DRAIN = false;
    bf16_t* Y;
    __device__ __forceinline__ void operator()(const f32x4 (&acc)[2][2][4][2], const Unit& u, int wr, int wc, int fr, int fq) const {
        const int row0 = u.pm * BM + wr * 64 + fr, col0 = (u.pn & 3) * BM + wc * 32 + 8 * fq;
#pragma unroll
        for (int ai = 0; ai < 2; ++ai)
#pragma unroll
            for (int m = 0; m < 4; ++m) { bf16_t* rowp = Y + (size_t)(row0 + ai * HALF + m * 16) * 1024 + col0;
#pragma unroll
                for (int bj = 0; bj < 2; ++bj) { const f32x4 v0 = acc[ai][bj][m][0], v1 = acc[ai][bj][m][1];
                    u32x4 w; w.x = cvt_pk_bf16(v0[0], v0[1]); w.y = cvt_pk_bf16(v0[2], v0[3]); w.z = cvt_pk_bf16(v1[0], v1[1]); w.w = cvt_pk_bf16(v1[2], v1[3]);
                    *(u32x4*)(rowp + bj * HALF) = w; } }
    }
};

struct EpiGdnIn {
    static constexpr bool PERM = true, AFTER_DRAIN = false;
    bf16_t *QKV, *Z;
    __device__ __forceinline__ void operator()(const f32x4 (&acc)[2][2][4][2], const Unit& u, int wr, int wc, int fr, int fq) const {
        const int row0 = u.pm * BM + wr * 64 + fr;
        bf16_t* dst; int ld;
        if (u.pn < 12) { dst = QKV + u.pn * BM; ld = 3072; } else { dst = Z + (u.pn - 12) * BM; ld = 1024; }
        dst += wc * 32 + 8 * fq;
#pragma unroll
        for (int ai = 0; ai < 2; ++ai)
#pragma unroll
            for (int m = 0; m < 4; ++m) { bf16_t* rowp = dst + (size_t)(row0 + ai * HALF + m * 16) * ld;
#pragma unroll
                for (int bj = 0; bj < 2; ++bj) { const f32x4 v0 = acc[ai][bj][m][0], v1 = acc[ai][bj][m][1];
                    u32x4 w; w.x = cvt_pk_bf16(v0[0], v0[1]); w.y = cvt_pk_bf16(v0[2], v0[3]); w.z = cvt_pk_bf16(v1[0], v1[1]); w.w = cvt_pk_bf16(v1[2], v1[3]);
                    *(u32x4*)(rowp + bj * HALF) = w; } }
    }
};
template <class Epi, class Sched, bool ALIGN_EPI = false, bool SP2 = false, bool GATHER = false>
__device__ __forceinline__ void gemm_phase(PG8_LAS unsigned char* lds, const Gemm g, const Sched& S, const Epi& E, int tid_in) {
    int tid_ = tid_in; asm volatile("" : "+v"(tid_));
    const int tid = tid_, wid = __builtin_amdgcn_readfirstlane(tid >> 6), lane = tid & 63, wr = wid >> 2, wc = wid & 3, fr = lane & 15, fq = lane >> 4;
    int K_ = g.K; asm volatile("" : "+s"(K_));
    const int K = K_, nt = K / BK;
    unsigned voffA[2], voffB[2];
#pragma unroll
    for (int i = 0; i < 2; ++i) { int R, C; stage_rc(tid * 16 + i * 8192, R, C); const int Rb = Epi::PERM ? ((R & ~31) + perm32(R & 31)) : R;
        voffA[i] = (unsigned)(R * K + C) * 2u; voffB[i] = (unsigned)(Rb * K + C) * 2u; }
    const size_t kstep = (size_t)(BK * 2);
    const size_t hstep = (size_t)HALF * K * 2; const size_t hstepA = GATHER ? (size_t)0 : hstep;
    const size_t tstep = 2 * hstep;
    const unsigned ldsw = (unsigned)wid * 1024u;
    const int aoff = lds_byte(wr * 64 + fr, fq * 8), boff = lds_byte(wc * 32 + fr, fq * 8);
#define PG8_SA(b, h) (((b) * 2 + (h)) * HTB)
#define PG8_SB(b, h) ((4 + (b) * 2 + (h)) * HTB)
#define PG8_STAGE(bufoff, gbase, voff) do { _Pragma("unroll") for (int _i = 0; _i < 2; ++_i) \
        __builtin_amdgcn_global_load_lds((const unsigned*)((const char*)(gbase) + (voff)[_i]), (PG8_LAS unsigned*)(lds + (bufoff) + ldsw + _i * 8192), 16, 0, 0); } while (0)
#define PG8_LDA(dst, b, h) do { _Pragma("unroll") for (int m = 0; m < 4; ++m) _Pragma("unroll") for (int k = 0; k < 2; ++k) dst[m][k] = *(const PG8_LAS bf16x8*)(lds + PG8_SA(b, h) + aoff + m * 2048 + k * 1024); } while (0)
#define PG8_LDB(dst, b, h) do { _Pragma("unroll") for (int n = 0; n < 2; ++n) _Pragma("unroll") for (int k = 0; k < 2; ++k) dst[n][k] = *(const PG8_LAS bf16x8*)(lds + PG8_SB(b, h) + boff + n * 2048 + k * 1024); } while (0)
#define PG8_MMA(ai, bj, At, Bt) do { __builtin_amdgcn_s_setprio(1); _Pragma("unroll") for (int m = 0; m < 4; ++m) _Pragma("unroll") for (int n = 0; n < 2; ++n) _Pragma("unroll") for (int k = 0; k < 2; ++k) \
        acc[ai][bj][m][n] = __builtin_amdgcn_mfma_f32_16x16x32_bf16(Bt[n][k], At[m][k], acc[ai][bj][m][n], 0, 0, 0); __builtin_amdgcn_s_setprio(0); } while (0)
#define PG8_WAIT_V(n) asm volatile("s_waitcnt vmcnt(" #n ")" ::: "memory")
#define PG8_WAIT_L(n) asm volatile("s_waitcnt lgkmcnt(" #n ")" ::: "memory")
#define PG8_BAR __builtin_amdgcn_s_barrier()
#define PG8_SCHED __builtin_amdgcn_sched_barrier(0)
    Unit cur, nxt; int ui = 0;
    if (!S.next(0, cur)) return;
    f32x4 acc[2][2][4][2];
#pragma unroll
    for (int a = 0; a < 2; ++a)
#pragma unroll
        for (int b = 0; b < 2; ++b)
#pragma unroll
            for (int m = 0; m < 4; ++m)
#pragma unroll
                for (int n = 0; n < 2; ++n) acc[a][b][m][n] = (f32x4){0.f, 0.f, 0.f, 0.f};
    bf16x8 At[4][2], B0[2][2], B1[2][2];
    const char* cA = (const char*)g.A + (GATHER ? (size_t)0 : (size_t)cur.pm * tstep);
    unsigned vC[2][2];
    PG8_LAS unsigned* vNl = (PG8_LAS unsigned*)(lds + STAGE_BYTES + 2048) + tid;
#pragma unroll
    for (int h = 0; h < 2; ++h)
#pragma unroll
        for (int i = 0; i < 2; ++i) { if constexpr (GATHER) { int R, C; stage_rc(tid * 16 + i * 8192, R, C); vC[h][i] = S.rowoff(cur, 128 * h + R) + (unsigned)C * 2u; vNl[(h * 2 + i) * 512] = vC[h][i]; } else vC[h][i] = voffA[i]; }
    const char* cB = (const char*)g.Bt + (size_t)cur.pn * tstep;
    S.a_ready(cur);
    if constexpr (SP2) {
        PG8_STAGE(PG8_SB(0, 0), cB, voffB); PG8_STAGE(PG8_SB(0, 1), cB + hstep, voffB); PG8_STAGE(PG8_SA(0, 0), cA, vC[0]); PG8_STAGE(PG8_SA(0, 1), cA + hstepA, vC[1]);
        if (wr == 1) PG8_BAR;
        PG8_WAIT_V(2); PG8_BAR;
        PG8_STAGE(PG8_SB(1, 0), cB + kstep, voffB); PG8_STAGE(PG8_SA(1, 0), cA + kstep, vC[0]); PG8_STAGE(PG8_SB(1, 1), cB + hstep + kstep, voffB);
        PG8_WAIT_V(6); PG8_BAR;
    } else {
        PG8_STAGE(PG8_SB(0, 0), cB, voffB); PG8_STAGE(PG8_SA(0, 0), cA, vC[0]); PG8_STAGE(PG8_SB(0, 1), cB + hstep, voffB); PG8_STAGE(PG8_SA(0, 1), cA + hstepA, vC[1]);
        if (wr == 1) PG8_BAR;
        PG8_WAIT_V(4); PG8_BAR;
        PG8_STAGE(PG8_SB(1, 0), cB + kstep, voffB); PG8_STAGE(PG8_SA(1, 0), cA + kstep, vC[0]); PG8_STAGE(PG8_SB(1, 1), cB + hstep + kstep, voffB);
        PG8_WAIT_V(6); PG8_BAR;
    }
    for (;;) {
        const bool has_next = S.next(ui + 1, nxt);
        const char* nA = (has_next && !GATHER) ? (const char*)g.A + (size_t)nxt.pm * tstep : cA;
        if constexpr (GATHER) { if (has_next) {
#pragma unroll
            for (int h = 0; h < 2; ++h)
#pragma unroll
                for (int i = 0; i < 2; ++i) { int R, C; stage_rc(tid * 16 + i * 8192, R, C); vNl[(h * 2 + i) * 512] = S.rowoff(nxt, 128 * h + R) + (unsigned)C * 2u; } } }
        const char* nB = has_next ? (const char*)g.Bt + (size_t)nxt.pn * tstep : cB;
        for (int t = 0; t < nt; t += 2) {
            const bool last = (t == nt - 2);
            const char* a1 = cA + (size_t)(t + 1) * kstep;
            const char* a2 = last ? nA : cA + (size_t)(t + 2) * kstep; const char* b2 = last ? nB : cB + (size_t)(t + 2) * kstep;
            const char* a3 = a2 + kstep; const char* b3 = b2 + kstep;
            unsigned v2[2][2];
#pragma unroll
            for (int h = 0; h < 2; ++h)
#pragma unroll
                for (int i = 0; i < 2; ++i) { if constexpr (GATHER) { v2[h][i] = vC[h][i]; if (last) v2[h][i] = vNl[(h * 2 + i) * 512]; } else v2[h][i] = vC[h][i]; }
            if (last && has_next) S.a_ready(nxt);
            if constexpr (SP2) {
            PG8_LDB(B0, 0, 0); PG8_LDB(B1, 0, 1); PG8_SCHED; PG8_LDA(At, 0, 0); PG8_STAGE(PG8_SA(1, 1), a1 + hstepA, vC[1]);
            PG8_WAIT_V(8); PG8_WAIT_L(0); PG8_BAR; PG8_MMA(0, 0, At, B0); PG8_MMA(0, 1, At, B1); PG8_BAR; PG8_SCHED;
            PG8_LDA(At, 0, 1); PG8_STAGE(PG8_SB(0, 0), b2, voffB); PG8_STAGE(PG8_SB(0, 1), b2 + hstep, voffB); PG8_STAGE(PG8_SA(0, 0), a2, v2[0]);
            PG8_WAIT_V(8); PG8_WAIT_L(0); PG8_BAR; PG8_MMA(1, 0, At, B0); PG8_MMA(1, 1, At, B1); PG8_BAR; PG8_SCHED;
            PG8_LDB(B0, 1, 0); PG8_LDB(B1, 1, 1); PG8_SCHED; PG8_LDA(At, 1, 0); PG8_STAGE(PG8_SA(0, 1), a2 + hstepA, v2[1]);
            PG8_WAIT_V(8); PG8_WAIT_L(0); PG8_BAR; PG8_MMA(0, 0, At, B0); PG8_MMA(0, 1, At, B1); PG8_BAR; PG8_SCHED;
            PG8_LDA(At, 1, 1); PG8_STAGE(PG8_SB(1, 0), b3, voffB); PG8_STAGE(PG8_SB(1, 1), b3 + hstep, voffB); PG8_STAGE(PG8_SA(1, 0), a3, v2[0]);
            PG8_WAIT_V(8); PG8_WAIT_L(0); PG8_BAR; PG8_MMA(1, 0, At, B0); PG8_MMA(1, 1, At, B1); PG8_BAR; PG8_SCHED;
            } else {
            PG8_LDB(B0, 0, 0); PG8_SCHED; PG8_LDA(At, 0, 0); PG8_STAGE(PG8_SA(1, 1), a1 + hstepA, vC[1]);
            PG8_WAIT_L(8); PG8_BAR; PG8_WAIT_L(0); PG8_MMA(0, 0, At, B0); PG8_BAR; PG8_SCHED;
            PG8_LDB(B1, 0, 1); PG8_STAGE(PG8_SB(0, 0), b2, voffB);
            PG8_BAR; PG8_WAIT_L(0); PG8_MMA(0, 1, At, B1); PG8_BAR;
            PG8_LDA(At, 0, 1); PG8_STAGE(PG8_SA(0, 0), a2, v2[0]);
            PG8_BAR; PG8_WAIT_L(0); PG8_MMA(1, 0, At, B0); PG8_BAR; PG8_SCHED;
            PG8_STAGE(PG8_SB(0, 1), b2 + hstep, voffB);
            PG8_WAIT_V(6); PG8_BAR; PG8_MMA(1, 1, At, B1); PG8_BAR;
            PG8_LDB(B0, 1, 0); PG8_SCHED; PG8_LDA(At, 1, 0); PG8_STAGE(PG8_SA(0, 1), a2 + hstepA, v2[1]);
            PG8_WAIT_L(8); PG8_BAR; PG8_WAIT_L(0); PG8_MMA(0, 0, At, B0); PG8_BAR; PG8_SCHED;
            PG8_LDB(B1, 1, 1); PG8_STAGE(PG8_SB(1, 0), b3, voffB);
            PG8_BAR; PG8_WAIT_L(0); PG8_MMA(0, 1, At, B1); PG8_BAR;
            PG8_LDA(At, 1, 1); PG8_STAGE(PG8_SA(1, 0), a3, v2[0]);
            PG8_BAR; PG8_WAIT_L(0); PG8_MMA(1, 0, At, B0); PG8_BAR; PG8_SCHED;
            PG8_STAGE(PG8_SB(1, 1), b3 + hstep, voffB);
            PG8_WAIT_V(6); PG8_BAR; PG8_MMA(1, 1, At, B1); PG8_BAR;
            }
        }
        if constexpr (ALIGN_EPI) { if (wr == 0) PG8_BAR; }
        if constexpr (!Epi::AFTER_DRAIN) { E(acc, cur, wr, wc, fr, fq); S.done(cur); }
        if (!has_next) break;
#pragma unroll
        for (int a = 0; a < 2; ++a)
#pragma unroll
            for (int b = 0; b < 2; ++b)
#pragma unroll
                for (int m = 0; m < 4; ++m)
#pragma unroll
                    for (int n = 0; n < 2; ++n) acc[a][b][m][n] = (f32x4){0.f, 0.f, 0.f, 0.f};
        cur = nxt; cA = nA; cB = nB; ++ui;
#pragma unroll
        for (int h = 0; h < 2; ++h)
#pragma unroll
            for (int i = 0; i < 2; ++i) { if constexpr (GATHER) vC[h][i] = vNl[(h * 2 + i) * 512]; }
        if constexpr (ALIGN_EPI) { if (wr == 1) PG8_BAR; }
    }
    PG8_WAIT_V(0);
    if constexpr (!ALIGN_EPI) { if (wr == 0) PG8_BAR; }
    PG8_BAR;
    if constexpr (Epi::AFTER_DRAIN) { E.fused(acc, cur, wr, wc, fr, fq, lds, wid, lane); S.done(cur); }
#undef PG8_SA
#undef PG8_SB
#undef PG8_STAGE
#undef PG8_LDA
#undef PG8_LDB
#undef PG8_MMA
#undef PG8_WAIT_V
#undef PG8_WAIT_L
#undef PG8_BAR
#undef PG8_SCHED
}
}
#define GAS __attribute__((address_space(1)))
#define LAS __attribute__((address_space(3)))
typedef unsigned short bf16;
typedef unsigned v4u __attribute__((ext_vector_type(4)));
typedef float f32x4 __attribute__((ext_vector_type(4)));
typedef short bf16x8 __attribute__((ext_vector_type(8)));
typedef GAS unsigned gu32;
typedef GAS unsigned long long gu64;
#define RLX_AGENT __ATOMIC_RELAXED, __HIP_MEMORY_SCOPE_AGENT
#define LDS_WAIT() asm volatile("s_waitcnt lgkmcnt(0)" ::: "memory")
#define VM_WAIT() asm volatile("s_waitcnt vmcnt(0)" ::: "memory")
__device__ __forceinline__ unsigned long long rt() { return __builtin_amdgcn_s_memrealtime(); }
__device__ __forceinline__ unsigned f2bf(float f) { unsigned u = __builtin_bit_cast(unsigned, f); return (u + 0x7fffu + ((u >> 16) & 1u)) >> 16; }
__device__ __forceinline__ unsigned pk2(float lo, float hi) { return f2bf(lo) | (f2bf(hi) << 16); }

#define XB_TMO      128
#define XB_XCNT(j)  (256  + 64 * (j))
#define XB_XSUB(j)  (1280 + 64 * (j))
#define XB_XGEN(j)  (2304 + 64 * (j))
#define XB_TOP      3328
#define XB_TOPGEN   3392
#define XCD_BAR_WORDS 3456
#define XB_SPIN_CAP (1u << 18)

__device__ __forceinline__ unsigned xb_ld(unsigned* p)              { return __hip_atomic_load(p, __ATOMIC_RELAXED, __HIP_MEMORY_SCOPE_AGENT); }
__device__ __forceinline__ unsigned xb_add(unsigned* p, unsigned v) { return __hip_atomic_fetch_add(p, v, __ATOMIC_RELAXED, __HIP_MEMORY_SCOPE_AGENT); }
__device__ __forceinline__ unsigned xb_xcc_id() { return (unsigned)__builtin_amdgcn_s_getreg((3 << 11) | 20) & 0xFu; }
#define XB_SPIN(cond, bar) do { unsigned _sp = 0; while (cond) { __builtin_amdgcn_s_sleep(1); \
    if ((++_sp & 255u) == 0u) { if (xb_ld(&(bar)[XB_TMO])) break; if (_sp > XB_SPIN_CAP) { atomicAdd(&(bar)[XB_TMO], 1u); break; } } } } while (0)

struct XcdBarrier {
    unsigned* bar; unsigned x;
    volatile LAS unsigned* st;
};

__device__ __forceinline__ XcdBarrier xcd_barrier_post(unsigned* bar, volatile LAS unsigned* st) {
    XcdBarrier b; b.bar = bar; b.x = xb_xcc_id(); b.st = st;
    if (threadIdx.x == 0) (void)xb_add(&bar[XB_XCNT(b.x)], 1u);
    return b;
}
__device__ __forceinline__ void xcd_barrier_complete(unsigned* bar, unsigned x, unsigned& nloc, unsigned& nx) {
    const unsigned G = gridDim.x * gridDim.y * gridDim.z;
    unsigned sum, cnt, mine, sp = 0u;
    for (;;) {
        sum = 0u; cnt = 0u; mine = 0u;
#pragma unroll
        for (unsigned j = 0; j < 16; ++j) { const unsigned c = xb_ld(&bar[XB_XCNT(j)]); sum += c; cnt += (c > 0u) ? 1u : 0u; mine = (j == x) ? c : mine; }
        if (sum == G) break;
        __builtin_amdgcn_s_sleep(1);
        if ((++sp & 255u) == 0u) { if (xb_ld(&bar[XB_TMO])) break; if (sp > XB_SPIN_CAP) { atomicAdd(&bar[XB_TMO], 1u); break; } }
    }
    nloc = mine > 0u ? mine : 1u; nx = cnt > 0u ? cnt : 1u;
}

__device__ __forceinline__ void xcd_barrier(const XcdBarrier& b, bool is_t0) {
    asm volatile("s_waitcnt vmcnt(0)" ::: "memory");
    __syncthreads();
    if (is_t0) {
        unsigned* bar = b.bar;
        __builtin_amdgcn_s_waitcnt(0);
        unsigned nloc = b.st[0], nx = b.st[1];
        if (nloc == 0u) { xcd_barrier_complete(bar, b.x, nloc, nx); b.st[0] = nloc; b.st[1] = nx; }
        const unsigned old = xb_add(&bar[XB_XSUB(b.x)], 1u);
        const unsigned gen = old / nloc;
        if (old + 1u == (gen + 1u) * nloc) {
            __builtin_amdgcn_fence(__ATOMIC_RELEASE, "agent");
            asm volatile("s_waitcnt vmcnt(0)" ::: "memory");
            const unsigned og = xb_add(&bar[XB_TOP], 1u);
            const unsigned tg = og / nx;
            if (og + 1u == (tg + 1u) * nx) xb_add(&bar[XB_TOPGEN], 1u);
            else XB_SPIN(xb_ld(&bar[XB_TOPGEN]) == tg, bar);
            __builtin_amdgcn_fence(__ATOMIC_ACQUIRE, "agent");
            xb_add(&bar[XB_XGEN(b.x)], 1u);
            asm volatile("s_waitcnt vmcnt(0)" ::: "memory");
        } else {
            XB_SPIN(xb_ld(&bar[XB_XGEN(b.x)]) == gen, bar);
            __builtin_amdgcn_fence(__ATOMIC_ACQUIRE, "agent");
            asm volatile("s_waitcnt vmcnt(0)" ::: "memory");
        }
    }
    __syncthreads();
}
constexpr int NWAVES = 8, NTHR = NWAVES * 64;
constexpr int MB = 2, MSEQ = 8192, MD = 1024, MT = MB * MSEQ;
constexpr float LOG2E = 1.4426950408889634f;
constexpr float QSCALE = 0.125f * LOG2E;
constexpr size_t MiB = 1u << 20;
constexpr size_t WS_CTL = 0, CTL_ZERO_BYTES = 1 * MiB;
constexpr size_t WS_WQKV = 1 * MiB;
constexpr size_t WS_WAO = 4 * MiB;
constexpr size_t WS_WGIN = 6 * MiB;
constexpr size_t WS_WAB = 14 * MiB;
constexpr size_t WS_WGO = 15 * MiB;
constexpr size_t WS_WR = 17 * MiB;
constexpr size_t WS_WGU = 18 * MiB;
constexpr size_t WS_WD = 50 * MiB;
constexpr size_t WS_XN = 66 * MiB;
constexpr size_t WS_LIST = 98 * MiB;
constexpr size_t WS_GLIST = 100 * MiB;
constexpr size_t WS_TOKSLOT = 102 * MiB;
constexpr size_t WS_H = 104 * MiB;
constexpr size_t WS_Y = 124 * MiB;
constexpr size_t WS_Q = 98 * MiB;
constexpr size_t WS_K = 130 * MiB;
constexpr size_t WS_V = 138 * MiB;
constexpr size_t WS_AO = 146 * MiB;
constexpr size_t WS_QKVPRE = 98 * MiB;
constexpr size_t WS_Z = 194 * MiB;
constexpr size_t WS_GB = 226 * MiB;
constexpr size_t WS_OF = 66 * MiB;
constexpr size_t WS_OB = 228 * MiB;
constexpr size_t WS_ON = 98 * MiB;
constexpr size_t WS_END = 260 * MiB;
constexpr int CW_TMO = 0, CW_CODE = 1, CW_BAR = 4096, CW_CNT = 16384;
constexpr int RING_OFF = 0, RING_BYTES = 131072, LDSCTL_OFF = RING_BYTES, MISC_OFF = LDSCTL_OFF + 320, MOETAB_OFF = LDSCTL_OFF + 1024, LDS_BYTES = 147456;

__device__ __forceinline__ float bf2f(unsigned short v) { return __uint_as_float((unsigned)v << 16); }
__device__ __forceinline__ float wsum(float v) {
#pragma unroll
    for (int o = 1; o < 64; o <<= 1) v += __shfl_xor(v, o);
    return v;
}
__device__ __forceinline__ float wmax(float v) {
#pragma unroll
    for (int o = 1; o < 64; o <<= 1) v = fmaxf(v, __shfl_xor(v, o));
    return v;
}
__device__ __forceinline__ float silu_f(float x) { return x * __builtin_amdgcn_rcpf(1.f + __expf(-x)); }
typedef unsigned u32x2_t __attribute__((ext_vector_type(2)));
__device__ __forceinline__ int opq(int x) { asm volatile("" : "+v"(x)); return x; }
__device__ __forceinline__ int lane_id() { return (int)__builtin_amdgcn_mbcnt_hi(~0u, __builtin_amdgcn_mbcnt_lo(~0u, 0u)); }
#define PHASE_IDS(F) const int wave = (F).wv, lane = opq(lane_id()), tid = wave * 64 + lane, gw = (F).gwb + wave; (void)tid; (void)lane; (void)wave; (void)gw

struct Ctx {
    LAS unsigned char* lds;
    volatile LAS unsigned* MISC;
    gu32* ctl;
    int G, gwb, NGW, wv;
    const float* in[21];
    float* out; unsigned char* ws;
};

template <class RowMap>
__device__ __forceinline__ void transpose_item(const float* W, int ldw, int K, bf16* WT, RowMap rm, LAS float* scr, int kb, int nb, int lane) {
    const int k0 = 64 * kb, n0 = 32 * nb;
#pragma unroll 8
    for (int i = 0; i < 32; ++i) { const int kk = 2 * i + (lane >> 5); scr[kk * 33 + (lane & 31)] = W[(size_t)(k0 + kk) * ldw + n0 + (lane & 31)]; }
    LDS_WAIT(); asm volatile("" ::: "memory");
    const int c = lane & 7;
#pragma unroll
    for (int j = 0; j < 4; ++j) { const int n = (lane >> 3) + 8 * j; const LAS float* s = scr + (8 * c) * 33 + n;
        v4u o; o.x = pk2(s[0 * 33], s[1 * 33]); o.y = pk2(s[2 * 33], s[3 * 33]); o.z = pk2(s[4 * 33], s[5 * 33]); o.w = pk2(s[6 * 33], s[7 * 33]);
        *(GAS v4u*)(WT + (size_t)rm(n0 + n) * K + k0 + 8 * c) = o; }
    LDS_WAIT(); asm volatile("" ::: "memory");
}
__device__ __forceinline__ void rms_row_to_bf16(const float* xrow, const float* g, bf16* orow, int lane) {
    const GAS f32x4* xr = (const GAS f32x4*)xrow + lane; const GAS f32x4* gr = (const GAS f32x4*)g + lane;
    f32x4 v[4]; float s = 0.f;
#pragma unroll
    for (int j = 0; j < 4; ++j) { v[j] = xr[64 * j]; s += (v[j].x * v[j].x + v[j].y * v[j].y) + (v[j].z * v[j].z + v[j].w * v[j].w); }
    const float rs = rsqrtf(wsum(s) * (1.f / MD) + 1e-6f);
    GAS unsigned long long* o8 = (GAS unsigned long long*)orow + lane;
#pragma unroll
    for (int j = 0; j < 4; ++j) { const f32x4 gg = gr[64 * j]; o8[64 * j] = (unsigned long long)pk2(v[j].x * rs * gg.x, v[j].y * rs * gg.y) | ((unsigned long long)pk2(v[j].z * rs * gg.z, v[j].w * rs * gg.w) << 32); }
}
__device__ __forceinline__ int qkv_rowmap(int c) { const int cl = c & 255; return (c & ~255) + ((cl >> 5) & 1) * 128 + (cl >> 6) * 32 + (cl & 31); }

__device__ __forceinline__ void moe_convert(Ctx& F, int layer, int widx, int wcnt) {
    PHASE_IDS(F);
    LAS float* scr = (LAS float*)(F.lds + RING_OFF + wave * 16384);
    const float* Wg = F.in[18] + (size_t)layer * 32 * MD * 256; const float* Wu = F.in[19] + (size_t)layer * 32 * MD * 256; const float* Wd = F.in[20] + (size_t)layer * 32 * 256 * MD;
    bf16* WGU = (bf16*)(F.ws + WS_WGU); bf16* WD = (bf16*)(F.ws + WS_WD);
    for (int it = widx; it < 32 * 384; it += wcnt) {
        const int e = it / 384, r = it % 384;
        if (r < 128) transpose_item(Wg + (size_t)e * MD * 256, 256, MD, WGU, [e](int f) { return e * 512 + ((f >> 7) << 8) + (f & 127); }, scr, r >> 3, r & 7, lane);
        else if (r < 256) transpose_item(Wu + (size_t)e * MD * 256, 256, MD, WGU, [e](int f) { return e * 512 + ((f >> 7) << 8) + 128 + (f & 127); }, scr, (r - 128) >> 3, (r - 128) & 7, lane);
        else transpose_item(Wd + (size_t)e * 256 * MD, MD, 256, WD, [e](int d) { return e * 1024 + d; }, scr, (r - 256) >> 5, (r - 256) & 31, lane);
    }
}
__device__ __forceinline__ void p0_prologue(Ctx& F) {
    PHASE_IDS(F);
    LAS float* scr = (LAS float*)(F.lds + RING_OFF + wave * 16384);
    constexpr int I_QKV = 16 * 48, I_AO = 16 * 32, I_GIN = 16 * 128, I_AB = 16, I_GO = 16 * 32;
    for (int it = gw; it < I_QKV + I_AO + I_GIN + I_AB + I_GO; it += F.NGW) {
        int r = it;
        if (r < I_QKV) { transpose_item(F.in[3], 1536, MD, (bf16*)(F.ws + WS_WQKV), [](int c) { return qkv_rowmap(c); }, scr, r / 48, r % 48, lane); continue; } r -= I_QKV;
        if (r < I_AO) { transpose_item(F.in[7], MD, MD, (bf16*)(F.ws + WS_WAO), [](int c) { return c; }, scr, r >> 5, r & 31, lane); continue; } r -= I_AO;
        if (r < I_GIN) { transpose_item(F.in[8], 4128, MD, (bf16*)(F.ws + WS_WGIN), [](int c) { return c; }, scr, r >> 7, r & 127, lane); continue; } r -= I_GIN;
        if (r < I_AB) { transpose_item(F.in[8], 4128, MD, (bf16*)(F.ws + WS_WAB), [](int c) { return c - 4096; }, scr, r, 128, lane); continue; } r -= I_AB;
        transpose_item(F.in[13], MD, MD, (bf16*)(F.ws + WS_WGO), [](int c) { return c; }, scr, r >> 5, r & 31, lane);
    }
    for (int layer = 0; layer < 2; ++layer) { bf16* wr = (bf16*)(F.ws + WS_WR + (size_t)layer * 131072); const float* wg = F.in[14] + (size_t)layer * MD * 4; const float* we = F.in[16] + (size_t)layer * MD * 32;
        for (int idx = gw * 64 + lane; idx < 48 * MD; idx += F.NGW * 64) { const int r = idx >> 10, k = idx & 1023;
            const float v = r < 4 ? wg[k * 4 + r] : (r < 36 ? we[k * 32 + (r - 4)] : 0.f); wr[idx] = (bf16)f2bf(v); } }
    moe_convert(F, 0, gw, F.NGW);
    for (int m = gw; m < MT; m += F.NGW) rms_row_to_bf16(F.in[0] + (size_t)m * MD, F.in[1], (bf16*)(F.ws + WS_XN) + (size_t)m * MD, lane);
}

__device__ __forceinline__ void attn_simple(Ctx& F) {
    PHASE_IDS(F);
    LAS float* qs = (LAS float*)(F.lds + RING_OFF + wave * 2048);
    LAS float* ps = qs + 64;
    const bf16* Q = (const bf16*)(F.ws + WS_Q); const bf16* K = (const bf16*)(F.ws + WS_K); const bf16* V = (const bf16*)(F.ws + WS_V); bf16* AO = (bf16*)(F.ws + WS_AO);
    const float* sink = F.in[6];
    for (int item = gw; item < MT * 16; item += F.NGW) {
        const int t = item >> 4, h = item & 15, b = t / MSEQ, tt = t % MSEQ, g = h >> 2;
        const float slope2 = exp2f(-8.0f * (float)(h + 1) / 16.0f) * LOG2E;
        qs[lane] = bf2f(Q[(size_t)t * 1024 + h * 64 + lane]);
        LDS_WAIT(); asm volatile("" ::: "memory");
        float sc[5]; bool valid[5]; float mx = -INFINITY;
#pragma unroll
        for (int i = 0; i < 5; ++i) {
            const int j = lane + 64 * i, s = tt - 128 + j;
            valid[i] = (j <= 256) && s >= 0 && s < MSEQ; sc[i] = -INFINITY;
            if (valid[i]) {
                const GAS v4u* kp = (const GAS v4u*)(K + (size_t)(b * MSEQ + s) * 256 + g * 64);
                float dot = 0.f;
#pragma unroll
                for (int d = 0; d < 8; ++d) { const v4u kv = kp[d];
                    dot += qs[8 * d + 0] * __uint_as_float(kv.x << 16) + qs[8 * d + 1] * __uint_as_float(kv.x & 0xffff0000u) + qs[8 * d + 2] * __uint_as_float(kv.y << 16) + qs[8 * d + 3] * __uint_as_float(kv.y & 0xffff0000u)
                         + qs[8 * d + 4] * __uint_as_float(kv.z << 16) + qs[8 * d + 5] * __uint_as_float(kv.z & 0xffff0000u) + qs[8 * d + 6] * __uint_as_float(kv.w << 16) + qs[8 * d + 7] * __uint_as_float(kv.w & 0xffff0000u); }
                const int dist = tt > s ? tt - s : s - tt;
                sc[i] = dot - slope2 * (float)dist; mx = fmaxf(mx, sc[i]);
            }
        }
        const float sk2 = sink[h] * LOG2E;
        const float m = fmaxf(wmax(mx), sk2);
        float psum = 0.f;
#pragma unroll
        for (int i = 0; i < 5; ++i) { const float p = valid[i] ? exp2f(sc[i] - m) : 0.f; ps[i * 64 + lane] = p; psum += p; }
        const float denom = wsum(psum) + exp2f(sk2 - m);
        LDS_WAIT(); asm volatile("" ::: "memory");
        float acc = 0.f;
        for (int j = 0; j <= 256; ++j) { const int s = tt - 128 + j; if (s >= 0 && s < MSEQ) acc += ps[j] * bf2f(V[(size_t)(b * MSEQ + s) * 256 + g * 64 + lane]); }
        AO[(size_t)t * 1024 + h * 64 + lane] = (bf16)f2bf(acc / denom);
        LDS_WAIT(); asm volatile("" ::: "memory");
    }
}

__device__ __forceinline__ void moe_tables(Ctx& F, int layer, int npn) {
    PHASE_IDS(F);
    LAS int* tab = (LAS int*)(F.lds + MOETAB_OFF);
    __syncthreads();
    if (tid < 32) tab[tid] = (int)__hip_atomic_load(F.ctl + CW_CNT + 64 * layer + tid, RLX_AGENT);
    __syncthreads();
    if (tid == 0) { int seg = 0, ub = 0; for (int e = 0; e < 32; ++e) { tab[32 + e] = seg; tab[65 + e] = ub; const int mt = (tab[e] + 255) >> 8; seg += mt << 8; ub += mt * npn; } tab[64] = seg; tab[97] = ub; }
    __syncthreads();
}
__device__ __forceinline__ void wg_self_visible(Ctx& F) {
    PHASE_IDS(F);
    VM_WAIT(); __syncthreads();
    if (tid == 0) { __builtin_amdgcn_fence(__ATOMIC_ACQUIRE, "agent"); VM_WAIT(); }
    __syncthreads();
}
__device__ __forceinline__ void p4_router(Ctx& F, int layer) {
    PHASE_IDS(F);
    const float* X = F.out; const float* g = F.in[2] + (size_t)layer * MD; bf16* XN = (bf16*)(F.ws + WS_XN);
    const bf16* Wr = (const bf16*)(F.ws + WS_WR + (size_t)layer * 131072);
    const float* bg = F.in[15] + layer * 4; const float* be = F.in[17] + layer * 32;
    gu32* cnt = F.ctl + CW_CNT + 64 * layer;
    int* list = (int*)(F.ws + WS_LIST); float* glist = (float*)(F.ws + WS_GLIST); int* tokslot = (int*)(F.ws + WS_TOKSLOT);
    LAS float* lg = (LAS float*)(F.lds + RING_OFF);
    const int w = wave, fr = lane & 15, fq = lane >> 4;
    for (int rb = blockIdx.x; rb < MT / 64; rb += F.G) {
        const int row0 = rb * 64;
        for (int r = 0; r < 8; ++r) { const size_t row = (size_t)(row0 + 8 * w + r); rms_row_to_bf16(X + row * MD, g, XN + row * MD, lane); }
        wg_self_visible(F);
        if (w < 4) {
            pg8::f32x4 acc[3] = {{0.f, 0.f, 0.f, 0.f}, {0.f, 0.f, 0.f, 0.f}, {0.f, 0.f, 0.f, 0.f}};
            const bf16* arow = XN + (size_t)(row0 + 16 * w + fr) * MD + 8 * fq; const bf16* brow = Wr + (size_t)fr * MD + 8 * fq;
#pragma unroll 4
            for (int ks = 0; ks < 32; ++ks) {
                const bf16x8 a = *(const GAS bf16x8*)(arow + 32 * ks);
#pragma unroll
                for (int nt = 0; nt < 3; ++nt) { const bf16x8 b = *(const GAS bf16x8*)(brow + (size_t)nt * 16 * MD + 32 * ks); acc[nt] = __builtin_amdgcn_mfma_f32_16x16x32_bf16(b, a, acc[nt], 0, 0, 0); }
            }
#pragma unroll
            for (int nt = 0; nt < 3; ++nt)
#pragma unroll
                for (int r = 0; r < 4; ++r) lg[(16 * w + fr) * 49 + 16 * nt + 4 * fq + r] = acc[nt][r];
        }
        __syncthreads();
        if (tid < 64) {
            const LAS float* l = lg + tid * 49; const int tok = row0 + tid;
            float gl[4]; for (int i = 0; i < 4; ++i) gl[i] = l[i] + bg[i];
            int gi = 0; float gm = gl[0];
            for (int i = 1; i < 4; ++i) if (gl[i] > gm) { gm = gl[i]; gi = i; }
            float gs = 0.f; for (int i = 0; i < 4; ++i) gs += __expf(gl[i] - gm);
            const float gprob = 1.f / gs;
            int e1 = 0, e2 = -1; float m1 = -INFINITY, m2 = -INFINITY;
            for (int i = 0; i < 8; ++i) { const float v = l[4 + gi * 8 + i] + be[gi * 8 + i]; if (v > m1) { m2 = m1; e2 = e1; m1 = v; e1 = i; } else if (v > m2) { m2 = v; e2 = i; } }
            const float p2 = __expf(m2 - m1), inv = 1.f / (1.f + p2);
            const int x1 = gi * 8 + e1, x2 = gi * 8 + e2;
            const unsigned pos1 = __hip_atomic_fetch_add(cnt + x1, 1u, RLX_AGENT), pos2 = __hip_atomic_fetch_add(cnt + x2, 1u, RLX_AGENT);
            list[x1 * 16384 + pos1] = tok; glist[x1 * 16384 + pos1] = gprob * inv;
            list[x2 * 16384 + pos2] = tok; glist[x2 * 16384 + pos2] = gprob * p2 * inv;
            tokslot[tok * 2] = (x1 << 16) | (int)pos1; tokslot[tok * 2 + 1] = (x2 << 16) | (int)pos2;
        }
        __syncthreads();
    }
}
template <bool NEXT>
__device__ __forceinline__ void p7_combine(Ctx& F) {
    PHASE_IDS(F);
    const LAS int* tab = (const LAS int*)(F.lds + MOETAB_OFF);
    const int* tokslot = (const int*)(F.ws + WS_TOKSLOT); const bf16* Y = (const bf16*)(F.ws + WS_Y); float* X = F.out;
    bf16* XN = (bf16*)(F.ws + WS_XN); const float* gn = F.in[1] + MD;
    const int w = wave, fr = lane & 15, fq = lane >> 4;
    for (int rb = blockIdx.x; rb < MT / 64; rb += F.G) {
        const int row0 = rb * 64;
        for (int r = 0; r < 8; ++r) {
            const int t = row0 + 8 * w + r;
            const int s0 = tokslot[t * 2], s1 = tokslot[t * 2 + 1];
            const size_t y0 = (size_t)(tab[32 + (s0 >> 16)] + (s0 & 0xffff)), y1 = (size_t)(tab[32 + (s1 >> 16)] + (s1 & 0xffff));
            GAS f32x4* xr = (GAS f32x4*)(X + (size_t)t * MD) + lane;
            const GAS u32x2_t* a = (const GAS u32x2_t*)(Y + y0 * MD) + lane; const GAS u32x2_t* b = (const GAS u32x2_t*)(Y + y1 * MD) + lane;
            f32x4 v[4]; float ss = 0.f;
#pragma unroll
            for (int j = 0; j < 4; ++j) { v[j] = xr[64 * j]; const u32x2_t p = a[64 * j], q = b[64 * j];
                v[j].x += __uint_as_float(p.x << 16) + __uint_as_float(q.x << 16); v[j].y += __uint_as_float(p.x & 0xffff0000u) + __uint_as_float(q.x & 0xffff0000u);
                v[j].z += __uint_as_float(p.y << 16) + __uint_as_float(q.y << 16); v[j].w += __uint_as_float(p.y & 0xffff0000u) + __uint_as_float(q.y & 0xffff0000u);
                xr[64 * j] = v[j]; ss += (v[j].x * v[j].x + v[j].y * v[j].y) + (v[j].z * v[j].z + v[j].w * v[j].w); }
            if constexpr (NEXT) {
                const float rs = rsqrtf(wsum(ss) * (1.f / MD) + 1e-6f);
                GAS unsigned long long* o8 = (GAS unsigned long long*)(XN + (size_t)t * MD) + lane; const GAS f32x4* gr = (const GAS f32x4*)gn + lane;
#pragma unroll
                for (int j = 0; j < 4; ++j) { const f32x4 gg = gr[64 * j]; o8[64 * j] = (unsigned long long)pk2(v[j].x * rs * gg.x, v[j].y * rs * gg.y) | ((unsigned long long)pk2(v[j].z * rs * gg.z, v[j].w * rs * gg.w) << 32); }
            }
        }
        if constexpr (NEXT) {
            wg_self_visible(F);
            if (w < 4) {
                const bf16* Wab = (const bf16*)(F.ws + WS_WAB); float* GB = (float*)(F.ws + WS_GB);
                pg8::f32x4 acc[2] = {{0.f, 0.f, 0.f, 0.f}, {0.f, 0.f, 0.f, 0.f}};
                const bf16* arow = XN + (size_t)(row0 + 16 * w + fr) * MD + 8 * fq; const bf16* brow = Wab + (size_t)fr * MD + 8 * fq;
#pragma unroll 4
                for (int ks = 0; ks < 32; ++ks) {
                    const bf16x8 a = *(const GAS bf16x8*)(arow + 32 * ks);
#pragma unroll
                    for (int nt = 0; nt < 2; ++nt) { const bf16x8 b = *(const GAS bf16x8*)(brow + (size_t)nt * 16 * MD + 32 * ks); acc[nt] = __builtin_amdgcn_mfma_f32_16x16x32_bf16(b, a, acc[nt], 0, 0, 0); }
                }
                const int tok = row0 + 16 * w + fr;
#pragma unroll
                for (int r = 0; r < 4; ++r) { const int c = 4 * fq + r;
                    const float xx = acc[0][r] + F.in[11][c]; const float sp = fmaxf(xx, 0.f) + log1pf(__expf(-fabsf(xx)));
                    GB[(size_t)tok * 32 + c] = -__expf(F.in[10][c]) * sp;
                    GB[(size_t)tok * 32 + 16 + c] = 1.f / (1.f + __expf(-acc[1][r])); }
            }
        }
    }
}

__device__ __forceinline__ void gdn_scan_naive(Ctx& F) {
    PHASE_IDS(F);
    constexpr int TS = 16;
    const int sq = blockIdx.x, b = sq >> 4, h = (sq >> 1) & 7, dir = sq & 1, w = wave;
    LAS float* qs = (LAS float*)(F.lds + RING_OFF);
    LAS float* red = qs + 3 * TS * 128;
    const bf16* pre = (const bf16*)(F.ws + WS_QKVPRE) + (size_t)b * MSEQ * 3072;
    const float* GB = (const float*)(F.ws + WS_GB) + (size_t)b * MSEQ * 32;
    bf16* od = (bf16*)(F.ws + (dir ? WS_OB : WS_OF)) + (size_t)b * MSEQ * MD;
    const float* convw = F.in[9];
    const int wh = tid >> 7, j = tid & 127;
    float cw[4] = {0.f, 0.f, 0.f, 0.f};
    if (tid < 384) {
#pragma unroll
        for (int jj = 0; jj < 4; ++jj) cw[jj] = convw[jj * 3072 + wh * 1024 + h * 128 + j]; }
    LAS float* kspart = red + 2 * TS;
    LAS float* opart = kspart + 2 * 4 * 128;
    const int part = tid >> 7, jc = tid & 127;
    float St[32];
#pragma unroll
    for (int i = 0; i < 32; ++i) St[i] = 0.f;
    for (int tile = 0; tile < MSEQ / TS; ++tile) {
        __syncthreads();
        if (tid < 384) {
            for (int st = 0; st < TS; ++st) {
                const int n = tile * TS + st, t = dir ? MSEQ - 1 - n : n;
                float a = 0.f;
#pragma unroll
                for (int jj = 0; jj < 4; ++jj) { const int tt = t + jj - 2; if (tt >= 0 && tt < MSEQ) a += cw[jj] * bf2f(pre[(size_t)tt * 3072 + wh * 1024 + h * 128 + j]); }
                qs[(wh * TS + st) * 128 + j] = silu_f(a);
            }
        }
        __syncthreads();
        for (int rr = w; rr < 2 * TS; rr += NWAVES) { const int which = rr & 1, st = rr >> 1; const float a0 = qs[(which * TS + st) * 128 + lane], a1 = qs[(which * TS + st) * 128 + lane + 64];
            const float ss = wsum(a0 * a0 + a1 * a1); if (lane == 0) red[which * TS + st] = ss; }
        __syncthreads();
        for (int st = 0; st < TS; ++st) {
            const float qn = rsqrtf(red[st] + 1e-6f) * 0.08838834764831845f, kn = rsqrtf(red[TS + st] + 1e-6f);
            const int n = tile * TS + st, t = dir ? MSEQ - 1 - n : n;
            const float gg = GB[(size_t)t * 32 + dir * 8 + h], beta = GB[(size_t)t * 32 + 16 + dir * 8 + h];
            const float dec = __expf(gg);
            const LAS float* kk = qs + (TS + st) * 128 + 32 * part; const LAS float* qq = qs + st * 128 + 32 * part;
            float ksp = 0.f;
#pragma unroll
            for (int i = 0; i < 32; ++i) ksp += kk[i] * St[i];
            kspart[((st & 1) * 4 + part) * 128 + jc] = ksp;
            __syncthreads();
            const LAS float* kp = kspart + (st & 1) * 4 * 128 + jc;
            const float kS = ((kp[0] + kp[128]) + (kp[256] + kp[384])) * kn * dec;
            const float vn = beta * (qs[(2 * TS + st) * 128 + jc] - kS) * kn;
            float ov = 0.f;
#pragma unroll
            for (int i = 0; i < 32; ++i) { St[i] = dec * St[i] + kk[i] * vn; ov += qq[i] * St[i]; }
            opart[(st * 4 + part) * 128 + jc] = ov * qn;
        }
        __syncthreads();
        for (int e = tid; e < TS * 128; e += NTHR) { const int st = e >> 7, c = e & 127; const LAS float* op = opart + st * 4 * 128 + c;
            const int n = tile * TS + st, t = dir ? MSEQ - 1 - n : n;
            od[(size_t)t * MD + h * 128 + c] = (bf16)f2bf((op[0] + op[128]) + (op[256] + op[384])); }
    }
}
__device__ __forceinline__ void gdn_gate(Ctx& F) {
    PHASE_IDS(F);
    const unsigned* of = (const unsigned*)(F.ws + WS_OF); const unsigned* ob = (const unsigned*)(F.ws + WS_OB); const unsigned* z = (const unsigned*)(F.ws + WS_Z);
    unsigned* on = (unsigned*)(F.ws + WS_ON); const float* og = F.in[12];
    const float g0 = og[2 * lane], g1 = og[2 * lane + 1];
    for (int it = gw; it < MT * 8; it += F.NGW) {
        const size_t idx = (size_t)it * 64 + lane;
        const unsigned a = of[idx], bb = ob[idx], zz = z[idx];
        const float o0 = __uint_as_float(a << 16) + __uint_as_float(bb << 16), o1 = __uint_as_float(a & 0xffff0000u) + __uint_as_float(bb & 0xffff0000u);
        const float rs = rsqrtf(wsum(o0 * o0 + o1 * o1) * (1.f / 128.f) + 1e-6f);
        on[idx] = pk2(o0 * rs * g0 * silu_f(__uint_as_float(zz << 16)), o1 * rs * g1 * silu_f(__uint_as_float(zz & 0xffff0000u)));
    }
}

struct Args { const float* in[21]; float* out; unsigned char* ws; int mask, li; };
__global__ void __launch_bounds__(NTHR, 2) mk_fwd(Args args) {
    extern __shared__ __attribute__((aligned(16))) unsigned char lds[];
    Ctx F;
    F.lds = (LAS unsigned char*)lds;
    F.MISC = (volatile LAS unsigned*)(F.lds + MISC_OFF);
    F.G = gridDim.x; { const int bx = blockIdx.x; const int vcu = (F.G % 8 == 0) ? (bx % 8) * (F.G / 8) + bx / 8 : bx; F.gwb = vcu * NWAVES; F.NGW = F.G * NWAVES; }
    F.wv = __builtin_amdgcn_readfirstlane((int)(threadIdx.x >> 6));
    F.ws = args.ws; F.out = args.out; F.ctl = (gu32*)(args.ws + WS_CTL);
#pragma unroll
    for (int i = 0; i < 21; ++i) F.in[i] = args.in[i];
    for (int u = threadIdx.x; u < (LDS_BYTES - LDSCTL_OFF) / 4; u += NTHR) ((LAS unsigned*)(F.lds + LDSCTL_OFF))[u] = 0u;
    __syncthreads();
    XcdBarrier bar = xcd_barrier_post((unsigned*)(F.ctl + CW_BAR) + args.li * XCD_BAR_WORDS, F.MISC + 8);
    const int mask = args.mask;
    const LAS int* tab = (const LAS int*)(F.lds + MOETAB_OFF);
#pragma unroll 1
    for (int ph = 0; ph < 16; ++ph) {
        if (!((mask >> ph) & 1)) continue;
        const int layer = ph >= 12 ? 1 : 0;
        int sel = ph >= 12 ? ph - 8 : (ph == 11 ? 3 : ph);
        asm volatile("" : "+s"(sel));
        switch (sel) {
        case 0: p0_prologue(F); break;
        case 1: {
            pg8::Gemm g{(const pg8::bf16_t*)(F.ws + WS_XN), (const pg8::bf16_t*)(F.ws + WS_WQKV), MT, 1536, MD}; pg8::StaticOrder S; S.init(MT, 1536, F.G, (int)blockIdx.x);
            pg8::EpiQKV E{(pg8::bf16_t*)(F.ws + WS_Q), (pg8::bf16_t*)(F.ws + WS_K), (pg8::bf16_t*)(F.ws + WS_V), F.in[4], F.in[5], QSCALE};
            pg8::gemm_phase<pg8::EpiQKV, pg8::StaticOrder, true, true>(F.lds + RING_OFF, g, S, E, F.wv * 64 + lane_id());
        } break;
        case 2: attn_simple(F); break;
        case 3: {
            pg8::Gemm g{(const pg8::bf16_t*)(F.ws + (ph == 3 ? WS_AO : WS_ON)), (const pg8::bf16_t*)(F.ws + (ph == 3 ? WS_WAO : WS_WGO)), MT, MD, MD}; pg8::StaticOrder S; S.init(MT, MD, F.G, (int)blockIdx.x);
            pg8::EpiResF32 E{ph == 3 ? F.in[0] : F.out, F.out, MD};
            pg8::gemm_phase<pg8::EpiResF32, pg8::StaticOrder, true, true>(F.lds + RING_OFF, g, S, E, F.wv * 64 + lane_id());
        } break;
        case 4: p4_router(F, layer); break;
        case 5: {
            moe_tables(F, layer, 2);
            pg8::Gemm g{(const pg8::bf16_t*)(F.ws + WS_XN), (const pg8::bf16_t*)(F.ws + WS_WGU), MT, 512, MD};
            pg8::MoeOrder S{tab, 2, F.G, (int)blockIdx.x, (const int*)(F.ws + WS_LIST), (unsigned)(MD * 2)};
            pg8::EpiGateUp E{(pg8::bf16_t*)(F.ws + WS_H), (const float*)(F.ws + WS_GLIST), tab};
            pg8::gemm_phase<pg8::EpiGateUp, pg8::MoeOrder, true, true, true>(F.lds + RING_OFF, g, S, E, F.wv * 64 + lane_id());
        } break;
        case 6: {
            moe_tables(F, layer, 4);
            pg8::Gemm g{(const pg8::bf16_t*)(F.ws + WS_H), (const pg8::bf16_t*)(F.ws + WS_WD), 40960, 1024, 256};
            pg8::MoeOrder S{tab, 4, F.G, (int)blockIdx.x, (const int*)(F.ws + WS_LIST), 512u};
            pg8::EpiY E{(pg8::bf16_t*)(F.ws + WS_Y)};
            pg8::gemm_phase<pg8::EpiY, pg8::MoeOrder, true, true, false>(F.lds + RING_OFF, g, S, E, F.wv * 64 + lane_id());
        } break;
        case 7: moe_tables(F, layer, 4); if (layer == 0) p7_combine<true>(F); else p7_combine<false>(F); break;
        case 8: {
            pg8::Gemm g{(const pg8::bf16_t*)(F.ws + WS_XN), (const pg8::bf16_t*)(F.ws + WS_WGIN), MT, 4096, MD}; pg8::StaticOrder S; S.init(MT, 4096, F.G, (int)blockIdx.x);
            pg8::EpiGdnIn E{(pg8::bf16_t*)(F.ws + WS_QKVPRE), (pg8::bf16_t*)(F.ws + WS_Z)};
            pg8::gemm_phase<pg8::EpiGdnIn, pg8::StaticOrder, true, true>(F.lds + RING_OFF, g, S, E, F.wv * 64 + lane_id());
        } break;
        case 9: if (blockIdx.x < 32) gdn_scan_naive(F); else moe_convert(F, 1, ((int)blockIdx.x - 32) * NWAVES + F.wv, (F.G - 32) * NWAVES); break;
        default: gdn_gate(F); break;
        }
        if ((mask >> (ph + 1)) != 0) xcd_barrier(bar, F.wv == 0 && lane_id() == 0);
    }
}

extern "C" void kernel_launch(void* const* d_in, const int* in_sizes, int n_in, void* d_out, int out_size, void* d_ws, size_t ws_size, hipStream_t stream) {
    static int grid = 0;
    if (grid == 0) {
        int dev = 0, cus = 0;
        if (hipGetDevice(&dev) != hipSuccess || hipDeviceGetAttribute(&cus, hipDeviceAttributeMultiprocessorCount, dev) != hipSuccess) { fprintf(stderr, "kernel_launch: device query failed\n"); grid = -1; return; }
        if (hipFuncSetAttribute((const void*)mk_fwd, hipFuncAttributeMaxDynamicSharedMemorySize, LDS_BYTES) != hipSuccess) { fprintf(stderr, "kernel_launch: hipFuncSetAttribute failed\n"); grid = -1; return; }
        (void)hipGetLastError();
        grid = cus;
        if (ws_size < WS_END) { fprintf(stderr, "kernel_launch: workspace too small\n"); }
    }
    if (grid < 0) return;
    (void)hipMemsetAsync((char*)d_ws + WS_CTL, 0, CTL_ZERO_BYTES, stream);
    Args a{};
    for (int i = 0; i < 21; ++i) a.in[i] = (const float*)d_in[i];
    a.out = (float*)d_out; a.ws = (unsigned char*)d_ws; a.mask = 0xffff; a.li = 0;
    hipLaunchKernelGGL(mk_fwd, dim3(grid), dim3(NTHR), LDS_BYTES, stream, a);
}
```

```cpp
#include <hip/hip_runtime.h>
#include <cstdio>
#include <cstdint>
namespace pg8 {
#define PG8_LAS __attribute__((address_space(3)))
typedef unsigned short bf16_t;
typedef short bf16x8 __attribute__((ext_vector_type(8)));
typedef float f32x4 __attribute__((ext_vector_type(4)));
typedef unsigned u32x4 __attribute__((ext_vector_type(4)));
constexpr int BM = 256, BK = 64, HALF = 128, HTB = HALF * BK * 2  , STAGE_BYTES = 8 * HTB, NXCD = 8, WGM = 8;

__host__ __device__ __forceinline__ int lds_byte(int r, int c) { const int st = (r >> 4) * 2 + (c >> 5), rr = r & 15, cc = c & 31, ob = rr * 64 + cc * 2; return st * 1024 + (ob ^ (((ob >> 9) & 1) << 5)); }
__host__ __device__ __forceinline__ void stage_rc(int b, int& R, int& C) { const int st = b / 1024, sb = b % 1024, swz = sb ^ (((sb >> 9) & 1) << 5); R = (st >> 1) * 16 + swz / 64; C = (st & 1) * 32 + (swz % 64) / 2; }
__host__ __device__ __forceinline__ int perm32(int rho) { const int n = rho >> 4, i = rho & 15; return 8 * (i >> 2) + 4 * n + (i & 3); }

struct Unit { int pm, pn; };
struct Gemm { const bf16_t* A; const bf16_t* Bt; int M, N, K; };

struct StaticOrder {
    int nM, nN, nwg, G, c;
    __host__ __device__ void init(int M, int N, int G_, int c_) { nM = M / BM; nN = N / BM; nwg = nM * nN; G = G_; c = c_; }
    __host__ __device__ bool next(int i, Unit& u) const {
        const long L = (long)i * G + c; if (L >= nwg) return false;
        int wgid = (int)L; { const int q = nwg / NXCD, r = nwg % NXCD, xcd = wgid % NXCD, off = wgid / NXCD; wgid = (xcd < r ? xcd * (q + 1) : r * (q + 1) + (xcd - r) * q) + off; }
        const int nig = WGM * nN, gid = wgid / nig, fm = gid * WGM, gsz = (nM - fm) < WGM ? (nM - fm) : WGM;
        u.pm = fm + ((wgid % nig) % gsz); u.pn = (wgid % nig) / gsz; return true;
    }
    __device__ __forceinline__ void a_ready(const Unit&) const {}
    __device__ __forceinline__ void done(const Unit&) const {}
};

__device__ __forceinline__ unsigned cvt_pk_bf16(float lo, float hi) { unsigned r; asm volatile("v_cvt_pk_bf16_f32 %0, %1, %2" : "=v"(r) : "v"(lo), "v"(hi)); return r; }
typedef unsigned u32x4 __attribute__((ext_vector_type(4)));
struct EpiQKV {
    static constexpr bool PERM = true, AFTER_DRAIN = false;
    bf16_t *Q, *K, *V; const float *qg, *kg; float qscale;
    __device__ __forceinline__ void operator()(const f32x4 (&acc)[2][2][4][2], const Unit& u, int wr, int wc, int fr, int fq) const {
        const int row0 = u.pm * BM + wr * 64 + fr;
        bf16_t* dst; int ld; const float* gain; float sc; bool norm;
        if (u.pn < 4) { dst = Q + (u.pn * 4 + wc) * 64; ld = 1024; gain = qg; sc = qscale; norm = true; }
        else if (u.pn == 4) { dst = K + wc * 64; ld = 256; gain = kg; sc = 1.f; norm = true; }
        else { dst = V + wc * 64; ld = 256; gain = qg; sc = 1.f; norm = false; }
        f32x4 gv[2][2];
#pragma unroll
        for (int bj = 0; bj < 2; ++bj)
#pragma unroll
            for (int n = 0; n < 2; ++n) { const f32x4 g4 = *(const f32x4*)(gain + 32 * bj + 8 * fq + 4 * n); gv[bj][n] = norm ? g4 * sc : (f32x4){1.f, 1.f, 1.f, 1.f}; }
#pragma unroll
        for (int ai = 0; ai < 2; ++ai)
#pragma unroll
            for (int m = 0; m < 4; ++m) {
                float ss = 0.f;
#pragma unroll
                for (int bj = 0; bj < 2; ++bj)
#pragma unroll
                    for (int n = 0; n < 2; ++n) { const f32x4 x = acc[ai][bj][m][n]; ss += (x[0] * x[0] + x[1] * x[1]) + (x[2] * x[2] + x[3] * x[3]); }
                ss += __shfl_xor(ss, 16); ss += __shfl_xor(ss, 32);
                const float rs = norm ? rsqrtf(ss * (1.0f / 64.0f) + 1e-6f) : 1.f;
                bf16_t* rowp = dst + (size_t)(row0 + ai * HALF + m * 16) * ld + 8 * fq;
#pragma unroll
                for (int bj = 0; bj < 2; ++bj) { const f32x4 v0 = acc[ai][bj][m][0] * rs * gv[bj][0], v1 = acc[ai][bj][m][1] * rs * gv[bj][1];
                    u32x4 w; w.x = cvt_pk_bf16(v0[0], v0[1]); w.y = cvt_pk_bf16(v0[2], v0[3]); w.z = cvt_pk_bf16(v1[0], v1[1]); w.w = cvt_pk_bf16(v1[2], v1[3]);
                    *(u32x4*)(rowp + 32 * bj) = w; }
            }
    }
};
struct EpiResF32 {
    static constexpr bool PERM = false, AFTER_DRAIN = false;
    const float* base; float* out; int ldc;
    __device__ __forceinline__ void operator()(const f32x4 (&acc)[2][2][4][2], const Unit& u, int wr, int wc, int fr, int fq) const {
        const int row0 = u.pm * BM + wr * 64 + fr, col0 = u.pn * BM + wc * 32 + 4 * fq;
#pragma unroll
        for (int ai = 0; ai < 2; ++ai)
#pragma unroll
            for (int m = 0; m < 4; ++m) { const size_t off = (size_t)(row0 + ai * HALF + m * 16) * ldc + col0;
#pragma unroll
                for (int bj = 0; bj < 2; ++bj)
#pragma unroll
                    for (int n = 0; n < 2; ++n) { const size_t o = off + bj * HALF + n * 16; const f32x4 b = *(const f32x4*)(base + o); *(f32x4*)(out + o) = b + acc[ai][bj][m][n]; } }
    }
};

constexpr int MOE_CAP = 16384;
struct MoeOrder {
    const PG8_LAS int* tab; int npn, G, c; const int* list; unsigned rowbytes;
    __device__ __forceinline__ bool next(int i, Unit& u) const {
        const int L = i * G + c; if (L >= tab[65 + 32]) return false;
        int e = 0;
        for (int j = 1; j < 32; ++j) e = (L >= tab[65 + j]) ? j : e;
        const int local = L - tab[65 + e], mt = local / npn, pnl = local - mt * npn;
        u.pm = (tab[32 + e] >> 8) + mt; u.pn = e * npn + pnl; return true;
    }
    __device__ __forceinline__ unsigned rowoff(const Unit& u, int r) const {
        const int e = u.pn >> 1, idx = u.pm * 256 - tab[32 + e] + r;
        const int tok = idx < tab[e] ? list[e * MOE_CAP + idx] : 0;
        return (unsigned)tok * rowbytes;
    }
    __device__ __forceinline__ void a_ready(const Unit&) const {}
    __device__ __forceinline__ void done(const Unit&) const {}
};
struct EpiGateUp {
    static constexpr bool PERM = true, AFTER_DRAIN = false;
    bf16_t* H; const float* glist; const PG8_LAS int* tab;
    __device__ __forceinline__ void operator()(const f32x4 (&acc)[2][2][4][2], const Unit& u, int wr, int wc, int fr, int fq) const {
        const int e = u.pn >> 1, pnl = u.pn & 1, row0 = u.pm * BM + wr * 64 + fr, li0 = row0 - tab[32 + e], cnt = tab[e];
#pragma unroll
        for (int ai = 0; ai < 2; ++ai)
#pragma unroll
            for (int m = 0; m < 4; ++m) { const int li = li0 + ai * HALF + m * 16; const float gw = li < cnt ? glist[e * MOE_CAP + li] : 0.f;
                f32x4 h[2];
#pragma unroll
                for (int n = 0; n < 2; ++n)
#pragma unroll
                    for (int i = 0; i < 4; ++i) { const float g = acc[ai][0][m][n][i], uu = acc[ai][1][m][n][i]; h[n][i] = g * __builtin_amdgcn_rcpf(1.f + __expf(-g)) * uu * gw; }
                u32x4 w; w.x = cvt_pk_bf16(h[0][0], h[0][1]); w.y = cvt_pk_bf16(h[0][2], h[0][3]); w.z = cvt_pk_bf16(h[1][0], h[1][1]); w.w = cvt_pk_bf16(h[1][2], h[1][3]);
                *(u32x4*)(H + (size_t)(row0 + ai * HALF + m * 16) * 256 + 128 * pnl + 32 * wc + 8 * fq) = w; }
    }
};
struct EpiY {
    static constexpr bool PERM = true, AFTER_DRAIN = false;
    bf16_t* Y;
    __device__ __forceinline__ void operator()(const f32x4 (&acc)[2][2][4][2], const Unit& u, int wr, int wc, int fr, int fq) const {
        const int row0 = u.pm * BM + wr * 64 + fr, col0 = (u.pn & 3) * BM + wc * 32 + 8 * fq;
#pragma unroll
        for (int ai = 0; ai < 2; ++ai)
#pragma unroll
            for (int m = 0; m < 4; ++m) { bf16_t* rowp = Y + (size_t)(row0 + ai * HALF + m * 16) * 1024 + col0;
#pragma unroll
                for (int bj = 0; bj < 2; ++bj) { const f32x4 v0 = acc[ai][bj][m][0], v1 = acc[ai][bj][m][1];
                    u32x4 w; w.x = cvt_pk_bf16(v0[0], v0[1]); w.y = cvt_pk_bf16(v0[2], v0[3]); w.z = cvt_pk_bf16(v1[0], v1[1]); w.w = cvt_pk_bf16(v1[2], v1[3]);
                    *(u32x4*)(rowp + bj * HALF) = w; } }
    }
};

struct EpiGdnIn {
    static constexpr bool PERM = true, AFTER_DRAIN = false;
    bf16_t *QKV, *Z, *HALO;
    __device__ __forceinline__ void operator()(const f32x4 (&acc)[2][2][4][2], const Unit& u, int wr, int wc, int fr, int fq) const {
        const int row0 = u.pm * BM + wr * 64 + fr;
        bf16_t* dst; int ld;
        if (u.pn < 12) { dst = QKV + u.pn * BM; ld = 3072; } else { dst = Z + (u.pn - 12) * BM; ld = 1024; }
        dst += wc * 32 + 8 * fq;
#pragma unroll
        for (int ai = 0; ai < 2; ++ai)
#pragma unroll
            for (int m = 0; m < 4; ++m) { bf16_t* rowp = dst + (size_t)(row0 + ai * HALF + m * 16) * ld;
#pragma unroll
                for (int bj = 0; bj < 2; ++bj) { const f32x4 v0 = acc[ai][bj][m][0], v1 = acc[ai][bj][m][1];
                    u32x4 w; w.x = cvt_pk_bf16(v0[0], v0[1]); w.y = cvt_pk_bf16(v0[2], v0[3]); w.z = cvt_pk_bf16(v1[0], v1[1]); w.w = cvt_pk_bf16(v1[2], v1[3]);
                    *(u32x4*)(rowp + bj * HALF) = w;
                    if (u.pn < 12 && ((m == 0 && fr == 0) || (m == 3 && fr >= 14))) { const int row = row0 + ai * HALF + m * 16, slot = m == 0 ? 0 : fr - 13;
                        *(u32x4*)(HALO + ((size_t)(row >> 6) * 3 + slot) * 3072 + u.pn * BM + wc * 32 + 8 * fq + bj * HALF) = w; } } }
    }
};
template <class Epi, class Sched, bool ALIGN_EPI = false, bool SP2 = false, bool GATHER = false>
__device__ __forceinline__ void gemm_phase(PG8_LAS unsigned char* lds, const Gemm g, const Sched& S, const Epi& E, int tid_in) {
    int tid_ = tid_in; asm volatile("" : "+v"(tid_));
    const int tid = tid_, wid = __builtin_amdgcn_readfirstlane(tid >> 6), lane = tid & 63, wr = wid >> 2, wc = wid & 3, fr = lane & 15, fq = lane >> 4;
    int K_ = g.K; asm volatile("" : "+s"(K_));
    const int K = K_, nt = K / BK;
    unsigned voffA[2], voffB[2];
#pragma unroll
    for (int i = 0; i < 2; ++i) { int R, C; stage_rc(tid * 16 + i * 8192, R, C); const int Rb = Epi::PERM ? ((R & ~31) + perm32(R & 31)) : R;
        voffA[i] = (unsigned)(R * K + C) * 2u; voffB[i] = (unsigned)(Rb * K + C) * 2u; }
    const size_t kstep = (size_t)(BK * 2);
    const size_t hstep = (size_t)HALF * K * 2; const size_t hstepA = GATHER ? (size_t)0 : hstep;
    const size_t tstep = 2 * hstep;
    const unsigned ldsw = (unsigned)wid * 1024u;
    const int aoff = lds_byte(wr * 64 + fr, fq * 8), boff = lds_byte(wc * 32 + fr, fq * 8);
#define PG8_SA(b, h) (((b) * 2 + (h)) * HTB)
#define PG8_SB(b, h) ((4 + (b) * 2 + (h)) * HTB)
#define PG8_STAGE(bufoff, gbase, voff) do { _Pragma("unroll") for (int _i = 0; _i < 2; ++_i) \
        __builtin_amdgcn_global_load_lds((const unsigned*)((const char*)(gbase) + (voff)[_i]), (PG8_LAS unsigned*)(lds + (bufoff) + ldsw + _i * 8192), 16, 0, 0); } while (0)
#define PG8_LDA(dst, b, h) do { _Pragma("unroll") for (int m = 0; m < 4; ++m) _Pragma("unroll") for (int k = 0; k < 2; ++k) dst[m][k] = *(const PG8_LAS bf16x8*)(lds + PG8_SA(b, h) + aoff + m * 2048 + k * 1024); } while (0)
#define PG8_LDB(dst, b, h) do { _Pragma("unroll") for (int n = 0; n < 2; ++n) _Pragma("unroll") for (int k = 0; k < 2; ++k) dst[n][k] = *(const PG8_LAS bf16x8*)(lds + PG8_SB(b, h) + boff + n * 2048 + k * 1024); } while (0)
#define PG8_MMA(ai, bj, At, Bt) do { __builtin_amdgcn_s_setprio(1); _Pragma("unroll") for (int m = 0; m < 4; ++m) _Pragma("unroll") for (int n = 0; n < 2; ++n) _Pragma("unroll") for (int k = 0; k < 2; ++k) \
        acc[ai][bj][m][n] = __builtin_amdgcn_mfma_f32_16x16x32_bf16(Bt[n][k], At[m][k], acc[ai][bj][m][n], 0, 0, 0); __builtin_amdgcn_s_setprio(0); } while (0)
#define PG8_WAIT_V(n) asm volatile("s_waitcnt vmcnt(" #n ")" ::: "memory")
#define PG8_WAIT_L(n) asm volatile("s_waitcnt lgkmcnt(" #n ")" ::: "memory")
#define PG8_BAR __builtin_amdgcn_s_barrier()
#define PG8_SCHED __builtin_amdgcn_sched_barrier(0)
    Unit cur, nxt; int ui = 0;
    if (!S.next(0, cur)) return;
    f32x4 acc[2][2][4][2];
#pragma unroll
    for (int a = 0; a < 2; ++a)
#pragma unroll
        for (int b = 0; b < 2; ++b)
#pragma unroll
            for (int m = 0; m < 4; ++m)
#pragma unroll
                for (int n = 0; n < 2; ++n) acc[a][b][m][n] = (f32x4){0.f, 0.f, 0.f, 0.f};
    bf16x8 At[4][2], B0[2][2], B1[2][2];
    const char* cA = (const char*)g.A + (GATHER ? (size_t)0 : (size_t)cur.pm * tstep);
    unsigned vC[2][2];
    PG8_LAS unsigned* vNl = (PG8_LAS unsigned*)(lds + STAGE_BYTES + 2048) + tid;
#pragma unroll
    for (int h = 0; h < 2; ++h)
#pragma unroll
        for (int i = 0; i < 2; ++i) { if constexpr (GATHER) { int R, C; stage_rc(tid * 16 + i * 8192, R, C); vC[h][i] = S.rowoff(cur, 128 * h + R) + (unsigned)C * 2u; vNl[(h * 2 + i) * 512] = vC[h][i]; } else vC[h][i] = voffA[i]; }
    const char* cB = (const char*)g.Bt + (size_t)cur.pn * tstep;
    S.a_ready(cur);
    if constexpr (SP2) {
        PG8_STAGE(PG8_SB(0, 0), cB, voffB); PG8_STAGE(PG8_SB(0, 1), cB + hstep, voffB); PG8_STAGE(PG8_SA(0, 0), cA, vC[0]); PG8_STAGE(PG8_SA(0, 1), cA + hstepA, vC[1]);
        if (wr == 1) PG8_BAR;
        PG8_WAIT_V(2); PG8_BAR;
        PG8_STAGE(PG8_SB(1, 0), cB + kstep, voffB); PG8_STAGE(PG8_SA(1, 0), cA + kstep, vC[0]); PG8_STAGE(PG8_SB(1, 1), cB + hstep + kstep, voffB);
        PG8_WAIT_V(6); PG8_BAR;
    } else {
        PG8_STAGE(PG8_SB(0, 0), cB, voffB); PG8_STAGE(PG8_SA(0, 0), cA, vC[0]); PG8_STAGE(PG8_SB(0, 1), cB + hstep, voffB); PG8_STAGE(PG8_SA(0, 1), cA + hstepA, vC[1]);
        if (wr == 1) PG8_BAR;
        PG8_WAIT_V(4); PG8_BAR;
        PG8_STAGE(PG8_SB(1, 0), cB + kstep, voffB); PG8_STAGE(PG8_SA(1, 0), cA + kstep, vC[0]); PG8_STAGE(PG8_SB(1, 1), cB + hstep + kstep, voffB);
        PG8_WAIT_V(6); PG8_BAR;
    }
    for (;;) {
        const bool has_next = S.next(ui + 1, nxt);
        const char* nA = (has_next && !GATHER) ? (const char*)g.A + (size_t)nxt.pm * tstep : cA;
        if constexpr (GATHER) { if (has_next) {
#pragma unroll
            for (int h = 0; h < 2; ++h)
#pragma unroll
                for (int i = 0; i < 2; ++i) { int R, C; stage_rc(tid * 16 + i * 8192, R, C); vNl[(h * 2 + i) * 512] = S.rowoff(nxt, 128 * h + R) + (unsigned)C * 2u; } } }
        const char* nB = has_next ? (const char*)g.Bt + (size_t)nxt.pn * tstep : cB;
        for (int t = 0; t < nt; t += 2) {
            const bool last = (t == nt - 2);
            const char* a1 = cA + (size_t)(t + 1) * kstep;
            const char* a2 = last ? nA : cA + (size_t)(t + 2) * kstep; const char* b2 = last ? nB : cB + (size_t)(t + 2) * kstep;
            const char* a3 = a2 + kstep; const char* b3 = b2 + kstep;
            unsigned v2[2][2];
#pragma unroll
            for (int h = 0; h < 2; ++h)
#pragma unroll
                for (int i = 0; i < 2; ++i) { if constexpr (GATHER) { v2[h][i] = vC[h][i]; if (last) v2[h][i] = vNl[(h * 2 + i) * 512]; } else v2[h][i] = vC[h][i]; }
            if (last && has_next) S.a_ready(nxt);
            if constexpr (SP2) {
            PG8_LDB(B0, 0, 0); PG8_LDB(B1, 0, 1); PG8_SCHED; PG8_LDA(At, 0, 0); PG8_STAGE(PG8_SA(1, 1), a1 + hstepA, vC[1]);
            PG8_WAIT_V(8); PG8_WAIT_L(0); PG8_BAR; PG8_MMA(0, 0, At, B0); PG8_MMA(0, 1, At, B1); PG8_BAR; PG8_SCHED;
            PG8_LDA(At, 0, 1); PG8_STAGE(PG8_SB(0, 0), b2, voffB); PG8_STAGE(PG8_SB(0, 1), b2 + hstep, voffB); PG8_STAGE(PG8_SA(0, 0), a2, v2[0]);
            PG8_WAIT_V(8); PG8_WAIT_L(0); PG8_BAR; PG8_MMA(1, 0, At, B0); PG8_MMA(1, 1, At, B1); PG8_BAR; PG8_SCHED;
            PG8_LDB(B0, 1, 0); PG8_LDB(B1, 1, 1); PG8_SCHED; PG8_LDA(At, 1, 0); PG8_STAGE(PG8_SA(0, 1), a2 + hstepA, v2[1]);
            PG8_WAIT_V(8); PG8_WAIT_L(0); PG8_BAR; PG8_MMA(0, 0, At, B0); PG8_MMA(0, 1, At, B1); PG8_BAR; PG8_SCHED;
            PG8_LDA(At, 1, 1); PG8_STAGE(PG8_SB(1, 0), b3, voffB); PG8_STAGE(PG8_SB(1, 1), b3 + hstep, voffB); PG8_STAGE(PG8_SA(1, 0), a3, v2[0]);
            PG8_WAIT_V(8); PG8_WAIT_L(0); PG8_BAR; PG8_MMA(1, 0, At, B0); PG8_MMA(1, 1, At, B1); PG8_BAR; PG8_SCHED;
            } else {
            PG8_LDB(B0, 0, 0); PG8_SCHED; PG8_LDA(At, 0, 0); PG8_STAGE(PG8_SA(1, 1), a1 + hstepA, vC[1]);
            PG8_WAIT_L(8); PG8_BAR; PG8_WAIT_L(0); PG8_MMA(0, 0, At, B0); PG8_BAR; PG8_SCHED;
            PG8_LDB(B1, 0, 1); PG8_STAGE(PG8_SB(0, 0), b2, voffB);
            PG8_BAR; PG8_WAIT_L(0); PG8_MMA(0, 1, At, B1); PG8_BAR;
            PG8_LDA(At, 0, 1); PG8_STAGE(PG8_SA(0, 0), a2, v2[0]);
            PG8_BAR; PG8_WAIT_L(0); PG8_MMA(1, 0, At, B0); PG8_BAR; PG8_SCHED;
            PG8_STAGE(PG8_SB(0, 1), b2 + hstep, voffB);
            PG8_WAIT_V(6); PG8_BAR; PG8_MMA(1, 1, At, B1); PG8_BAR;
            PG8_LDB(B0, 1, 0); PG8_SCHED; PG8_LDA(At, 1, 0); PG8_STAGE(PG8_SA(0, 1), a2 + hstepA, v2[1]);
            PG8_WAIT_L(8); PG8_BAR; PG8_WAIT_L(0); PG8_MMA(0, 0, At, B0); PG8_BAR; PG8_SCHED;
            PG8_LDB(B1, 1, 1); PG8_STAGE(PG8_SB(1, 0), b3, voffB);
            PG8_BAR; PG8_WAIT_L(0); PG8_MMA(0, 1, At, B1); PG8_BAR;
            PG8_LDA(At, 1, 1); PG8_STAGE(PG8_SA(1, 0), a3, v2[0]);
            PG8_BAR; PG8_WAIT_L(0); PG8_MMA(1, 0, At, B0); PG8_BAR; PG8_SCHED;
            PG8_STAGE(PG8_SB(1, 1), b3 + hstep, voffB);
            PG8_WAIT_V(6); PG8_BAR; PG8_MMA(1, 1, At, B1); PG8_BAR;
            }
        }
        if constexpr (ALIGN_EPI) { if (wr == 0) PG8_BAR; }
        if constexpr (!Epi::AFTER_DRAIN) { E(acc, cur, wr, wc, fr, fq); S.done(cur); }
        if (!has_next) break;
#pragma unroll
        for (int a = 0; a < 2; ++a)
#pragma unroll
            for (int b = 0; b < 2; ++b)
#pragma unroll
                for (int m = 0; m < 4; ++m)
#pragma unroll
                    for (int n = 0; n < 2; ++n) acc[a][b][m][n] = (f32x4){0.f, 0.f, 0.f, 0.f};
        cur = nxt; cA = nA; cB = nB; ++ui;
#pragma unroll
        for (int h = 0; h < 2; ++h)
#pragma unroll
            for (int i = 0; i < 2; ++i) { if constexpr (GATHER) vC[h][i] = vNl[(h * 2 + i) * 512]; }
        if constexpr (ALIGN_EPI) { if (wr == 1) PG8_BAR; }
    }
    PG8_WAIT_V(0);
    if constexpr (!ALIGN_EPI) { if (wr == 0) PG8_BAR; }
    PG8_BAR;
    if constexpr (Epi::AFTER_DRAIN) { E.fused(acc, cur, wr, wc, fr, fq, lds, wid, lane); S.done(cur); }
#undef PG8_SA
#undef PG8_SB
#undef PG8_STAGE
#undef PG8_LDA
#undef PG8_LDB
#undef PG8_MMA
#undef PG8_WAIT_V
#undef PG8_WAIT_L
#undef PG8_BAR
#undef PG8_SCHED
}
}
#define GAS __attribute__((address_space(1)))
#define LAS __attribute__((address_space(3)))
typedef unsigned short bf16;
typedef unsigned v4u __attribute__((ext_vector_type(4)));
typedef float f32x4 __attribute__((ext_vector_type(4)));
typedef short bf16x8 __attribute__((ext_vector_type(8)));
typedef GAS unsigned gu32;
typedef GAS unsigned long long gu64;
#define RLX_AGENT __ATOMIC_RELAXED, __HIP_MEMORY_SCOPE_AGENT
#define LDS_WAIT() asm volatile("s_waitcnt lgkmcnt(0)" ::: "memory")
#define VM_WAIT() asm volatile("s_waitcnt vmcnt(0)" ::: "memory")
__device__ __forceinline__ unsigned long long rt() { return __builtin_amdgcn_s_memrealtime(); }
__device__ __forceinline__ unsigned f2bf(float f) { unsigned u = __builtin_bit_cast(unsigned, f); return (u + 0x7fffu + ((u >> 16) & 1u)) >> 16; }
__device__ __forceinline__ unsigned pk2(float lo, float hi) { return f2bf(lo) | (f2bf(hi) << 16); }

#define XB_TMO      128
#define XB_XCNT(j)  (256  + 64 * (j))
#define XB_XSUB(j)  (1280 + 64 * (j))
#define XB_XGEN(j)  (2304 + 64 * (j))
#define XB_TOP      3328
#define XB_TOPGEN   3392
#define XCD_BAR_WORDS 3456
#define XB_SPIN_CAP (1u << 18)

__device__ __forceinline__ unsigned xb_ld(unsigned* p)              { return __hip_atomic_load(p, __ATOMIC_RELAXED, __HIP_MEMORY_SCOPE_AGENT); }
__device__ __forceinline__ unsigned xb_add(unsigned* p, unsigned v) { return __hip_atomic_fetch_add(p, v, __ATOMIC_RELAXED, __HIP_MEMORY_SCOPE_AGENT); }
__device__ __forceinline__ unsigned xb_xcc_id() { return (unsigned)__builtin_amdgcn_s_getreg((3 << 11) | 20) & 0xFu; }
#define XB_SPIN(cond, bar) do { unsigned _sp = 0; while (cond) { __builtin_amdgcn_s_sleep(1); \
    if ((++_sp & 255u) == 0u) { if (xb_ld(&(bar)[XB_TMO])) break; if (_sp > XB_SPIN_CAP) { atomicAdd(&(bar)[XB_TMO], 1u); break; } } } } while (0)

struct XcdBarrier {
    unsigned* bar; unsigned x;
    volatile LAS unsigned* st;
};

__device__ __forceinline__ XcdBarrier xcd_barrier_post(unsigned* bar, volatile LAS unsigned* st) {
    XcdBarrier b; b.bar = bar; b.x = xb_xcc_id(); b.st = st;
    if (threadIdx.x == 0) (void)xb_add(&bar[XB_XCNT(b.x)], 1u);
    return b;
}
__device__ __forceinline__ void xcd_barrier_complete(unsigned* bar, unsigned x, unsigned& nloc, unsigned& nx) {
    const unsigned G = gridDim.x * gridDim.y * gridDim.z;
    unsigned sum, cnt, mine, sp = 0u;
    for (;;) {
        sum = 0u; cnt = 0u; mine = 0u;
#pragma unroll
        for (unsigned j = 0; j < 16; ++j) { const unsigned c = xb_ld(&bar[XB_XCNT(j)]); sum += c; cnt += (c > 0u) ? 1u : 0u; mine = (j == x) ? c : mine; }
        if (sum == G) break;
        __builtin_amdgcn_s_sleep(1);
        if ((++sp & 255u) == 0u) { if (xb_ld(&bar[XB_TMO])) break; if (sp > XB_SPIN_CAP) { atomicAdd(&bar[XB_TMO], 1u); break; } }
    }
    nloc = mine > 0u ? mine : 1u; nx = cnt > 0u ? cnt : 1u;
}

__device__ __forceinline__ void xcd_barrier(const XcdBarrier& b, bool is_t0) {
    asm volatile("s_waitcnt vmcnt(0)" ::: "memory");
    __syncthreads();
    if (is_t0) {
        unsigned* bar = b.bar;
        __builtin_amdgcn_s_waitcnt(0);
        unsigned nloc = b.st[0], nx = b.st[1];
        if (nloc == 0u) { xcd_barrier_complete(bar, b.x, nloc, nx); b.st[0] = nloc; b.st[1] = nx; }
        const unsigned old = xb_add(&bar[XB_XSUB(b.x)], 1u);
        const unsigned gen = old / nloc;
        if (old + 1u == (gen + 1u) * nloc) {
            __builtin_amdgcn_fence(__ATOMIC_RELEASE, "agent");
            asm volatile("s_waitcnt vmcnt(0)" ::: "memory");
            const unsigned og = xb_add(&bar[XB_TOP], 1u);
            const unsigned tg = og / nx;
            if (og + 1u == (tg + 1u) * nx) xb_add(&bar[XB_TOPGEN], 1u);
            else XB_SPIN(xb_ld(&bar[XB_TOPGEN]) == tg, bar);
            __builtin_amdgcn_fence(__ATOMIC_ACQUIRE, "agent");
            xb_add(&bar[XB_XGEN(b.x)], 1u);
            asm volatile("s_waitcnt vmcnt(0)" ::: "memory");
        } else {
            XB_SPIN(xb_ld(&bar[XB_XGEN(b.x)]) == gen, bar);
            __builtin_amdgcn_fence(__ATOMIC_ACQUIRE, "agent");
            asm volatile("s_waitcnt vmcnt(0)" ::: "memory");
        }
    }
    __syncthreads();
}
constexpr int NWAVES = 8, NTHR = NWAVES * 64;
constexpr int MB = 2, MSEQ = 8192, MD = 1024, MT = MB * MSEQ;
constexpr float LOG2E = 1.4426950408889634f;
constexpr float QSCALE = 0.125f * LOG2E;
constexpr size_t MiB = 1u << 20;
constexpr size_t WS_CTL = 0, CTL_ZERO_BYTES = 1 * MiB;
constexpr size_t WS_WQKV = 1 * MiB;
constexpr size_t WS_WAO = 4 * MiB;
constexpr size_t WS_WGIN = 6 * MiB;
constexpr size_t WS_WAB = 14 * MiB;
constexpr size_t WS_WGO = 15 * MiB;
constexpr size_t WS_WR = 17 * MiB;
constexpr size_t WS_WGU = 18 * MiB;
constexpr size_t WS_WD = 50 * MiB;
constexpr size_t WS_XN = 66 * MiB;
constexpr size_t WS_LIST = 98 * MiB;
constexpr size_t WS_GLIST = 100 * MiB;
constexpr size_t WS_TOKSLOT = 102 * MiB;
constexpr size_t WS_H = 104 * MiB;
constexpr size_t WS_Y = 124 * MiB;
constexpr size_t WS_Q = 98 * MiB;
constexpr size_t WS_K = 130 * MiB;
constexpr size_t WS_V = 138 * MiB;
constexpr size_t WS_AO = 146 * MiB;
constexpr size_t WS_QKVPRE = 98 * MiB;
constexpr size_t WS_Z = 194 * MiB;
constexpr size_t WS_GB = 226 * MiB;
constexpr size_t WS_OF = 66 * MiB;
constexpr size_t WS_OB = 18 * MiB;
constexpr size_t WS_ON = 98 * MiB;
constexpr size_t WS_END = 285 * MiB;
constexpr int CW_TMO = 0, CW_CODE = 1, CW_BAR = 4096, CW_CNT = 16384;
constexpr int RING_OFF = 0, RING_BYTES = 131072, LDSCTL_OFF = RING_BYTES, MISC_OFF = LDSCTL_OFF + 320, MOETAB_OFF = LDSCTL_OFF + 1024, LDS_BYTES = 147456;

__device__ __forceinline__ float bf2f(unsigned short v) { return __uint_as_float((unsigned)v << 16); }
__device__ __forceinline__ float wsum(float v) {
#pragma unroll
    for (int o = 1; o < 64; o <<= 1) v += __shfl_xor(v, o);
    return v;
}
__device__ __forceinline__ float wmax(float v) {
#pragma unroll
    for (int o = 1; o < 64; o <<= 1) v = fmaxf(v, __shfl_xor(v, o));
    return v;
}
__device__ __forceinline__ float silu_f(float x) { return x * __builtin_amdgcn_rcpf(1.f + __expf(-x)); }
typedef unsigned u32x2_t __attribute__((ext_vector_type(2)));
__device__ __forceinline__ int opq(int x) { asm volatile("" : "+v"(x)); return x; }
__device__ __forceinline__ int lane_id() { return (int)__builtin_amdgcn_mbcnt_hi(~0u, __builtin_amdgcn_mbcnt_lo(~0u, 0u)); }
__device__ __forceinline__ int opqs(int x) { asm volatile("" : "+s"(x)); return x; }
#define PHASE_IDS(F) const int wave = opqs((F).wv), lane = opq(lane_id()), tid = wave * 64 + lane, gw = (F).gwb + wave; (void)tid; (void)lane; (void)wave; (void)gw

struct Ctx {
    LAS unsigned char* lds;
    volatile LAS unsigned* MISC;
    gu32* ctl;
    int G, gwb, NGW, wv;
    const float* in[21];
    float* out; unsigned char* ws;
};

template <class RowMap>
__device__ __forceinline__ void transpose_item(const float* W, int ldw, int K, bf16* WT, RowMap rm, LAS float* scr, int kb, int nb, int lane) {
    const int k0 = 64 * kb, n0 = 32 * nb;
#pragma unroll 8
    for (int i = 0; i < 32; ++i) { const int kk = 2 * i + (lane >> 5); scr[kk * 33 + (lane & 31)] = W[(size_t)(k0 + kk) * ldw + n0 + (lane & 31)]; }
    LDS_WAIT(); asm volatile("" ::: "memory");
    const int c = lane & 7;
#pragma unroll
    for (int j = 0; j < 4; ++j) { const int n = (lane >> 3) + 8 * j; const LAS float* s = scr + (8 * c) * 33 + n;
        v4u o; o.x = pk2(s[0 * 33], s[1 * 33]); o.y = pk2(s[2 * 33], s[3 * 33]); o.z = pk2(s[4 * 33], s[5 * 33]); o.w = pk2(s[6 * 33], s[7 * 33]);
        *(GAS v4u*)(WT + (size_t)rm(n0 + n) * K + k0 + 8 * c) = o; }
    LDS_WAIT(); asm volatile("" ::: "memory");
}
__device__ __forceinline__ void rms_row_to_bf16(const float* xrow, const float* g, bf16* orow, int lane) {
    const GAS f32x4* xr = (const GAS f32x4*)xrow + lane; const GAS f32x4* gr = (const GAS f32x4*)g + lane;
    f32x4 v[4]; float s = 0.f;
#pragma unroll
    for (int j = 0; j < 4; ++j) { v[j] = xr[64 * j]; s += (v[j].x * v[j].x + v[j].y * v[j].y) + (v[j].z * v[j].z + v[j].w * v[j].w); }
    const float rs = rsqrtf(wsum(s) * (1.f / MD) + 1e-6f);
    GAS unsigned long long* o8 = (GAS unsigned long long*)orow + lane;
#pragma unroll
    for (int j = 0; j < 4; ++j) { const f32x4 gg = gr[64 * j]; o8[64 * j] = (unsigned long long)pk2(v[j].x * rs * gg.x, v[j].y * rs * gg.y) | ((unsigned long long)pk2(v[j].z * rs * gg.z, v[j].w * rs * gg.w) << 32); }
}
__device__ __forceinline__ int qkv_rowmap(int c) { const int cl = c & 255; return (c & ~255) + ((cl >> 5) & 1) * 128 + (cl >> 6) * 32 + (cl & 31); }

__device__ __forceinline__ void moe_convert(Ctx& F, int layer, int widx, int wcnt) {
    PHASE_IDS(F);
    LAS float* scr = (LAS float*)(F.lds + RING_OFF + wave * 16384);
    const float* Wg = F.in[18] + (size_t)layer * 32 * MD * 256; const float* Wu = F.in[19] + (size_t)layer * 32 * MD * 256; const float* Wd = F.in[20] + (size_t)layer * 32 * 256 * MD;
    bf16* WGU = (bf16*)(F.ws + WS_WGU); bf16* WD = (bf16*)(F.ws + WS_WD);
    for (int it = widx; it < 32 * 384; it += wcnt) {
        const int e = it / 384, r = it % 384;
        if (r < 128) transpose_item(Wg + (size_t)e * MD * 256, 256, MD, WGU, [e](int f) { return e * 512 + ((f >> 7) << 8) + (f & 127); }, scr, r >> 3, r & 7, lane);
        else if (r < 256) transpose_item(Wu + (size_t)e * MD * 256, 256, MD, WGU, [e](int f) { return e * 512 + ((f >> 7) << 8) + 128 + (f & 127); }, scr, (r - 128) >> 3, (r - 128) & 7, lane);
        else transpose_item(Wd + (size_t)e * 256 * MD, MD, 256, WD, [e](int d) { return e * 1024 + d; }, scr, (r - 256) >> 5, (r - 256) & 31, lane);
    }
}
__device__ __forceinline__ void p0_prologue(Ctx& F) {
    PHASE_IDS(F);
    LAS float* scr = (LAS float*)(F.lds + RING_OFF + wave * 16384);
    constexpr int I_QKV = 16 * 48, I_AO = 16 * 32, I_GIN = 16 * 128, I_AB = 16, I_GO = 16 * 32;
    for (int it = gw; it < I_QKV + I_AO + I_GIN + I_AB + I_GO; it += F.NGW) {
        int r = it;
        if (r < I_QKV) { transpose_item(F.in[3], 1536, MD, (bf16*)(F.ws + WS_WQKV), [](int c) { return qkv_rowmap(c); }, scr, r / 48, r % 48, lane); continue; } r -= I_QKV;
        if (r < I_AO) { transpose_item(F.in[7], MD, MD, (bf16*)(F.ws + WS_WAO), [](int c) { return c; }, scr, r >> 5, r & 31, lane); continue; } r -= I_AO;
        if (r < I_GIN) { transpose_item(F.in[8], 4128, MD, (bf16*)(F.ws + WS_WGIN), [](int c) { return c; }, scr, r >> 7, r & 127, lane); continue; } r -= I_GIN;
        if (r < I_AB) { transpose_item(F.in[8], 4128, MD, (bf16*)(F.ws + WS_WAB), [](int c) { return c - 4096; }, scr, r, 128, lane); continue; } r -= I_AB;
        transpose_item(F.in[13], MD, MD, (bf16*)(F.ws + WS_WGO), [](int c) { return c; }, scr, r >> 5, r & 31, lane);
    }
    for (int layer = 0; layer < 2; ++layer) { bf16* wr = (bf16*)(F.ws + WS_WR + (size_t)layer * 131072); const float* wg = F.in[14] + (size_t)layer * MD * 4; const float* we = F.in[16] + (size_t)layer * MD * 32;
        for (int idx = gw * 64 + lane; idx < 48 * MD; idx += F.NGW * 64) { const int r = idx >> 10, k = idx & 1023;
            const float v = r < 4 ? wg[k * 4 + r] : (r < 36 ? we[k * 32 + (r - 4)] : 0.f); wr[idx] = (bf16)f2bf(v); } }
    moe_convert(F, 0, gw, F.NGW);
    for (int m = gw; m < MT; m += F.NGW) rms_row_to_bf16(F.in[0] + (size_t)m * MD, F.in[1], (bf16*)(F.ws + WS_XN) + (size_t)m * MD, lane);
}

__device__ __forceinline__ void attn_simple(Ctx& F) {
    PHASE_IDS(F);
    LAS float* qs = (LAS float*)(F.lds + RING_OFF + wave * 2048);
    LAS float* ps = qs + 64;
    const bf16* Q = (const bf16*)(F.ws + WS_Q); const bf16* K = (const bf16*)(F.ws + WS_K); const bf16* V = (const bf16*)(F.ws + WS_V); bf16* AO = (bf16*)(F.ws + WS_AO);
    const float* sink = F.in[6];
    for (int item = gw; item < MT * 16; item += F.NGW) {
        const int t = item >> 4, h = item & 15, b = t / MSEQ, tt = t % MSEQ, g = h >> 2;
        const float slope2 = exp2f(-8.0f * (float)(h + 1) / 16.0f) * LOG2E;
        qs[lane] = bf2f(Q[(size_t)t * 1024 + h * 64 + lane]);
        LDS_WAIT(); asm volatile("" ::: "memory");
        float sc[5]; bool valid[5]; float mx = -INFINITY;
#pragma unroll
        for (int i = 0; i < 5; ++i) {
            const int j = lane + 64 * i, s = tt - 128 + j;
            valid[i] = (j <= 256) && s >= 0 && s < MSEQ; sc[i] = -INFINITY;
            if (valid[i]) {
                const GAS v4u* kp = (const GAS v4u*)(K + (size_t)(b * MSEQ + s) * 256 + g * 64);
                float dot = 0.f;
#pragma unroll
                for (int d = 0; d < 8; ++d) { const v4u kv = kp[d];
                    dot += qs[8 * d + 0] * __uint_as_float(kv.x << 16) + qs[8 * d + 1] * __uint_as_float(kv.x & 0xffff0000u) + qs[8 * d + 2] * __uint_as_float(kv.y << 16) + qs[8 * d + 3] * __uint_as_float(kv.y & 0xffff0000u)
                         + qs[8 * d + 4] * __uint_as_float(kv.z << 16) + qs[8 * d + 5] * __uint_as_float(kv.z & 0xffff0000u) + qs[8 * d + 6] * __uint_as_float(kv.w << 16) + qs[8 * d + 7] * __uint_as_float(kv.w & 0xffff0000u); }
                const int dist = tt > s ? tt - s : s - tt;
                sc[i] = dot - slope2 * (float)dist; mx = fmaxf(mx, sc[i]);
            }
        }
        const float sk2 = sink[h] * LOG2E;
        const float m = fmaxf(wmax(mx), sk2);
        float psum = 0.f;
#pragma unroll
        for (int i = 0; i < 5; ++i) { const float p = valid[i] ? exp2f(sc[i] - m) : 0.f; ps[i * 64 + lane] = p; psum += p; }
        const float denom = wsum(psum) + exp2f(sk2 - m);
        LDS_WAIT(); asm volatile("" ::: "memory");
        float acc = 0.f;
        for (int j = 0; j <= 256; ++j) { const int s = tt - 128 + j; if (s >= 0 && s < MSEQ) acc += ps[j] * bf2f(V[(size_t)(b * MSEQ + s) * 256 + g * 64 + lane]); }
        AO[(size_t)t * 1024 + h * 64 + lane] = (bf16)f2bf(acc / denom);
        LDS_WAIT(); asm volatile("" ::: "memory");
    }
}

__device__ __forceinline__ void moe_tables(Ctx& F, int layer, int npn) {
    PHASE_IDS(F);
    LAS int* tab = (LAS int*)(F.lds + MOETAB_OFF);
    __syncthreads();
    if (tid < 32) tab[tid] = (int)__hip_atomic_load(F.ctl + CW_CNT + 64 * layer + tid, RLX_AGENT);
    __syncthreads();
    if (tid == 0) { int seg = 0, ub = 0; for (int e = 0; e < 32; ++e) { tab[32 + e] = seg; tab[65 + e] = ub; const int mt = (tab[e] + 255) >> 8; seg += mt << 8; ub += mt * npn; } tab[64] = seg; tab[97] = ub; }
    __syncthreads();
}
__device__ __forceinline__ void wg_self_visible(Ctx& F) {
    PHASE_IDS(F);
    VM_WAIT(); __syncthreads();
    if (tid == 0) { __builtin_amdgcn_fence(__ATOMIC_ACQUIRE, "agent"); VM_WAIT(); }
    __syncthreads();
}
__device__ __forceinline__ void p4_router(Ctx& F, int layer) {
    PHASE_IDS(F);
    const float* X = F.out; const float* g = F.in[2] + (size_t)layer * MD; bf16* XN = (bf16*)(F.ws + WS_XN);
    const bf16* Wr = (const bf16*)(F.ws + WS_WR + (size_t)layer * 131072);
    const float* bg = F.in[15] + layer * 4; const float* be = F.in[17] + layer * 32;
    gu32* cnt = F.ctl + CW_CNT + 64 * layer;
    int* list = (int*)(F.ws + WS_LIST); float* glist = (float*)(F.ws + WS_GLIST); int* tokslot = (int*)(F.ws + WS_TOKSLOT);
    LAS float* lg = (LAS float*)(F.lds + RING_OFF);
    const int w = wave, fr = lane & 15, fq = lane >> 4;
    for (int rb = blockIdx.x; rb < MT / 64; rb += F.G) {
        const int row0 = rb * 64;
        for (int r = 0; r < 8; ++r) { const size_t row = (size_t)(row0 + 8 * w + r); rms_row_to_bf16(X + row * MD, g, XN + row * MD, lane); }
        wg_self_visible(F);
        if (w < 4) {
            pg8::f32x4 acc[3] = {{0.f, 0.f, 0.f, 0.f}, {0.f, 0.f, 0.f, 0.f}, {0.f, 0.f, 0.f, 0.f}};
            const bf16* arow = XN + (size_t)(row0 + 16 * w + fr) * MD + 8 * fq; const bf16* brow = Wr + (size_t)fr * MD + 8 * fq;
#pragma unroll 4
            for (int ks = 0; ks < 32; ++ks) {
                const bf16x8 a = *(const GAS bf16x8*)(arow + 32 * ks);
#pragma unroll
                for (int nt = 0; nt < 3; ++nt) { const bf16x8 b = *(const GAS bf16x8*)(brow + (size_t)nt * 16 * MD + 32 * ks); acc[nt] = __builtin_amdgcn_mfma_f32_16x16x32_bf16(b, a, acc[nt], 0, 0, 0); }
            }
#pragma unroll
            for (int nt = 0; nt < 3; ++nt)
#pragma unroll
                for (int r = 0; r < 4; ++r) lg[(16 * w + fr) * 49 + 16 * nt + 4 * fq + r] = acc[nt][r];
        }
        __syncthreads();
        if (tid < 64) {
            const LAS float* l = lg + tid * 49; const int tok = row0 + tid;
            float gl[4]; for (int i = 0; i < 4; ++i) gl[i] = l[i] + bg[i];
            int gi = 0; float gm = gl[0];
            for (int i = 1; i < 4; ++i) if (gl[i] > gm) { gm = gl[i]; gi = i; }
            float gs = 0.f; for (int i = 0; i < 4; ++i) gs += __expf(gl[i] - gm);
            const float gprob = 1.f / gs;
            int e1 = 0, e2 = -1; float m1 = -INFINITY, m2 = -INFINITY;
            for (int i = 0; i < 8; ++i) { const float v = l[4 + gi * 8 + i] + be[gi * 8 + i]; if (v > m1) { m2 = m1; e2 = e1; m1 = v; e1 = i; } else if (v > m2) { m2 = v; e2 = i; } }
            const float p2 = __expf(m2 - m1), inv = 1.f / (1.f + p2);
            const int x1 = gi * 8 + e1, x2 = gi * 8 + e2;
            const unsigned pos1 = __hip_atomic_fetch_add(cnt + x1, 1u, RLX_AGENT), pos2 = __hip_atomic_fetch_add(cnt + x2, 1u, RLX_AGENT);
            list[x1 * 16384 + pos1] = tok; glist[x1 * 16384 + pos1] = gprob * inv;
            list[x2 * 16384 + pos2] = tok; glist[x2 * 16384 + pos2] = gprob * p2 * inv;
            tokslot[tok * 2] = (x1 << 16) | (int)pos1; tokslot[tok * 2 + 1] = (x2 << 16) | (int)pos2;
        }
        __syncthreads();
    }
}
template <bool NEXT>
__device__ __forceinline__ void p7_combine(Ctx& F) {
    PHASE_IDS(F);
    const LAS int* tab = (const LAS int*)(F.lds + MOETAB_OFF);
    const int* tokslot = (const int*)(F.ws + WS_TOKSLOT); const bf16* Y = (const bf16*)(F.ws + WS_Y); float* X = F.out;
    bf16* XN = (bf16*)(F.ws + WS_XN); const float* gn = F.in[1] + MD;
    const int w = wave, fr = lane & 15, fq = lane >> 4;
    for (int rb = blockIdx.x; rb < MT / 64; rb += F.G) {
        const int row0 = rb * 64;
        for (int r = 0; r < 8; ++r) {
            const int t = row0 + 8 * w + r;
            const int s0 = tokslot[t * 2], s1 = tokslot[t * 2 + 1];
            const size_t y0 = (size_t)(tab[32 + (s0 >> 16)] + (s0 & 0xffff)), y1 = (size_t)(tab[32 + (s1 >> 16)] + (s1 & 0xffff));
            GAS f32x4* xr = (GAS f32x4*)(X + (size_t)t * MD) + lane;
            const GAS u32x2_t* a = (const GAS u32x2_t*)(Y + y0 * MD) + lane; const GAS u32x2_t* b = (const GAS u32x2_t*)(Y + y1 * MD) + lane;
            f32x4 v[4]; float ss = 0.f;
#pragma unroll
            for (int j = 0; j < 4; ++j) { v[j] = xr[64 * j]; const u32x2_t p = a[64 * j], q = b[64 * j];
                v[j].x += __uint_as_float(p.x << 16) + __uint_as_float(q.x << 16); v[j].y += __uint_as_float(p.x & 0xffff0000u) + __uint_as_float(q.x & 0xffff0000u);
                v[j].z += __uint_as_float(p.y << 16) + __uint_as_float(q.y << 16); v[j].w += __uint_as_float(p.y & 0xffff0000u) + __uint_as_float(q.y & 0xffff0000u);
                xr[64 * j] = v[j]; ss += (v[j].x * v[j].x + v[j].y * v[j].y) + (v[j].z * v[j].z + v[j].w * v[j].w); }
            if constexpr (NEXT) {
                const float rs = rsqrtf(wsum(ss) * (1.f / MD) + 1e-6f);
                GAS unsigned long long* o8 = (GAS unsigned long long*)(XN + (size_t)t * MD) + lane; const GAS f32x4* gr = (const GAS f32x4*)gn + lane;
#pragma unroll
                for (int j = 0; j < 4; ++j) { const f32x4 gg = gr[64 * j]; o8[64 * j] = (unsigned long long)pk2(v[j].x * rs * gg.x, v[j].y * rs * gg.y) | ((unsigned long long)pk2(v[j].z * rs * gg.z, v[j].w * rs * gg.w) << 32); }
            }
        }
        if constexpr (NEXT) {
            wg_self_visible(F);
            if (w < 4) {
                const bf16* Wab = (const bf16*)(F.ws + WS_WAB); float* GB = (float*)(F.ws + WS_GB);
                pg8::f32x4 acc[2] = {{0.f, 0.f, 0.f, 0.f}, {0.f, 0.f, 0.f, 0.f}};
                const bf16* arow = XN + (size_t)(row0 + 16 * w + fr) * MD + 8 * fq; const bf16* brow = Wab + (size_t)fr * MD + 8 * fq;
#pragma unroll 4
                for (int ks = 0; ks < 32; ++ks) {
                    const bf16x8 a = *(const GAS bf16x8*)(arow + 32 * ks);
#pragma unroll
                    for (int nt = 0; nt < 2; ++nt) { const bf16x8 b = *(const GAS bf16x8*)(brow + (size_t)nt * 16 * MD + 32 * ks); acc[nt] = __builtin_amdgcn_mfma_f32_16x16x32_bf16(b, a, acc[nt], 0, 0, 0); }
                }
                const int tok = row0 + 16 * w + fr;
#pragma unroll
                for (int r = 0; r < 4; ++r) { const int c = 4 * fq + r;
                    const float xx = acc[0][r] + F.in[11][c]; const float sp = fmaxf(xx, 0.f) + log1pf(__expf(-fabsf(xx)));
                    GB[(size_t)tok * 32 + c] = -__expf(F.in[10][c]) * sp;
                    GB[(size_t)tok * 32 + 16 + c] = 1.f / (1.f + __expf(-acc[1][r])); }
            }
        }
    }
}

__device__ __forceinline__ void gdn_scan_naive(Ctx& F) {
    PHASE_IDS(F);
    constexpr int TS = 16;
    const int sq = blockIdx.x, b = sq >> 4, h = (sq >> 1) & 7, dir = sq & 1, w = wave;
    LAS float* qs = (LAS float*)(F.lds + RING_OFF);
    LAS float* red = qs + 3 * TS * 128;
    const bf16* pre = (const bf16*)(F.ws + WS_QKVPRE) + (size_t)b * MSEQ * 3072;
    const float* GB = (const float*)(F.ws + WS_GB) + (size_t)b * MSEQ * 32;
    bf16* od = (bf16*)(F.ws + (dir ? WS_OB : WS_OF)) + (size_t)b * MSEQ * MD;
    const float* convw = F.in[9];
    const int wh = tid >> 7, j = tid & 127;
    float cw[4] = {0.f, 0.f, 0.f, 0.f};
    if (tid < 384) {
#pragma unroll
        for (int jj = 0; jj < 4; ++jj) cw[jj] = convw[jj * 3072 + wh * 1024 + h * 128 + j]; }
    LAS float* kspart = red + 2 * TS;
    LAS float* opart = kspart + 2 * 4 * 128;
    const int part = tid >> 7, jc = tid & 127;
    float St[32];
#pragma unroll
    for (int i = 0; i < 32; ++i) St[i] = 0.f;
    for (int tile = 0; tile < MSEQ / TS; ++tile) {
        __syncthreads();
        if (tid < 384) {
            for (int st = 0; st < TS; ++st) {
                const int n = tile * TS + st, t = dir ? MSEQ - 1 - n : n;
                float a = 0.f;
#pragma unroll
                for (int jj = 0; jj < 4; ++jj) { const int tt = t + jj - 2; if (tt >= 0 && tt < MSEQ) a += cw[jj] * bf2f(pre[(size_t)tt * 3072 + wh * 1024 + h * 128 + j]); }
                qs[(wh * TS + st) * 128 + j] = silu_f(a);
            }
        }
        __syncthreads();
        for (int rr = w; rr < 2 * TS; rr += NWAVES) { const int which = rr & 1, st = rr >> 1; const float a0 = qs[(which * TS + st) * 128 + lane], a1 = qs[(which * TS + st) * 128 + lane + 64];
            const float ss = wsum(a0 * a0 + a1 * a1); if (lane == 0) red[which * TS + st] = ss; }
        __syncthreads();
        for (int st = 0; st < TS; ++st) {
            const float qn = rsqrtf(red[st] + 1e-6f) * 0.08838834764831845f, kn = rsqrtf(red[TS + st] + 1e-6f);
            const int n = tile * TS + st, t = dir ? MSEQ - 1 - n : n;
            const float gg = GB[(size_t)t * 32 + dir * 8 + h], beta = GB[(size_t)t * 32 + 16 + dir * 8 + h];
            const float dec = __expf(gg);
            const LAS float* kk = qs + (TS + st) * 128 + 32 * part; const LAS float* qq = qs + st * 128 + 32 * part;
            float ksp = 0.f;
#pragma unroll
            for (int i = 0; i < 32; ++i) ksp += kk[i] * St[i];
            kspart[((st & 1) * 4 + part) * 128 + jc] = ksp;
            __syncthreads();
            const LAS float* kp = kspart + (st & 1) * 4 * 128 + jc;
            const float kS = ((kp[0] + kp[128]) + (kp[256] + kp[384])) * kn * dec;
            const float vn = beta * (qs[(2 * TS + st) * 128 + jc] - kS) * kn;
            float ov = 0.f;
#pragma unroll
            for (int i = 0; i < 32; ++i) { St[i] = dec * St[i] + kk[i] * vn; ov += qq[i] * St[i]; }
            opart[(st * 4 + part) * 128 + jc] = ov * qn;
        }
        __syncthreads();
        for (int e = tid; e < TS * 128; e += NTHR) { const int st = e >> 7, c = e & 127; const LAS float* op = opart + st * 4 * 128 + c;
            const int n = tile * TS + st, t = dir ? MSEQ - 1 - n : n;
            od[(size_t)t * MD + h * 128 + c] = (bf16)f2bf((op[0] + op[128]) + (op[256] + op[384])); }
    }
}
__device__ __forceinline__ void gdn_gate(Ctx& F) {
    PHASE_IDS(F);
    const unsigned* of = (const unsigned*)(F.ws + WS_OF); const unsigned* ob = (const unsigned*)(F.ws + WS_OB); const unsigned* z = (const unsigned*)(F.ws + WS_Z);
    unsigned* on = (unsigned*)(F.ws + WS_ON); const float* og = F.in[12];
    const float g0 = og[2 * lane], g1 = og[2 * lane + 1];
    for (int it = gw; it < MT * 8; it += F.NGW) {
        const size_t idx = (size_t)it * 64 + lane;
        const unsigned a = of[idx], bb = ob[idx], zz = z[idx];
        const float o0 = __uint_as_float(a << 16) + __uint_as_float(bb << 16), o1 = __uint_as_float(a & 0xffff0000u) + __uint_as_float(bb & 0xffff0000u);
        const float rs = rsqrtf(wsum(o0 * o0 + o1 * o1) * (1.f / 128.f) + 1e-6f);
        on[idx] = pk2(o0 * rs * g0 * silu_f(__uint_as_float(zz << 16)), o1 * rs * g1 * silu_f(__uint_as_float(zz & 0xffff0000u)));
    }
}

constexpr size_t WS_HALO = 228 * MiB;
constexpr size_t WS_REC = 233 * MiB;
constexpr int REC_BYTES = 13312;
constexpr int PQT = 0, PKT = 17408, PSC = 34816, PLB = 36864, PLB_STRIDE = 8704;
typedef short v4i16_t __attribute__((ext_vector_type(4)));

__device__ __forceinline__ int tri_off(int i) { const int a = (i - 1) >> 2, r = (i - 1) & 3; return 4 * (a + 1) * (2 * a + r); }
__device__ __forceinline__ int img_off(int i, int j) {
    const int mt = i >> 4, ks = j >> 5, f = mt < 2 ? mt : 2 + (mt - 2) * 2 + ks, cc = j & 31, g = (cc & 15) >> 2, jj = (cc & 3) + ((cc >> 4) << 2);
    return f * 1024 + ((g * 16 + (i & 15)) * 8 + jj) * 2;
}
__device__ __forceinline__ void gdn_prep(Ctx& F) {
    PHASE_IDS(F);
    LAS unsigned char* L = F.lds + RING_OFF;
    bf16* QKV = (bf16*)(F.ws + WS_QKVPRE); const bf16* HALO = (const bf16*)(F.ws + WS_HALO); const float* GB = (const float*)(F.ws + WS_GB);
    unsigned char* REC = F.ws + WS_REC; const float* convw = F.in[9];
    for (int batch = blockIdx.x; batch < 512; batch += F.G) {
        const int b = batch >> 8, h = (batch >> 5) & 7, n0 = (batch & 31) * 4;
#pragma unroll 1
        for (int c4 = 0; c4 < 4; ++c4) {
            const int n = n0 + c4, t0 = n * 64;
            const int tidc = opq(tid), lanec = tidc & 63, g4 = lanec >> 4, l16 = lanec & 15;
            const int rg = tidc / 48, rem = tidc - 48 * rg, which = rem >> 4, c16 = rem & 15;
            const int col = which * 1024 + h * 128 + c16 * 8;
            v4u in[11];
            if (tidc < 384) {
#pragma unroll
                for (int ri = 0; ri < 11; ++ri) { const int lr = 8 * rg - 2 + ri; const bf16* src = nullptr;
                    if (lr >= 0 && lr < 64) src = QKV + ((size_t)(b * MSEQ + t0 + lr) * 3072 + col);
                    else if (lr < 0) { if (n > 0) src = HALO + ((size_t)((b * 128 + n - 1) * 3 + (lr + 3)) * 3072 + col); }
                    else { if (n < 127) src = HALO + ((size_t)((b * 128 + n + 1) * 3) * 3072 + col); }
                    in[ri] = src ? *(const GAS v4u*)src : (v4u){0u, 0u, 0u, 0u}; }
            }
            __syncthreads();
            if (tidc < 384) {
                float cw[4][8];
#pragma unroll
                for (int jj = 0; jj < 4; ++jj) { const GAS f32x4* p = (const GAS f32x4*)(convw + jj * 3072 + col); const f32x4 a = p[0], bq = p[1];
                    cw[jj][0] = a.x; cw[jj][1] = a.y; cw[jj][2] = a.z; cw[jj][3] = a.w; cw[jj][4] = bq.x; cw[jj][5] = bq.y; cw[jj][6] = bq.z; cw[jj][7] = bq.w; }
#pragma unroll
                for (int r = 0; r < 8; ++r) {
                    float o[8];
#pragma unroll
                    for (int c = 0; c < 8; ++c) o[c] = 0.f;
#pragma unroll
                    for (int jj = 0; jj < 4; ++jj) { const v4u x = in[r + jj];
                        o[0] += cw[jj][0] * __uint_as_float(x.x << 16); o[1] += cw[jj][1] * __uint_as_float(x.x & 0xffff0000u);
                        o[2] += cw[jj][2] * __uint_as_float(x.y << 16); o[3] += cw[jj][3] * __uint_as_float(x.y & 0xffff0000u);
                        o[4] += cw[jj][4] * __uint_as_float(x.z << 16); o[5] += cw[jj][5] * __uint_as_float(x.z & 0xffff0000u);
                        o[6] += cw[jj][6] * __uint_as_float(x.w << 16); o[7] += cw[jj][7] * __uint_as_float(x.w & 0xffff0000u); }
                    float ss = 0.f;
#pragma unroll
                    for (int c = 0; c < 8; ++c) { o[c] = silu_f(o[c]); ss += o[c] * o[c]; }
                    ss += __shfl_xor(ss, 1); ss += __shfl_xor(ss, 2); ss += __shfl_xor(ss, 4); ss += __shfl_xor(ss, 8);
                    const float sc = which == 0 ? rsqrtf(ss + 1e-6f) * 0.08838834764831845f : (which == 1 ? rsqrtf(ss + 1e-6f) : 1.f);
                    v4u w; w.x = pk2(o[0] * sc, o[1] * sc); w.y = pk2(o[2] * sc, o[3] * sc); w.z = pk2(o[4] * sc, o[5] * sc); w.w = pk2(o[6] * sc, o[7] * sc);
                    const int lr = 8 * rg + r;
                    *(GAS v4u*)(QKV + ((size_t)(b * MSEQ + t0 + lr) * 3072 + col)) = w;
                    if (which < 2) *(LAS v4u*)(L + (which ? PKT : PQT) + lr * 272 + c16 * 16) = w;
                }
            }
            if (wave < 2) {
                const int dir = wave, lane = lanec, tok = b * MSEQ + t0 + (dir ? 63 - lane : lane);
                const float gv = GB[(size_t)tok * 32 + dir * 8 + h], bv = GB[(size_t)tok * 32 + 16 + dir * 8 + h];
                float x = gv;
#pragma unroll
                for (int o = 1; o < 64; o <<= 1) { const float t = __shfl_up(x, o); if (lane >= o) x += t; }
                const float gl = __shfl(x, 63);
                LAS float* sc = (LAS float*)(L + PSC);
                sc[dir * 64 + lane] = x; sc[128 + dir * 64 + lane] = bv;
                float* rs = (float*)(REC + (size_t)((((b * 8 + h) * 2 + dir) * 128) + n) * REC_BYTES + 12288);
                const float eg = __expf(x);
                rs[lane] = bv * eg; rs[64 + lane] = bv; rs[128 + lane] = eg; rs[192 + lane] = __expf(gl - x);
            }
            __syncthreads();
            {
                const int m = wave >> 2, mt = wave & 3;
                const LAS float* sc = (const LAS float*)(L + PSC);
                bf16x8 afr[4];
#pragma unroll
                for (int ks = 0; ks < 4; ++ks) afr[ks] = *(const LAS bf16x8*)(L + (m ? PQT : PKT) + (16 * mt + l16) * 272 + (32 * ks + 8 * g4) * 2);
                LAS float* Lb0 = (LAS float*)(L + PLB + (c4 * 2) * PLB_STRIDE); LAS float* Lb1 = (LAS float*)(L + PLB + (c4 * 2 + 1) * PLB_STRIDE);
                bf16* im0 = (bf16*)(REC + (size_t)((((b * 8 + h) * 2 + 0) * 128) + n) * REC_BYTES + 6144);
                bf16* im1 = (bf16*)(REC + (size_t)((((b * 8 + h) * 2 + 1) * 128) + n) * REC_BYTES + 6144);
#pragma unroll
                for (int nt = 0; nt < 4; ++nt) {
                    pg8::f32x4 acc = {0.f, 0.f, 0.f, 0.f};
#pragma unroll
                    for (int ks = 0; ks < 4; ++ks) { const bf16x8 bfr = *(const LAS bf16x8*)(L + PKT + (16 * nt + l16) * 272 + (32 * ks + 8 * g4) * 2);
                        acc = __builtin_amdgcn_mfma_f32_16x16x32_bf16(afr[ks], bfr, acc, 0, 0, 0); }
                    const int j = 16 * nt + l16, jp = 63 - j;
                    const float gc0j = sc[j], gc1jp = sc[64 + jp];
#pragma unroll
                    for (int r = 0; r < 4; ++r) { const int i = 16 * mt + 4 * g4 + r, ip = 63 - i; const float val = acc[r];
                        if (m == 0) {
                            if (i > j) Lb0[tri_off(i) + j] = sc[128 + i] * val * __expf(sc[i] - gc0j);
                            else if (i < j) Lb1[tri_off(ip) + jp] = sc[192 + ip] * val * __expf(sc[64 + ip] - gc1jp);
                        } else {
                            if ((j >> 5) <= (i >> 5)) im0[img_off(i, j) >> 1] = (bf16)f2bf(i >= j ? val * __expf(sc[i] - gc0j) : 0.f);
                            if ((jp >> 5) <= (ip >> 5)) im1[img_off(ip, jp) >> 1] = (bf16)f2bf(ip >= jp ? val * __expf(sc[64 + ip] - gc1jp) : 0.f);
                        }
                    }
                }
            }
        }
        __syncthreads();
        {
            const int c4 = wave >> 1, dir = wave & 1, n = n0 + c4, lane = opq(tid) & 63;
            LAS float* Lb = (LAS float*)(L + PLB + wave * PLB_STRIDE);
            float x[64];
#pragma unroll
            for (int i = 0; i < 64; ++i) {
                const int off = tri_off(i);
                int dep = 0; if (i > 0) asm volatile("" : "+v"(dep) : "v"(x[i > 0 ? i - 1 : 0]));
                const LAS float* Lr = Lb + off + dep;
                float a0 = (i == lane) ? 1.f : 0.f, a1 = 0.f, a2 = 0.f, a3 = 0.f;
#pragma unroll
                for (int jb = 0; jb < (i + 3) / 4; ++jb) { const f32x4 l4 = *(const LAS f32x4*)(Lr + 4 * jb);
                    if (4 * jb + 0 < i) a0 -= l4.x * x[4 * jb + 0];
                    if (4 * jb + 1 < i) a1 -= l4.y * x[4 * jb + 1];
                    if (4 * jb + 2 < i) a2 -= l4.z * x[4 * jb + 2];
                    if (4 * jb + 3 < i) a3 -= l4.w * x[4 * jb + 3]; }
                x[i] = (a0 + a1) + (a2 + a3);
            }
            LDS_WAIT(); asm volatile("" ::: "memory");
            LAS bf16* stg = (LAS bf16*)Lb;
            const int cc = lane & 31, gq = (cc & 15) >> 2, jj = (cc & 3) + ((cc >> 4) << 2), ksl = lane >> 5;
#pragma unroll
            for (int i = 0; i < 64; ++i) { const int mt = i >> 4;
                if (ksl <= (i >> 5)) { const int f = mt < 2 ? mt : 2 + (mt - 2) * 2 + ksl; stg[f * 512 + (gq * 16 + (i & 15)) * 8 + jj] = (bf16)f2bf(x[i]); } }
            LDS_WAIT(); asm volatile("" ::: "memory");
            unsigned char* rec = REC + (size_t)((((b * 8 + h) * 2 + dir) * 128) + n) * REC_BYTES;
#pragma unroll
            for (int it = 0; it < 6; ++it) *(GAS v4u*)(rec + (it * 64 + lane) * 16) = *(const LAS v4u*)((LAS unsigned char*)Lb + (it * 64 + lane) * 16);
            LDS_WAIT(); asm volatile("" ::: "memory");
        }
        __syncthreads();
    }
}

constexpr int SKT = 0, SQT = 16384, SVT = 32768, SRC = 36864, SBUF = 50176;
__device__ __forceinline__ int kswz(int row) { return ((row & 7) << 1) | ((row >> 3) & 1); }
__device__ __forceinline__ void gdn_scan(Ctx& F) {
    PHASE_IDS(F);
    if (blockIdx.x >= 128) return;
    const int xcd = blockIdx.x & 7, idx = blockIdx.x >> 3, sp = idx & 3, sq = xcd * 4 + (idx >> 2), b = sq >> 4, h = (sq >> 1) & 7, dir = sq & 1;
    LAS unsigned char* L = F.lds + RING_OFF;
    const bf16* QKV = (const bf16*)(F.ws + WS_QKVPRE) + (size_t)b * MSEQ * 3072 + h * 128;
    const unsigned char* REC = F.ws + WS_REC + (size_t)(((b * 8 + h) * 2 + dir) * 128) * REC_BYTES;
    bf16* od = (bf16*)(F.ws + (dir ? WS_OB : WS_OF)) + (size_t)b * MSEQ * MD + h * 128 + sp * 32;
    const int g4 = lane >> 4, l16 = lane & 15;
    auto issue = [&](int s) {
        const int n = dir ? 127 - s : s, t0 = n * 64; LAS unsigned char* buf = L + (s & 1) * SBUF;
#pragma unroll
        for (int k = 0; k < 7; ++k) { const int d = wave + 8 * k; if (d >= 49) break;
            const void* src;
            if (d < 32) { const int dd = d & 15, row = 4 * dd + g4, G = l16 ^ kswz(row), tok = t0 + (dir ? 63 - row : row);
                src = QKV + (size_t)tok * 3072 + (d < 16 ? 1024 : 0) + G * 8; }
            else if (d < 36) { const int row = 16 * (d - 32) + (lane >> 2), tok = t0 + (dir ? 63 - row : row);
                src = QKV + (size_t)tok * 3072 + 2048 + sp * 32 + (lane & 3) * 8; }
            else src = REC + (size_t)n * REC_BYTES + (d - 36) * 1024 + lane * 16;
            const int loff = d < 16 ? SKT + d * 1024 : (d < 32 ? SQT + (d - 16) * 1024 : (d < 36 ? SVT + (d - 32) * 1024 : SRC + (d - 36) * 1024));
            __builtin_amdgcn_global_load_lds((const unsigned*)src, (LAS unsigned*)(buf + loff), 16, 0, 0); }
    };
    pg8::f32x4 S[8]; bf16x8 Sb[4];
#pragma unroll
    for (int i = 0; i < 8; ++i) S[i] = (pg8::f32x4){0.f, 0.f, 0.f, 0.f};
#pragma unroll
    for (int i = 0; i < 4; ++i) Sb[i] = (bf16x8){0, 0, 0, 0, 0, 0, 0, 0};
    issue(0);
    asm volatile("s_waitcnt vmcnt(0)" ::: "memory"); __syncthreads();
    for (int s = 0; s < 128; ++s) {
        if (s + 1 < 128) issue(s + 1);
        if (wave < 2) {
            const LAS unsigned char* buf = L + (s & 1) * SBUF; const int n = dir ? 127 - s : s, t0 = n * 64;
            const LAS float* scl = (const LAS float*)(buf + SRC + 12288);
            auto rowfrag = [&](int tile_off, int mt, int ks) -> bf16x8 {
                const int row = 16 * mt + l16, sw = kswz(row);
                const LAS unsigned char* rp = buf + tile_off + row * 256 + (g4 & 1) * 8;
                const u32x2_t lo = *(const LAS u32x2_t*)(rp + (((4 * ks + (g4 >> 1)) ^ sw) << 4)), hi = *(const LAS u32x2_t*)(rp + (((4 * ks + 2 + (g4 >> 1)) ^ sw) << 4));
                v4u t; t.x = lo.x; t.y = lo.y; t.z = hi.x; t.w = hi.y; return __builtin_bit_cast(bf16x8, t); };
            auto pack = [&](const pg8::f32x4& a, const pg8::f32x4& c) -> bf16x8 { v4u t; t.x = pk2(a[0], a[1]); t.y = pk2(a[2], a[3]); t.z = pk2(c[0], c[1]); t.w = pk2(c[2], c[3]); return __builtin_bit_cast(bf16x8, t); };
            pg8::f32x4 P[4], O[4];
#pragma unroll
            for (int mt = 0; mt < 4; ++mt) { P[mt] = (pg8::f32x4){0.f, 0.f, 0.f, 0.f}; O[mt] = (pg8::f32x4){0.f, 0.f, 0.f, 0.f};
#pragma unroll
                for (int ks = 0; ks < 4; ++ks) { P[mt] = __builtin_amdgcn_mfma_f32_16x16x32_bf16(rowfrag(SKT, mt, ks), Sb[ks], P[mt], 0, 0, 0);
                                                 O[mt] = __builtin_amdgcn_mfma_f32_16x16x32_bf16(rowfrag(SQT, mt, ks), Sb[ks], O[mt], 0, 0, 0); } }
            pg8::f32x4 R[4];
#pragma unroll
            for (int mt = 0; mt < 4; ++mt) { const f32x4 cv = *(const LAS f32x4*)(scl + 16 * mt + 4 * g4), bv = *(const LAS f32x4*)(scl + 64 + 16 * mt + 4 * g4);
#pragma unroll
                for (int r = 0; r < 4; ++r) { const int row = 16 * mt + 4 * g4 + r;
                    const float vv = bf2f(*(const LAS unsigned short*)(buf + SVT + row * 64 + (16 * wave + l16) * 2));
                    R[mt][r] = bv[r] * vv - cv[r] * P[mt][r]; } }
            bf16x8 rb[2] = {pack(R[0], R[1]), pack(R[2], R[3])};
            pg8::f32x4 VN[4];
#pragma unroll
            for (int mt = 0; mt < 4; ++mt) { VN[mt] = (pg8::f32x4){0.f, 0.f, 0.f, 0.f};
#pragma unroll
                for (int ks = 0; ks <= (mt >> 1); ++ks) { const int f = mt < 2 ? mt : 2 + (mt - 2) * 2 + ks;
                    VN[mt] = __builtin_amdgcn_mfma_f32_16x16x32_bf16(*(const LAS bf16x8*)(buf + SRC + f * 1024 + lane * 16), rb[ks], VN[mt], 0, 0, 0); } }
            bf16x8 vb[2] = {pack(VN[0], VN[1]), pack(VN[2], VN[3])};
            pg8::f32x4 VS[4];
#pragma unroll
            for (int mt = 0; mt < 4; ++mt) { const f32x4 egv = *(const LAS f32x4*)(scl + 128 + 16 * mt + 4 * g4), ekv = *(const LAS f32x4*)(scl + 192 + 16 * mt + 4 * g4);
                pg8::f32x4 o;
#pragma unroll
                for (int r = 0; r < 4; ++r) { o[r] = egv[r] * O[mt][r]; VS[mt][r] = ekv[r] * VN[mt][r]; }
#pragma unroll
                for (int ks = 0; ks <= (mt >> 1); ++ks) { const int f = mt < 2 ? mt : 2 + (mt - 2) * 2 + ks;
                    o = __builtin_amdgcn_mfma_f32_16x16x32_bf16(*(const LAS bf16x8*)(buf + SRC + 6144 + f * 1024 + lane * 16), vb[ks], o, 0, 0, 0); }
#pragma unroll
                for (int r = 0; r < 4; ++r) { const int row = 16 * mt + 4 * g4 + r, tok = t0 + (dir ? 63 - row : row);
                    od[(size_t)tok * MD + 16 * wave + l16] = (bf16)f2bf(o[r]); } }
            bf16x8 vsb[2] = {pack(VS[0], VS[1]), pack(VS[2], VS[3])};
            const float dd = scl[128 + 63];
#pragma unroll
            for (int dt = 0; dt < 8; ++dt) {
                pg8::f32x4 acc = S[dt] * dd;
#pragma unroll
                for (int ks = 0; ks < 2; ++ks) {
                    const int q = l16 >> 2, p = l16 & 3, r0 = 32 * ks + 4 * g4 + q, r1 = r0 + 16;
                    const LAS unsigned char* a0 = buf + SKT + r0 * 256 + (((2 * dt + (p >> 1)) ^ kswz(r0)) << 4) + (p & 1) * 8;
                    const LAS unsigned char* a1 = buf + SKT + r1 * 256 + (((2 * dt + (p >> 1)) ^ kswz(r1)) << 4) + (p & 1) * 8;
                    const v4i16_t lo = __builtin_amdgcn_ds_read_tr16_b64_v4i16((LAS v4i16_t*)a0), hi = __builtin_amdgcn_ds_read_tr16_b64_v4i16((LAS v4i16_t*)a1);
                    const bf16x8 afr = {lo[0], lo[1], lo[2], lo[3], hi[0], hi[1], hi[2], hi[3]};
                    acc = __builtin_amdgcn_mfma_f32_16x16x32_bf16(afr, vsb[ks], acc, 0, 0, 0);
                }
                S[dt] = acc;
            }
#pragma unroll
            for (int ks = 0; ks < 4; ++ks) Sb[ks] = pack(S[2 * ks], S[2 * ks + 1]);
        }
        asm volatile("s_waitcnt vmcnt(0)" ::: "memory"); __syncthreads();
    }
}
struct Args { const float* in[21]; float* out; unsigned char* ws; int mask, li; };
__global__ void __launch_bounds__(NTHR, 2) mk_fwd(Args args) {
    extern __shared__ __attribute__((aligned(16))) unsigned char lds[];
    Ctx F;
    F.lds = (LAS unsigned char*)lds;
    F.MISC = (volatile LAS unsigned*)(F.lds + MISC_OFF);
    F.G = gridDim.x; { const int bx = blockIdx.x; const int vcu = (F.G % 8 == 0) ? (bx % 8) * (F.G / 8) + bx / 8 : bx; F.gwb = vcu * NWAVES; F.NGW = F.G * NWAVES; }
    F.wv = __builtin_amdgcn_readfirstlane((int)(threadIdx.x >> 6));
    F.ws = args.ws; F.out = args.out; F.ctl = (gu32*)(args.ws + WS_CTL);
#pragma unroll
    for (int i = 0; i < 21; ++i) F.in[i] = args.in[i];
    for (int u = threadIdx.x; u < (LDS_BYTES - LDSCTL_OFF) / 4; u += NTHR) ((LAS unsigned*)(F.lds + LDSCTL_OFF))[u] = 0u;
    __syncthreads();
    XcdBarrier bar = xcd_barrier_post((unsigned*)(F.ctl + CW_BAR) + args.li * XCD_BAR_WORDS, F.MISC + 8);
    const int mask = args.mask;
    const LAS int* tab = (const LAS int*)(F.lds + MOETAB_OFF);
#pragma unroll 1
    for (int ph = 0; ph < 17; ++ph) {
        if (!((mask >> ph) & 1)) continue;
        const int layer = ph >= 13 ? 1 : 0;
        int sel = ph >= 13 ? ph - 9 : (ph == 12 ? 3 : ph);
        asm volatile("" : "+s"(sel));
        switch (sel) {
        case 0: p0_prologue(F); break;
        case 1: {
            pg8::Gemm g{(const pg8::bf16_t*)(F.ws + WS_XN), (const pg8::bf16_t*)(F.ws + WS_WQKV), MT, 1536, MD}; pg8::StaticOrder S; S.init(MT, 1536, F.G, (int)blockIdx.x);
            pg8::EpiQKV E{(pg8::bf16_t*)(F.ws + WS_Q), (pg8::bf16_t*)(F.ws + WS_K), (pg8::bf16_t*)(F.ws + WS_V), F.in[4], F.in[5], QSCALE};
            pg8::gemm_phase<pg8::EpiQKV, pg8::StaticOrder, true, true>(F.lds + RING_OFF, g, S, E, F.wv * 64 + lane_id());
        } break;
        case 2: attn_simple(F); break;
        case 3: {
            pg8::Gemm g{(const pg8::bf16_t*)(F.ws + (ph == 3 ? WS_AO : WS_ON)), (const pg8::bf16_t*)(F.ws + (ph == 3 ? WS_WAO : WS_WGO)), MT, MD, MD}; pg8::StaticOrder S; S.init(MT, MD, F.G, (int)blockIdx.x);
            pg8::EpiResF32 E{ph == 3 ? F.in[0] : F.out, F.out, MD};
            pg8::gemm_phase<pg8::EpiResF32, pg8::StaticOrder, true, true>(F.lds + RING_OFF, g, S, E, F.wv * 64 + lane_id());
            if (ph != 3) moe_convert(F, 1, F.gwb + F.wv, F.NGW);
        } break;
        case 4: p4_router(F, layer); break;
        case 5: {
            moe_tables(F, layer, 2);
            pg8::Gemm g{(const pg8::bf16_t*)(F.ws + WS_XN), (const pg8::bf16_t*)(F.ws + WS_WGU), MT, 512, MD};
            pg8::MoeOrder S{tab, 2, F.G, (int)blockIdx.x, (const int*)(F.ws + WS_LIST), (unsigned)(MD * 2)};
            pg8::EpiGateUp E{(pg8::bf16_t*)(F.ws + WS_H), (const float*)(F.ws + WS_GLIST), tab};
            pg8::gemm_phase<pg8::EpiGateUp, pg8::MoeOrder, true, true, true>(F.lds + RING_OFF, g, S, E, F.wv * 64 + lane_id());
        } break;
        case 6: {
            moe_tables(F, layer, 4);
            pg8::Gemm g{(const pg8::bf16_t*)(F.ws + WS_H), (const pg8::bf16_t*)(F.ws + WS_WD), 40960, 1024, 256};
            pg8::MoeOrder S{tab, 4, F.G, (int)blockIdx.x, (const int*)(F.ws + WS_LIST), 512u};
            pg8::EpiY E{(pg8::bf16_t*)(F.ws + WS_Y)};
            pg8::gemm_phase<pg8::EpiY, pg8::MoeOrder, true, true, false>(F.lds + RING_OFF, g, S, E, F.wv * 64 + lane_id());
        } break;
        case 7: moe_tables(F, layer, 4); if (layer == 0) p7_combine<true>(F); else p7_combine<false>(F); break;
        case 8: {
            pg8::Gemm g{(const pg8::bf16_t*)(F.ws + WS_XN), (const pg8::bf16_t*)(F.ws + WS_WGIN), MT, 4096, MD}; pg8::StaticOrder S; S.init(MT, 4096, F.G, (int)blockIdx.x);
            pg8::EpiGdnIn E{(pg8::bf16_t*)(F.ws + WS_QKVPRE), (pg8::bf16_t*)(F.ws + WS_Z), (pg8::bf16_t*)(F.ws + WS_HALO)};
            pg8::gemm_phase<pg8::EpiGdnIn, pg8::StaticOrder, true, true>(F.lds + RING_OFF, g, S, E, F.wv * 64 + lane_id());
        } break;
        case 9: gdn_prep(F); break;
        case 10: gdn_scan(F); break;
        default: gdn_gate(F); break;
        }
        if ((mask >> (ph + 1)) != 0) xcd_barrier(bar, F.wv == 0 && lane_id() == 0);
    }
}

extern "C" void kernel_launch(void* const* d_in, const int* in_sizes, int n_in, void* d_out, int out_size, void* d_ws, size_t ws_size, hipStream_t stream) {
    static int grid = 0;
    if (grid == 0) {
        int dev = 0, cus = 0;
        if (hipGetDevice(&dev) != hipSuccess || hipDeviceGetAttribute(&cus, hipDeviceAttributeMultiprocessorCount, dev) != hipSuccess) { fprintf(stderr, "kernel_launch: device query failed\n"); grid = -1; return; }
        if (hipFuncSetAttribute((const void*)mk_fwd, hipFuncAttributeMaxDynamicSharedMemorySize, LDS_BYTES) != hipSuccess) { fprintf(stderr, "kernel_launch: hipFuncSetAttribute failed\n"); grid = -1; return; }
        (void)hipGetLastError();
        grid = cus;
        if (ws_size < WS_END) { fprintf(stderr, "kernel_launch: workspace too small\n"); }
    }
    if (grid < 0) return;
    (void)hipMemsetAsync((char*)d_ws + WS_CTL, 0, CTL_ZERO_BYTES, stream);
    Args a{};
    for (int i = 0; i < 21; ++i) a.in[i] = (const float*)d_in[i];
    a.out = (float*)d_out; a.ws = (unsigned char*)d_ws; a.mask = 0x1ffff; a.li = 0;
    hipLaunchKernelGGL(mk_fwd, dim3(grid), dim3(NTHR), LDS_BYTES, stream, a);
}
```

```cpp
#include <hip/hip_runtime.h>
#include <cstdio>
#include <cstdint>
namespace pg8 {
#define PG8_LAS __attribute__((address_space(3)))
typedef unsigned short bf16_t;
typedef short bf16x8 __attribute__((ext_vector_type(8)));
typedef float f32x4 __attribute__((ext_vector_type(4)));
typedef unsigned u32x4 __attribute__((ext_vector_type(4)));
constexpr int BM = 256, BK = 64, HALF = 128, HTB = HALF * BK * 2  , STAGE_BYTES = 8 * HTB, NXCD = 8, WGM = 8;

__host__ __device__ __forceinline__ int lds_byte(int r, int c) { const int st = (r >> 4) * 2 + (c >> 5), rr = r & 15, cc = c & 31, ob = rr * 64 + cc * 2; return st * 1024 + (ob ^ (((ob >> 9) & 1) << 5)); }
__host__ __device__ __forceinline__ void stage_rc(int b, int& R, int& C) { const int st = b / 1024, sb = b % 1024, swz = sb ^ (((sb >> 9) & 1) << 5); R = (st >> 1) * 16 + swz / 64; C = (st & 1) * 32 + (swz % 64) / 2; }
__host__ __device__ __forceinline__ int perm32(int rho) { const int n = rho >> 4, i = rho & 15; return 8 * (i >> 2) + 4 * n + (i & 3); }

struct Unit { int pm, pn; };
struct Gemm { const bf16_t* A; const bf16_t* Bt; int M, N, K; };

struct StaticOrder {
    int nM, nN, nwg, G, c;
    __host__ __device__ void init(int M, int N, int G_, int c_) { nM = M / BM; nN = N / BM; nwg = nM * nN; G = G_; c = c_; }
    __host__ __device__ bool next(int i, Unit& u) const {
        const long L = (long)i * G + c; if (L >= nwg) return false;
        int wgid = (int)L; { const int q = nwg / NXCD, r = nwg % NXCD, xcd = wgid % NXCD, off = wgid / NXCD; wgid = (xcd < r ? xcd * (q + 1) : r * (q + 1) + (xcd - r) * q) + off; }
        const int nig = WGM * nN, gid = wgid / nig, fm = gid * WGM, gsz = (nM - fm) < WGM ? (nM - fm) : WGM;
        u.pm = fm + ((wgid % nig) % gsz); u.pn = (wgid % nig) / gsz; return true;
    }
    __device__ __forceinline__ void a_ready(const Unit&) const {}
    __device__ __forceinline__ void done(const Unit&) const {}
};

__device__ __forceinline__ unsigned cvt_pk_bf16(float lo, float hi) { unsigned r; asm volatile("v_cvt_pk_bf16_f32 %0, %1, %2" : "=v"(r) : "v"(lo), "v"(hi)); return r; }
typedef unsigned u32x4 __attribute__((ext_vector_type(4)));
struct EpiQKV {
    static constexpr bool PERM = true, AFTER_DRAIN = false;
    bf16_t *Q, *K, *V; const float *qg, *kg; float qscale;
    __device__ __forceinline__ void operator()(const f32x4 (&acc)[2][2][4][2], const Unit& u, int wr, int wc, int fr, int fq) const {
        const int row0 = u.pm * BM + wr * 64 + fr;
        bf16_t* dst; int ld; const float* gain; float sc; bool norm;
        if (u.pn < 4) { dst = Q + (u.pn * 4 + wc) * 64; ld = 1024; gain = qg; sc = qscale; norm = true; }
        else if (u.pn == 4) { dst = K + wc * 64; ld = 256; gain = kg; sc = 1.f; norm = true; }
        else { dst = V + wc * 64; ld = 256; gain = qg; sc = 1.f; norm = false; }
        f32x4 gv[2][2];
#pragma unroll
        for (int bj = 0; bj < 2; ++bj)
#pragma unroll
            for (int n = 0; n < 2; ++n) { const f32x4 g4 = *(const f32x4*)(gain + 32 * bj + 8 * fq + 4 * n); gv[bj][n] = norm ? g4 * sc : (f32x4){1.f, 1.f, 1.f, 1.f}; }
#pragma unroll
        for (int ai = 0; ai < 2; ++ai)
#pragma unroll
            for (int m = 0; m < 4; ++m) {
                float ss = 0.f;
#pragma unroll
                for (int bj = 0; bj < 2; ++bj)
#pragma unroll
                    for (int n = 0; n < 2; ++n) { const f32x4 x = acc[ai][bj][m][n]; ss += (x[0] * x[0] + x[1] * x[1]) + (x[2] * x[2] + x[3] * x[3]); }
                ss += __shfl_xor(ss, 16); ss += __shfl_xor(ss, 32);
                const float rs = norm ? rsqrtf(ss * (1.0f / 64.0f) + 1e-6f) : 1.f;
                bf16_t* rowp = dst + (size_t)(row0 + ai * HALF + m * 16) * ld + 8 * fq;
#pragma unroll
                for (int bj = 0; bj < 2; ++bj) { const f32x4 v0 = acc[ai][bj][m][0] * rs * gv[bj][0], v1 = acc[ai][bj][m][1] * rs * gv[bj][1];
                    u32x4 w; w.x = cvt_pk_bf16(v0[0], v0[1]); w.y = cvt_pk_bf16(v0[2], v0[3]); w.z = cvt_pk_bf16(v1[0], v1[1]); w.w = cvt_pk_bf16(v1[2], v1[3]);
                    *(u32x4*)(rowp + 32 * bj) = w; }
            }
    }
};
struct EpiResF32 {
    static constexpr bool PERM = false, AFTER_DRAIN = false;
    const float* base; float* out; int ldc;
    __device__ __forceinline__ void operator()(const f32x4 (&acc)[2][2][4][2], const Unit& u, int wr, int wc, int fr, int fq) const {
        const int row0 = u.pm * BM + wr * 64 + fr, col0 = u.pn * BM + wc * 32 + 4 * fq;
#pragma unroll
        for (int ai = 0; ai < 2; ++ai)
#pragma unroll
            for (int m = 0; m < 4; ++m) { const size_t off = (size_t)(row0 + ai * HALF + m * 16) * ldc + col0;
#pragma unroll
                for (int bj = 0; bj < 2; ++bj)
#pragma unroll
                    for (int n = 0; n < 2; ++n) { const size_t o = off + bj * HALF + n * 16; const f32x4 b = *(const f32x4*)(base + o); *(f32x4*)(out + o) = b + acc[ai][bj][m][n]; } }
    }
};

constexpr int MOE_CAP = 16384;
struct MoeOrder {
    const PG8_LAS int* tab; int npn, G, c; const int* list; unsigned rowbytes;
    __device__ __forceinline__ bool next(int i, Unit& u) const {
        const int L = i * G + c; if (L >= tab[65 + 32]) return false;
        int e = 0;
        for (int j = 1; j < 32; ++j) e = (L >= tab[65 + j]) ? j : e;
        const int local = L - tab[65 + e], mt = local / npn, pnl = local - mt * npn;
        u.pm = (tab[32 + e] >> 8) + mt; u.pn = e * npn + pnl; return true;
    }
    __device__ __forceinline__ unsigned rowoff(const Unit& u, int r) const {
        const int e = u.pn >> 1, idx = u.pm * 256 - tab[32 + e] + r;
        const int tok = idx < tab[e] ? list[e * MOE_CAP + idx] : 0;
        return (unsigned)tok * rowbytes;
    }
    __device__ __forceinline__ void a_ready(const Unit&) const {}
    __device__ __forceinline__ void done(const Unit&) const {}
};
struct EpiGateUp {
    static constexpr bool PERM = true, AFTER_DRAIN = false;
    bf16_t* H; const float* glist; const PG8_LAS int* tab;
    __device__ __forceinline__ void operator()(const f32x4 (&acc)[2][2][4][2], const Unit& u, int wr, int wc, int fr, int fq) const {
        const int e = u.pn >> 1, pnl = u.pn & 1, row0 = u.pm * BM + wr * 64 + fr, li0 = row0 - tab[32 + e], cnt = tab[e];
#pragma unroll
        for (int ai = 0; ai < 2; ++ai)
#pragma unroll
            for (int m = 0; m < 4; ++m) { const int li = li0 + ai * HALF + m * 16; const float gw = li < cnt ? glist[e * MOE_CAP + li] : 0.f;
                f32x4 h[2];
#pragma unroll
                for (int n = 0; n < 2; ++n)
#pragma unroll
                    for (int i = 0; i < 4; ++i) { const float g = acc[ai][0][m][n][i], uu = acc[ai][1][m][n][i]; h[n][i] = g * __builtin_amdgcn_rcpf(1.f + __expf(-g)) * uu * gw; }
                u32x4 w; w.x = cvt_pk_bf16(h[0][0], h[0][1]); w.y = cvt_pk_bf16(h[0][2], h[0][3]); w.z = cvt_pk_bf16(h[1][0], h[1][1]); w.w = cvt_pk_bf16(h[1][2], h[1][3]);
                *(u32x4*)(H + (size_t)(row0 + ai * HALF + m * 16) * 256 + 128 * pnl + 32 * wc + 8 * fq) = w; }
    }
};
struct EpiY {
    static constexpr bool PERM = true, AFTER_DRAIN = false;
    bf16_t* Y;
    __device__ __forceinline__ void operator()(const f32x4 (&acc)[2][2][4][2], const Unit& u, int wr, int wc, int fr, int fq) const {
        const int row0 = u.pm * BM + wr * 64 + fr, col0 = (u.pn & 3) * BM + wc * 32 + 8 * fq;
#pragma unroll
        for (int ai = 0; ai < 2; ++ai)
#pragma unroll
            for (int m = 0; m < 4; ++m) { bf16_t* rowp = Y + (size_t)(row0 + ai * HALF + m * 16) * 1024 + col0;
#pragma unroll
                for (int bj = 0; bj < 2; ++bj) { const f32x4 v0 = acc[ai][bj][m][0], v1 = acc[ai][bj][m][1];
                    u32x4 w; w.x = cvt_pk_bf16(v0[0], v0[1]); w.y = cvt_pk_bf16(v0[2], v0[3]); w.z = cvt_pk_bf16(v1[0], v1[1]); w.w = cvt_pk_bf16(v1[2], v1[3]);
                    *(u32x4*)(rowp + bj * HALF) = w; } }
    }
};

struct EpiGdnIn {
    static constexpr bool PERM = true, AFTER_DRAIN = false;
    bf16_t *QKV, *Z, *HALO;
    __device__ __forceinline__ void operator()(const f32x4 (&acc)[2][2][4][2], const Unit& u, int wr, int wc, int fr, int fq) const {
        const int row0 = u.pm * BM + wr * 64 + fr;
        bf16_t* dst; int ld;
        if (u.pn < 12) { dst = QKV + u.pn * BM; ld = 3072; } else { dst = Z + (u.pn - 12) * BM; ld = 1024; }
        dst += wc * 32 + 8 * fq;
#pragma unroll
        for (int ai = 0; ai < 2; ++ai)
#pragma unroll
            for (int m = 0; m < 4; ++m) { bf16_t* rowp = dst + (size_t)(row0 + ai * HALF + m * 16) * ld;
#pragma unroll
                for (int bj = 0; bj < 2; ++bj) { const f32x4 v0 = acc[ai][bj][m][0], v1 = acc[ai][bj][m][1];
                    u32x4 w; w.x = cvt_pk_bf16(v0[0], v0[1]); w.y = cvt_pk_bf16(v0[2], v0[3]); w.z = cvt_pk_bf16(v1[0], v1[1]); w.w = cvt_pk_bf16(v1[2], v1[3]);
                    *(u32x4*)(rowp + bj * HALF) = w;
                    if (u.pn < 12 && ((m == 0 && fr == 0) || (m == 3 && fr >= 14))) { const int row = row0 + ai * HALF + m * 16, slot = m == 0 ? 0 : fr - 13;
                        *(u32x4*)(HALO + ((size_t)(row >> 6) * 3 + slot) * 3072 + u.pn * BM + wc * 32 + 8 * fq + bj * HALF) = w; } } }
    }
};
template <class Epi, class Sched, bool ALIGN_EPI = false, bool SP2 = false, bool GATHER = false>
__device__ __forceinline__ void gemm_phase(PG8_LAS unsigned char* lds, const Gemm g, const Sched& S, const Epi& E, int tid_in) {
    int tid_ = tid_in; asm volatile("" : "+v"(tid_));
    const int tid = tid_, wid = __builtin_amdgcn_readfirstlane(tid >> 6), lane = tid & 63, wr = wid >> 2, wc = wid & 3, fr = lane & 15, fq = lane >> 4;
    int K_ = g.K; asm volatile("" : "+s"(K_));
    const int K = K_, nt = K / BK;
    unsigned voffA[2], voffB[2];
#pragma unroll
    for (int i = 0; i < 2; ++i) { int R, C; stage_rc(tid * 16 + i * 8192, R, C); const int Rb = Epi::PERM ? ((R & ~31) + perm32(R & 31)) : R;
        voffA[i] = (unsigned)(R * K + C) * 2u; voffB[i] = (unsigned)(Rb * K + C) * 2u; }
    const size_t kstep = (size_t)(BK * 2);
    const size_t hstep = (size_t)HALF * K * 2; const size_t hstepA = GATHER ? (size_t)0 : hstep;
    const size_t tstep = 2 * hstep;
    const unsigned ldsw = (unsigned)wid * 1024u;
    const int aoff = lds_byte(wr * 64 + fr, fq * 8), boff = lds_byte(wc * 32 + fr, fq * 8);
#define PG8_SA(b, h) (((b) * 2 + (h)) * HTB)
#define PG8_SB(b, h) ((4 + (b) * 2 + (h)) * HTB)
#define PG8_STAGE(bufoff, gbase, voff) do { _Pragma("unroll") for (int _i = 0; _i < 2; ++_i) \
        __builtin_amdgcn_global_load_lds((const unsigned*)((const char*)(gbase) + (voff)[_i]), (PG8_LAS unsigned*)(lds + (bufoff) + ldsw + _i * 8192), 16, 0, 0); } while (0)
#define PG8_LDA(dst, b, h) do { _Pragma("unroll") for (int m = 0; m < 4; ++m) _Pragma("unroll") for (int k = 0; k < 2; ++k) dst[m][k] = *(const PG8_LAS bf16x8*)(lds + PG8_SA(b, h) + aoff + m * 2048 + k * 1024); } while (0)
#define PG8_LDB(dst, b, h) do { _Pragma("unroll") for (int n = 0; n < 2; ++n) _Pragma("unroll") for (int k = 0; k < 2; ++k) dst[n][k] = *(const PG8_LAS bf16x8*)(lds + PG8_SB(b, h) + boff + n * 2048 + k * 1024); } while (0)
#define PG8_MMA(ai, bj, At, Bt) do { __builtin_amdgcn_s_setprio(1); _Pragma("unroll") for (int m = 0; m < 4; ++m) _Pragma("unroll") for (int n = 0; n < 2; ++n) _Pragma("unroll") for (int k = 0; k < 2; ++k) \
        acc[ai][bj][m][n] = __builtin_amdgcn_mfma_f32_16x16x32_bf16(Bt[n][k], At[m][k], acc[ai][bj][m][n], 0, 0, 0); __builtin_amdgcn_s_setprio(0); } while (0)
#define PG8_WAIT_V(n) asm volatile("s_waitcnt vmcnt(" #n ")" ::: "memory")
#define PG8_WAIT_L(n) asm volatile("s_waitcnt lgkmcnt(" #n ")" ::: "memory")
#define PG8_BAR __builtin_amdgcn_s_barrier()
#define PG8_SCHED __builtin_amdgcn_sched_barrier(0)
    Unit cur, nxt; int ui = 0;
    if (!S.next(0, cur)) return;
    f32x4 acc[2][2][4][2];
#pragma unroll
    for (int a = 0; a < 2; ++a)
#pragma unroll
        for (int b = 0; b < 2; ++b)
#pragma unroll
            for (int m = 0; m < 4; ++m)
#pragma unroll
                for (int n = 0; n < 2; ++n) acc[a][b][m][n] = (f32x4){0.f, 0.f, 0.f, 0.f};
    bf16x8 At[4][2], B0[2][2], B1[2][2];
    const char* cA = (const char*)g.A + (GATHER ? (size_t)0 : (size_t)cur.pm * tstep);
    unsigned vC[2][2];
    PG8_LAS unsigned* vNl = (PG8_LAS unsigned*)(lds + STAGE_BYTES + 2048) + tid;
#pragma unroll
    for (int h = 0; h < 2; ++h)
#pragma unroll
        for (int i = 0; i < 2; ++i) { if constexpr (GATHER) { int R, C; stage_rc(tid * 16 + i * 8192, R, C); vC[h][i] = S.rowoff(cur, 128 * h + R) + (unsigned)C * 2u; vNl[(h * 2 + i) * 512] = vC[h][i]; } else vC[h][i] = voffA[i]; }
    const char* cB = (const char*)g.Bt + (size_t)cur.pn * tstep;
    S.a_ready(cur);
    if constexpr (SP2) {
        PG8_STAGE(PG8_SB(0, 0), cB, voffB); PG8_STAGE(PG8_SB(0, 1), cB + hstep, voffB); PG8_STAGE(PG8_SA(0, 0), cA, vC[0]); PG8_STAGE(PG8_SA(0, 1), cA + hstepA, vC[1]);
        if (wr == 1) PG8_BAR;
        PG8_WAIT_V(2); PG8_BAR;
        PG8_STAGE(PG8_SB(1, 0), cB + kstep, voffB); PG8_STAGE(PG8_SA(1, 0), cA + kstep, vC[0]); PG8_STAGE(PG8_SB(1, 1), cB + hstep + kstep, voffB);
        PG8_WAIT_V(6); PG8_BAR;
    } else {
        PG8_STAGE(PG8_SB(0, 0), cB, voffB); PG8_STAGE(PG8_SA(0, 0), cA, vC[0]); PG8_STAGE(PG8_SB(0, 1), cB + hstep, voffB); PG8_STAGE(PG8_SA(0, 1), cA + hstepA, vC[1]);
        if (wr == 1) PG8_BAR;
        PG8_WAIT_V(4); PG8_BAR;
        PG8_STAGE(PG8_SB(1, 0), cB + kstep, voffB); PG8_STAGE(PG8_SA(1, 0), cA + kstep, vC[0]); PG8_STAGE(PG8_SB(1, 1), cB + hstep + kstep, voffB);
        PG8_WAIT_V(6); PG8_BAR;
    }
    for (;;) {
        const bool has_next = S.next(ui + 1, nxt);
        const char* nA = (has_next && !GATHER) ? (const char*)g.A + (size_t)nxt.pm * tstep : cA;
        if constexpr (GATHER) { if (has_next) {
#pragma unroll
            for (int h = 0; h < 2; ++h)
#pragma unroll
                for (int i = 0; i < 2; ++i) { int R, C; stage_rc(tid * 16 + i * 8192, R, C); vNl[(h * 2 + i) * 512] = S.rowoff(nxt, 128 * h + R) + (unsigned)C * 2u; } } }
        const char* nB = has_next ? (const char*)g.Bt + (size_t)nxt.pn * tstep : cB;
        for (int t = 0; t < nt; t += 2) {
            const bool last = (t == nt - 2);
            const char* a1 = cA + (size_t)(t + 1) * kstep;
            const char* a2 = last ? nA : cA + (size_t)(t + 2) * kstep; const char* b2 = last ? nB : cB + (size_t)(t + 2) * kstep;
            const char* a3 = a2 + kstep; const char* b3 = b2 + kstep;
            unsigned v2[2][2];
#pragma unroll
            for (int h = 0; h < 2; ++h)
#pragma unroll
                for (int i = 0; i < 2; ++i) { if constexpr (GATHER) { v2[h][i] = vC[h][i]; if (last) v2[h][i] = vNl[(h * 2 + i) * 512]; } else v2[h][i] = vC[h][i]; }
            if (last && has_next) S.a_ready(nxt);
            if constexpr (SP2) {
            PG8_LDB(B0, 0, 0); PG8_LDB(B1, 0, 1); PG8_SCHED; PG8_LDA(At, 0, 0); PG8_STAGE(PG8_SA(1, 1), a1 + hstepA, vC[1]);
            PG8_WAIT_V(8); PG8_WAIT_L(0); PG8_BAR; PG8_MMA(0, 0, At, B0); PG8_MMA(0, 1, At, B1); PG8_BAR; PG8_SCHED;
            PG8_LDA(At, 0, 1); PG8_STAGE(PG8_SB(0, 0), b2, voffB); PG8_STAGE(PG8_SB(0, 1), b2 + hstep, voffB); PG8_STAGE(PG8_SA(0, 0), a2, v2[0]);
            PG8_WAIT_V(8); PG8_WAIT_L(0); PG8_BAR; PG8_MMA(1, 0, At, B0); PG8_MMA(1, 1, At, B1); PG8_BAR; PG8_SCHED;
            PG8_LDB(B0, 1, 0); PG8_LDB(B1, 1, 1); PG8_SCHED; PG8_LDA(At, 1, 0); PG8_STAGE(PG8_SA(0, 1), a2 + hstepA, v2[1]);
            PG8_WAIT_V(8); PG8_WAIT_L(0); PG8_BAR; PG8_MMA(0, 0, At, B0); PG8_MMA(0, 1, At, B1); PG8_BAR; PG8_SCHED;
            PG8_LDA(At, 1, 1); PG8_STAGE(PG8_SB(1, 0), b3, voffB); PG8_STAGE(PG8_SB(1, 1), b3 + hstep, voffB); PG8_STAGE(PG8_SA(1, 0), a3, v2[0]);
            PG8_WAIT_V(8); PG8_WAIT_L(0); PG8_BAR; PG8_MMA(1, 0, At, B0); PG8_MMA(1, 1, At, B1); PG8_BAR; PG8_SCHED;
            } else {
            PG8_LDB(B0, 0, 0); PG8_SCHED; PG8_LDA(At, 0, 0); PG8_STAGE(PG8_SA(1, 1), a1 + hstepA, vC[1]);
            PG8_WAIT_L(8); PG8_BAR; PG8_WAIT_L(0); PG8_MMA(0, 0, At, B0); PG8_BAR; PG8_SCHED;
            PG8_LDB(B1, 0, 1); PG8_STAGE(PG8_SB(0, 0), b2, voffB);
            PG8_BAR; PG8_WAIT_L(0); PG8_MMA(0, 1, At, B1); PG8_BAR;
            PG8_LDA(At, 0, 1); PG8_STAGE(PG8_SA(0, 0), a2, v2[0]);
            PG8_BAR; PG8_WAIT_L(0); PG8_MMA(1, 0, At, B0); PG8_BAR; PG8_SCHED;
            PG8_STAGE(PG8_SB(0, 1), b2 + hstep, voffB);
            PG8_WAIT_V(6); PG8_BAR; PG8_MMA(1, 1, At, B1); PG8_BAR;
            PG8_LDB(B0, 1, 0); PG8_SCHED; PG8_LDA(At, 1, 0); PG8_STAGE(PG8_SA(0, 1), a2 + hstepA, v2[1]);
            PG8_WAIT_L(8); PG8_BAR; PG8_WAIT_L(0); PG8_MMA(0, 0, At, B0); PG8_BAR; PG8_SCHED;
            PG8_LDB(B1, 1, 1); PG8_STAGE(PG8_SB(1, 0), b3, voffB);
            PG8_BAR; PG8_WAIT_L(0); PG8_MMA(0, 1, At, B1); PG8_BAR;
            PG8_LDA(At, 1, 1); PG8_STAGE(PG8_SA(1, 0), a3, v2[0]);
            PG8_BAR; PG8_WAIT_L(0); PG8_MMA(1, 0, At, B0); PG8_BAR; PG8_SCHED;
            PG8_STAGE(PG8_SB(1, 1), b3 + hstep, voffB);
            PG8_WAIT_V(6); PG8_BAR; PG8_MMA(1, 1, At, B1); PG8_BAR;
            }
        }
        if constexpr (ALIGN_EPI) { if (wr == 0) PG8_BAR; }
        if constexpr (!Epi::AFTER_DRAIN) { E(acc, cur, wr, wc, fr, fq); S.done(cur); }
        if (!has_next) break;
#pragma unroll
        for (int a = 0; a < 2; ++a)
#pragma unroll
            for (int b = 0; b < 2; ++b)
#pragma unroll
                for (int m = 0; m < 4; ++m)
#pragma unroll
                    for (int n = 0; n < 2; ++n) acc[a][b][m][n] = (f32x4){0.f, 0.f, 0.f, 0.f};
        cur = nxt; cA = nA; cB = nB; ++ui;
#pragma unroll
        for (int h = 0; h < 2; ++h)
#pragma unroll
            for (int i = 0; i < 2; ++i) { if constexpr (GATHER) vC[h][i] = vNl[(h * 2 + i) * 512]; }
        if constexpr (ALIGN_EPI) { if (wr == 1) PG8_BAR; }
    }
    PG8_WAIT_V(0);
    if constexpr (!ALIGN_EPI) { if (wr == 0) PG8_BAR; }
    PG8_BAR;
    if constexpr (Epi::AFTER_DRAIN) { E.fused(acc, cur, wr, wc, fr, fq, lds, wid, lane); S.done(cur); }
#undef PG8_SA
#undef PG8_SB
#undef PG8_STAGE
#undef PG8_LDA
#undef PG8_LDB
#undef PG8_MMA
#undef PG8_WAIT_V
#undef PG8_WAIT_L
#undef PG8_BAR
#undef PG8_SCHED
}
}
#define GAS __attribute__((address_space(1)))
#define LAS __attribute__((address_space(3)))
typedef unsigned short bf16;
typedef unsigned v4u __attribute__((ext_vector_type(4)));
typedef float f32x4 __attribute__((ext_vector_type(4)));
typedef short bf16x8 __attribute__((ext_vector_type(8)));
typedef GAS unsigned gu32;
typedef GAS unsigned long long gu64;
#define RLX_AGENT __ATOMIC_RELAXED, __HIP_MEMORY_SCOPE_AGENT
#define LDS_WAIT() asm volatile("s_waitcnt lgkmcnt(0)" ::: "memory")
#define VM_WAIT() asm volatile("s_waitcnt vmcnt(0)" ::: "memory")
__device__ __forceinline__ unsigned long long rt() { return __builtin_amdgcn_s_memrealtime(); }
__device__ __forceinline__ unsigned f2bf(float f) { unsigned u = __builtin_bit_cast(unsigned, f); return (u + 0x7fffu + ((u >> 16) & 1u)) >> 16; }
__device__ __forceinline__ unsigned pk2(float lo, float hi) { return f2bf(lo) | (f2bf(hi) << 16); }

#define XB_TMO      128
#define XB_XCNT(j)  (256  + 64 * (j))
#define XB_XSUB(j)  (1280 + 64 * (j))
#define XB_XGEN(j)  (2304 + 64 * (j))
#define XB_TOP      3328
#define XB_TOPGEN   3392
#define XCD_BAR_WORDS 3456
#define XB_SPIN_CAP (1u << 18)

__device__ __forceinline__ unsigned xb_ld(unsigned* p)              { return __hip_atomic_load(p, __ATOMIC_RELAXED, __HIP_MEMORY_SCOPE_AGENT); }
__device__ __forceinline__ unsigned xb_add(unsigned* p, unsigned v) { return __hip_atomic_fetch_add(p, v, __ATOMIC_RELAXED, __HIP_MEMORY_SCOPE_AGENT); }
__device__ __forceinline__ unsigned xb_xcc_id() { return (unsigned)__builtin_amdgcn_s_getreg((3 << 11) | 20) & 0xFu; }
#define XB_SPIN(cond, bar) do { unsigned _sp = 0; while (cond) { __builtin_amdgcn_s_sleep(1); \
    if ((++_sp & 255u) == 0u) { if (xb_ld(&(bar)[XB_TMO])) break; if (_sp > XB_SPIN_CAP) { atomicAdd(&(bar)[XB_TMO], 1u); break; } } } } while (0)

struct XcdBarrier {
    unsigned* bar; unsigned x;
    volatile LAS unsigned* st;
};

__device__ __forceinline__ XcdBarrier xcd_barrier_post(unsigned* bar, volatile LAS unsigned* st) {
    XcdBarrier b; b.bar = bar; b.x = xb_xcc_id(); b.st = st;
    if (threadIdx.x == 0) (void)xb_add(&bar[XB_XCNT(b.x)], 1u);
    return b;
}
__device__ __forceinline__ void xcd_barrier_complete(unsigned* bar, unsigned x, unsigned& nloc, unsigned& nx) {
    const unsigned G = gridDim.x * gridDim.y * gridDim.z;
    unsigned sum, cnt, mine, sp = 0u;
    for (;;) {
        sum = 0u; cnt = 0u; mine = 0u;
#pragma unroll
        for (unsigned j = 0; j < 16; ++j) { const unsigned c = xb_ld(&bar[XB_XCNT(j)]); sum += c; cnt += (c > 0u) ? 1u : 0u; mine = (j == x) ? c : mine; }
        if (sum == G) break;
        __builtin_amdgcn_s_sleep(1);
        if ((++sp & 255u) == 0u) { if (xb_ld(&bar[XB_TMO])) break; if (sp > XB_SPIN_CAP) { atomicAdd(&bar[XB_TMO], 1u); break; } }
    }
    nloc = mine > 0u ? mine : 1u; nx = cnt > 0u ? cnt : 1u;
}

__device__ __forceinline__ void xcd_barrier(const XcdBarrier& b, bool is_t0) {
    asm volatile("s_waitcnt vmcnt(0)" ::: "memory");
    __syncthreads();
    if (is_t0) {
        unsigned* bar = b.bar;
        __builtin_amdgcn_s_waitcnt(0);
        unsigned nloc = b.st[0], nx = b.st[1];
        if (nloc == 0u) { xcd_barrier_complete(bar, b.x, nloc, nx); b.st[0] = nloc; b.st[1] = nx; }
        const unsigned old = xb_add(&bar[XB_XSUB(b.x)], 1u);
        const unsigned gen = old / nloc;
        if (old + 1u == (gen + 1u) * nloc) {
            __builtin_amdgcn_fence(__ATOMIC_RELEASE, "agent");
            asm volatile("s_waitcnt vmcnt(0)" ::: "memory");
            const unsigned og = xb_add(&bar[XB_TOP], 1u);
            const unsigned tg = og / nx;
            if (og + 1u == (tg + 1u) * nx) xb_add(&bar[XB_TOPGEN], 1u);
            else XB_SPIN(xb_ld(&bar[XB_TOPGEN]) == tg, bar);
            __builtin_amdgcn_fence(__ATOMIC_ACQUIRE, "agent");
            xb_add(&bar[XB_XGEN(b.x)], 1u);
            asm volatile("s_waitcnt vmcnt(0)" ::: "memory");
        } else {
            XB_SPIN(xb_ld(&bar[XB_XGEN(b.x)]) == gen, bar);
            __builtin_amdgcn_fence(__ATOMIC_ACQUIRE, "agent");
            asm volatile("s_waitcnt vmcnt(0)" ::: "memory");
        }
    }
    __syncthreads();
}
constexpr int NWAVES = 8, NTHR = NWAVES * 64;
constexpr int MB = 2, MSEQ = 8192, MD = 1024, MT = MB * MSEQ;
constexpr float LOG2E = 1.4426950408889634f;
constexpr float QSCALE = 0.125f * LOG2E;
constexpr size_t MiB = 1u << 20;
constexpr size_t WS_CTL = 0, CTL_ZERO_BYTES = 1 * MiB;
constexpr size_t WS_WQKV = 1 * MiB;
constexpr size_t WS_WAO = 4 * MiB;
constexpr size_t WS_WGIN = 6 * MiB;
constexpr size_t WS_WAB = 14 * MiB;
constexpr size_t WS_WGO = 15 * MiB;
constexpr size_t WS_WR = 17 * MiB;
constexpr size_t WS_WGU = 18 * MiB;
constexpr size_t WS_WD = 50 * MiB;
constexpr size_t WS_XN = 66 * MiB;
constexpr size_t WS_LIST = 98 * MiB;
constexpr size_t WS_GLIST = 100 * MiB;
constexpr size_t WS_TOKSLOT = 102 * MiB;
constexpr size_t WS_H = 104 * MiB;
constexpr size_t WS_Y = 124 * MiB;
constexpr size_t WS_Q = 98 * MiB;
constexpr size_t WS_K = 130 * MiB;
constexpr size_t WS_V = 138 * MiB;
constexpr size_t WS_AO = 146 * MiB;
constexpr size_t WS_QKVPRE = 98 * MiB;
constexpr size_t WS_Z = 194 * MiB;
constexpr size_t WS_GB = 226 * MiB;
constexpr size_t WS_OF = 66 * MiB;
constexpr size_t WS_OB = 18 * MiB;
constexpr size_t WS_ON = 98 * MiB;
constexpr size_t WS_END = 285 * MiB;
constexpr int CW_TMO = 0, CW_CODE = 1, CW_BAR = 4096, CW_CNT = 16384;
constexpr int RING_OFF = 0, RING_BYTES = 131072, LDSCTL_OFF = RING_BYTES, MISC_OFF = LDSCTL_OFF + 320, MOETAB_OFF = LDSCTL_OFF + 1024, LDS_BYTES = 147456;

__device__ __forceinline__ float bf2f(unsigned short v) { return __uint_as_float((unsigned)v << 16); }
__device__ __forceinline__ float wsum(float v) {
#pragma unroll
    for (int o = 1; o < 64; o <<= 1) v += __shfl_xor(v, o);
    return v;
}
__device__ __forceinline__ float wmax(float v) {
#pragma unroll
    for (int o = 1; o < 64; o <<= 1) v = fmaxf(v, __shfl_xor(v, o));
    return v;
}
__device__ __forceinline__ float silu_f(float x) { return x * __builtin_amdgcn_rcpf(1.f + __expf(-x)); }
typedef unsigned u32x2_t __attribute__((ext_vector_type(2)));
__device__ __forceinline__ int opq(int x) { asm volatile("" : "+v"(x)); return x; }
__device__ __forceinline__ int lane_id() { return (int)__builtin_amdgcn_mbcnt_hi(~0u, __builtin_amdgcn_mbcnt_lo(~0u, 0u)); }
__device__ __forceinline__ int opqs(int x) { asm volatile("" : "+s"(x)); return x; }
#define PHASE_IDS(F) const int wave = opqs((F).wv), lane = opq(lane_id()), tid = wave * 64 + lane, gw = (F).gwb + wave; (void)tid; (void)lane; (void)wave; (void)gw

struct Ctx {
    LAS unsigned char* lds;
    volatile LAS unsigned* MISC;
    gu32* ctl;
    int G, gwb, NGW, wv;
    const float* in[21];
    float* out; unsigned char* ws;
};

template <class RowMap>
__device__ __forceinline__ void transpose_item(const float* W, int ldw, int K, bf16* WT, RowMap rm, LAS float* scr, int kb, int nb, int lane) {
    const int k0 = 64 * kb, n0 = 32 * nb;
#pragma unroll 8
    for (int i = 0; i < 32; ++i) { const int kk = 2 * i + (lane >> 5); scr[kk * 33 + (lane & 31)] = W[(size_t)(k0 + kk) * ldw + n0 + (lane & 31)]; }
    LDS_WAIT(); asm volatile("" ::: "memory");
    const int c = lane & 7;
#pragma unroll
    for (int j = 0; j < 4; ++j) { const int n = (lane >> 3) + 8 * j; const LAS float* s = scr + (8 * c) * 33 + n;
        v4u o; o.x = pk2(s[0 * 33], s[1 * 33]); o.y = pk2(s[2 * 33], s[3 * 33]); o.z = pk2(s[4 * 33], s[5 * 33]); o.w = pk2(s[6 * 33], s[7 * 33]);
        *(GAS v4u*)(WT + (size_t)rm(n0 + n) * K + k0 + 8 * c) = o; }
    LDS_WAIT(); asm volatile("" ::: "memory");
}
__device__ __forceinline__ void rms_row_to_bf16(const float* xrow, const float* g, bf16* orow, int lane) {
    const GAS f32x4* xr = (const GAS f32x4*)xrow + lane; const GAS f32x4* gr = (const GAS f32x4*)g + lane;
    f32x4 v[4]; float s = 0.f;
#pragma unroll
    for (int j = 0; j < 4; ++j) { v[j] = xr[64 * j]; s += (v[j].x * v[j].x + v[j].y * v[j].y) + (v[j].z * v[j].z + v[j].w * v[j].w); }
    const float rs = rsqrtf(wsum(s) * (1.f / MD) + 1e-6f);
    GAS unsigned long long* o8 = (GAS unsigned long long*)orow + lane;
#pragma unroll
    for (int j = 0; j < 4; ++j) { const f32x4 gg = gr[64 * j]; o8[64 * j] = (unsigned long long)pk2(v[j].x * rs * gg.x, v[j].y * rs * gg.y) | ((unsigned long long)pk2(v[j].z * rs * gg.z, v[j].w * rs * gg.w) << 32); }
}
__device__ __forceinline__ int qkv_rowmap(int c) { const int cl = c & 255; return (c & ~255) + ((cl >> 5) & 1) * 128 + (cl >> 6) * 32 + (cl & 31); }

__device__ __forceinline__ void moe_convert(Ctx& F, int layer, int widx, int wcnt) {
    PHASE_IDS(F);
    LAS float* scr = (LAS float*)(F.lds + RING_OFF + wave * 16384);
    const float* Wg = F.in[18] + (size_t)layer * 32 * MD * 256; const float* Wu = F.in[19] + (size_t)layer * 32 * MD * 256; const float* Wd = F.in[20] + (size_t)layer * 32 * 256 * MD;
    bf16* WGU = (bf16*)(F.ws + WS_WGU); bf16* WD = (bf16*)(F.ws + WS_WD);
    for (int it = widx; it < 32 * 384; it += wcnt) {
        const int e = it / 384, r = it % 384;
        if (r < 128) transpose_item(Wg + (size_t)e * MD * 256, 256, MD, WGU, [e](int f) { return e * 512 + ((f >> 7) << 8) + (f & 127); }, scr, r >> 3, r & 7, lane);
        else if (r < 256) transpose_item(Wu + (size_t)e * MD * 256, 256, MD, WGU, [e](int f) { return e * 512 + ((f >> 7) << 8) + 128 + (f & 127); }, scr, (r - 128) >> 3, (r - 128) & 7, lane);
        else transpose_item(Wd + (size_t)e * 256 * MD, MD, 256, WD, [e](int d) { return e * 1024 + d; }, scr, (r - 256) >> 5, (r - 256) & 31, lane);
    }
}
__device__ __forceinline__ void p0_prologue(Ctx& F) {
    PHASE_IDS(F);
    LAS float* scr = (LAS float*)(F.lds + RING_OFF + wave * 16384);
    constexpr int I_QKV = 16 * 48, I_AO = 16 * 32, I_GIN = 16 * 128, I_AB = 16, I_GO = 16 * 32;
    for (int it = gw; it < I_QKV + I_AO + I_GIN + I_AB + I_GO; it += F.NGW) {
        int r = it;
        if (r < I_QKV) { transpose_item(F.in[3], 1536, MD, (bf16*)(F.ws + WS_WQKV), [](int c) { return qkv_rowmap(c); }, scr, r / 48, r % 48, lane); continue; } r -= I_QKV;
        if (r < I_AO) { transpose_item(F.in[7], MD, MD, (bf16*)(F.ws + WS_WAO), [](int c) { return c; }, scr, r >> 5, r & 31, lane); continue; } r -= I_AO;
        if (r < I_GIN) { transpose_item(F.in[8], 4128, MD, (bf16*)(F.ws + WS_WGIN), [](int c) { return c; }, scr, r >> 7, r & 127, lane); continue; } r -= I_GIN;
        if (r < I_AB) { transpose_item(F.in[8], 4128, MD, (bf16*)(F.ws + WS_WAB), [](int c) { return c - 4096; }, scr, r, 128, lane); continue; } r -= I_AB;
        transpose_item(F.in[13], MD, MD, (bf16*)(F.ws + WS_WGO), [](int c) { return c; }, scr, r >> 5, r & 31, lane);
    }
    for (int layer = 0; layer < 2; ++layer) { bf16* wr = (bf16*)(F.ws + WS_WR + (size_t)layer * 131072); const float* wg = F.in[14] + (size_t)layer * MD * 4; const float* we = F.in[16] + (size_t)layer * MD * 32;
        for (int idx = gw * 64 + lane; idx < 48 * MD; idx += F.NGW * 64) { const int r = idx >> 10, k = idx & 1023;
            const float v = r < 4 ? wg[k * 4 + r] : (r < 36 ? we[k * 32 + (r - 4)] : 0.f); wr[idx] = (bf16)f2bf(v); } }
    moe_convert(F, 0, gw, F.NGW);
    for (int m = gw; m < MT; m += F.NGW) rms_row_to_bf16(F.in[0] + (size_t)m * MD, F.in[1], (bf16*)(F.ws + WS_XN) + (size_t)m * MD, lane);
}

__device__ __forceinline__ void attn_simple(Ctx& F) {
    PHASE_IDS(F);
    LAS float* qs = (LAS float*)(F.lds + RING_OFF + wave * 2048);
    LAS float* ps = qs + 64;
    const bf16* Q = (const bf16*)(F.ws + WS_Q); const bf16* K = (const bf16*)(F.ws + WS_K); const bf16* V = (const bf16*)(F.ws + WS_V); bf16* AO = (bf16*)(F.ws + WS_AO);
    const float* sink = F.in[6];
    for (int item = gw; item < MT * 16; item += F.NGW) {
        const int t = item >> 4, h = item & 15, b = t / MSEQ, tt = t % MSEQ, g = h >> 2;
        const float slope2 = exp2f(-8.0f * (float)(h + 1) / 16.0f) * LOG2E;
        qs[lane] = bf2f(Q[(size_t)t * 1024 + h * 64 + lane]);
        LDS_WAIT(); asm volatile("" ::: "memory");
        float sc[5]; bool valid[5]; float mx = -INFINITY;
#pragma unroll
        for (int i = 0; i < 5; ++i) {
            const int j = lane + 64 * i, s = tt - 128 + j;
            valid[i] = (j <= 256) && s >= 0 && s < MSEQ; sc[i] = -INFINITY;
            if (valid[i]) {
                const GAS v4u* kp = (const GAS v4u*)(K + (size_t)(b * MSEQ + s) * 256 + g * 64);
                float dot = 0.f;
#pragma unroll
                for (int d = 0; d < 8; ++d) { const v4u kv = kp[d];
                    dot += qs[8 * d + 0] * __uint_as_float(kv.x << 16) + qs[8 * d + 1] * __uint_as_float(kv.x & 0xffff0000u) + qs[8 * d + 2] * __uint_as_float(kv.y << 16) + qs[8 * d + 3] * __uint_as_float(kv.y & 0xffff0000u)
                         + qs[8 * d + 4] * __uint_as_float(kv.z << 16) + qs[8 * d + 5] * __uint_as_float(kv.z & 0xffff0000u) + qs[8 * d + 6] * __uint_as_float(kv.w << 16) + qs[8 * d + 7] * __uint_as_float(kv.w & 0xffff0000u); }
                const int dist = tt > s ? tt - s : s - tt;
                sc[i] = dot - slope2 * (float)dist; mx = fmaxf(mx, sc[i]);
            }
        }
        const float sk2 = sink[h] * LOG2E;
        const float m = fmaxf(wmax(mx), sk2);
        float psum = 0.f;
#pragma unroll
        for (int i = 0; i < 5; ++i) { const float p = valid[i] ? exp2f(sc[i] - m) : 0.f; ps[i * 64 + lane] = p; psum += p; }
        const float denom = wsum(psum) + exp2f(sk2 - m);
        LDS_WAIT(); asm volatile("" ::: "memory");
        float acc = 0.f;
        for (int j = 0; j <= 256; ++j) { const int s = tt - 128 + j; if (s >= 0 && s < MSEQ) acc += ps[j] * bf2f(V[(size_t)(b * MSEQ + s) * 256 + g * 64 + lane]); }
        AO[(size_t)t * 1024 + h * 64 + lane] = (bf16)f2bf(acc / denom);
        LDS_WAIT(); asm volatile("" ::: "memory");
    }
}

__device__ __forceinline__ void moe_tables(Ctx& F, int layer, int npn) {
    PHASE_IDS(F);
    LAS int* tab = (LAS int*)(F.lds + MOETAB_OFF);
    __syncthreads();
    if (tid < 32) tab[tid] = (int)__hip_atomic_load(F.ctl + CW_CNT + 64 * layer + tid, RLX_AGENT);
    __syncthreads();
    if (tid == 0) { int seg = 0, ub = 0; for (int e = 0; e < 32; ++e) { tab[32 + e] = seg; tab[65 + e] = ub; const int mt = (tab[e] + 255) >> 8; seg += mt << 8; ub += mt * npn; } tab[64] = seg; tab[97] = ub; }
    __syncthreads();
}
__device__ __forceinline__ void wg_self_visible(Ctx& F) {
    PHASE_IDS(F);
    VM_WAIT(); __syncthreads();
    if (tid == 0) { __builtin_amdgcn_fence(__ATOMIC_ACQUIRE, "agent"); VM_WAIT(); }
    __syncthreads();
}
__device__ __forceinline__ void p4_router(Ctx& F, int layer) {
    PHASE_IDS(F);
    const float* X = F.out; const float* g = F.in[2] + (size_t)layer * MD; bf16* XN = (bf16*)(F.ws + WS_XN);
    const bf16* Wr = (const bf16*)(F.ws + WS_WR + (size_t)layer * 131072);
    const float* bg = F.in[15] + layer * 4; const float* be = F.in[17] + layer * 32;
    gu32* cnt = F.ctl + CW_CNT + 64 * layer;
    int* list = (int*)(F.ws + WS_LIST); float* glist = (float*)(F.ws + WS_GLIST); int* tokslot = (int*)(F.ws + WS_TOKSLOT);
    LAS float* lg = (LAS float*)(F.lds + RING_OFF);
    const int w = wave, fr = lane & 15, fq = lane >> 4;
    for (int rb = blockIdx.x; rb < MT / 64; rb += F.G) {
        const int row0 = rb * 64;
        for (int r = 0; r < 8; ++r) { const size_t row = (size_t)(row0 + 8 * w + r); rms_row_to_bf16(X + row * MD, g, XN + row * MD, lane); }
        wg_self_visible(F);
        if (w < 4) {
            pg8::f32x4 acc[3] = {{0.f, 0.f, 0.f, 0.f}, {0.f, 0.f, 0.f, 0.f}, {0.f, 0.f, 0.f, 0.f}};
            const bf16* arow = XN + (size_t)(row0 + 16 * w + fr) * MD + 8 * fq; const bf16* brow = Wr + (size_t)fr * MD + 8 * fq;
#pragma unroll 4
            for (int ks = 0; ks < 32; ++ks) {
                const bf16x8 a = *(const GAS bf16x8*)(arow + 32 * ks);
#pragma unroll
                for (int nt = 0; nt < 3; ++nt) { const bf16x8 b = *(const GAS bf16x8*)(brow + (size_t)nt * 16 * MD + 32 * ks); acc[nt] = __builtin_amdgcn_mfma_f32_16x16x32_bf16(b, a, acc[nt], 0, 0, 0); }
            }
#pragma unroll
            for (int nt = 0; nt < 3; ++nt)
#pragma unroll
                for (int r = 0; r < 4; ++r) lg[(16 * w + fr) * 49 + 16 * nt + 4 * fq + r] = acc[nt][r];
        }
        __syncthreads();
        if (tid < 64) {
            const LAS float* l = lg + tid * 49; const int tok = row0 + tid;
            float gl[4]; for (int i = 0; i < 4; ++i) gl[i] = l[i] + bg[i];
            int gi = 0; float gm = gl[0];
            for (int i = 1; i < 4; ++i) if (gl[i] > gm) { gm = gl[i]; gi = i; }
            float gs = 0.f; for (int i = 0; i < 4; ++i) gs += __expf(gl[i] - gm);
            const float gprob = 1.f / gs;
            int e1 = 0, e2 = -1; float m1 = -INFINITY, m2 = -INFINITY;
            for (int i = 0; i < 8; ++i) { const float v = l[4 + gi * 8 + i] + be[gi * 8 + i]; if (v > m1) { m2 = m1; e2 = e1; m1 = v; e1 = i; } else if (v > m2) { m2 = v; e2 = i; } }
            const float p2 = __expf(m2 - m1), inv = 1.f / (1.f + p2);
            const int x1 = gi * 8 + e1, x2 = gi * 8 + e2;
            const unsigned pos1 = __hip_atomic_fetch_add(cnt + x1, 1u, RLX_AGENT), pos2 = __hip_atomic_fetch_add(cnt + x2, 1u, RLX_AGENT);
            list[x1 * 16384 + pos1] = tok; glist[x1 * 16384 + pos1] = gprob * inv;
            list[x2 * 16384 + pos2] = tok; glist[x2 * 16384 + pos2] = gprob * p2 * inv;
            tokslot[tok * 2] = (x1 << 16) | (int)pos1; tokslot[tok * 2 + 1] = (x2 << 16) | (int)pos2;
        }
        __syncthreads();
    }
}
template <bool NEXT>
__device__ __forceinline__ void p7_combine(Ctx& F) {
    PHASE_IDS(F);
    const LAS int* tab = (const LAS int*)(F.lds + MOETAB_OFF);
    const int* tokslot = (const int*)(F.ws + WS_TOKSLOT); const bf16* Y = (const bf16*)(F.ws + WS_Y); float* X = F.out;
    bf16* XN = (bf16*)(F.ws + WS_XN); const float* gn = F.in[1] + MD;
    const int w = wave, fr = lane & 15, fq = lane >> 4;
    for (int rb = blockIdx.x; rb < MT / 64; rb += F.G) {
        const int row0 = rb * 64;
        for (int r = 0; r < 8; ++r) {
            const int t = row0 + 8 * w + r;
            const int s0 = tokslot[t * 2], s1 = tokslot[t * 2 + 1];
            const size_t y0 = (size_t)(tab[32 + (s0 >> 16)] + (s0 & 0xffff)), y1 = (size_t)(tab[32 + (s1 >> 16)] + (s1 & 0xffff));
            GAS f32x4* xr = (GAS f32x4*)(X + (size_t)t * MD) + lane;
            const GAS u32x2_t* a = (const GAS u32x2_t*)(Y + y0 * MD) + lane; const GAS u32x2_t* b = (const GAS u32x2_t*)(Y + y1 * MD) + lane;
            f32x4 v[4]; float ss = 0.f;
#pragma unroll
            for (int j = 0; j < 4; ++j) { v[j] = xr[64 * j]; const u32x2_t p = a[64 * j], q = b[64 * j];
                v[j].x += __uint_as_float(p.x << 16) + __uint_as_float(q.x << 16); v[j].y += __uint_as_float(p.x & 0xffff0000u) + __uint_as_float(q.x & 0xffff0000u);
                v[j].z += __uint_as_float(p.y << 16) + __uint_as_float(q.y << 16); v[j].w += __uint_as_float(p.y & 0xffff0000u) + __uint_as_float(q.y & 0xffff0000u);
                xr[64 * j] = v[j]; ss += (v[j].x * v[j].x + v[j].y * v[j].y) + (v[j].z * v[j].z + v[j].w * v[j].w); }
            if constexpr (NEXT) {
                const float rs = rsqrtf(wsum(ss) * (1.f / MD) + 1e-6f);
                GAS unsigned long long* o8 = (GAS unsigned long long*)(XN + (size_t)t * MD) + lane; const GAS f32x4* gr = (const GAS f32x4*)gn + lane;
#pragma unroll
                for (int j = 0; j < 4; ++j) { const f32x4 gg = gr[64 * j]; o8[64 * j] = (unsigned long long)pk2(v[j].x * rs * gg.x, v[j].y * rs * gg.y) | ((unsigned long long)pk2(v[j].z * rs * gg.z, v[j].w * rs * gg.w) << 32); }
            }
        }
        if constexpr (NEXT) {
            wg_self_visible(F);
            if (w < 4) {
                const bf16* Wab = (const bf16*)(F.ws + WS_WAB); float* GB = (float*)(F.ws + WS_GB);
                pg8::f32x4 acc[2] = {{0.f, 0.f, 0.f, 0.f}, {0.f, 0.f, 0.f, 0.f}};
                const bf16* arow = XN + (size_t)(row0 + 16 * w + fr) * MD + 8 * fq; const bf16* brow = Wab + (size_t)fr * MD + 8 * fq;
#pragma unroll 4
                for (int ks = 0; ks < 32; ++ks) {
                    const bf16x8 a = *(const GAS bf16x8*)(arow + 32 * ks);
#pragma unroll
                    for (int nt = 0; nt < 2; ++nt) { const bf16x8 b = *(const GAS bf16x8*)(brow + (size_t)nt * 16 * MD + 32 * ks); acc[nt] = __builtin_amdgcn_mfma_f32_16x16x32_bf16(b, a, acc[nt], 0, 0, 0); }
                }
                const int tok = row0 + 16 * w + fr;
#pragma unroll
                for (int r = 0; r < 4; ++r) { const int c = 4 * fq + r;
                    const float xx = acc[0][r] + F.in[11][c]; const float sp = fmaxf(xx, 0.f) + log1pf(__expf(-fabsf(xx)));
                    GB[(size_t)tok * 32 + c] = -__expf(F.in[10][c]) * sp;
                    GB[(size_t)tok * 32 + 16 + c] = 1.f / (1.f + __expf(-acc[1][r])); }
            }
        }
    }
}

__device__ __forceinline__ void gdn_scan_naive(Ctx& F) {
    PHASE_IDS(F);
    constexpr int TS = 16;
    const int sq = blockIdx.x, b = sq >> 4, h = (sq >> 1) & 7, dir = sq & 1, w = wave;
    LAS float* qs = (LAS float*)(F.lds + RING_OFF);
    LAS float* red = qs + 3 * TS * 128;
    const bf16* pre = (const bf16*)(F.ws + WS_QKVPRE) + (size_t)b * MSEQ * 3072;
    const float* GB = (const float*)(F.ws + WS_GB) + (size_t)b * MSEQ * 32;
    bf16* od = (bf16*)(F.ws + (dir ? WS_OB : WS_OF)) + (size_t)b * MSEQ * MD;
    const float* convw = F.in[9];
    const int wh = tid >> 7, j = tid & 127;
    float cw[4] = {0.f, 0.f, 0.f, 0.f};
    if (tid < 384) {
#pragma unroll
        for (int jj = 0; jj < 4; ++jj) cw[jj] = convw[jj * 3072 + wh * 1024 + h * 128 + j]; }
    LAS float* kspart = red + 2 * TS;
    LAS float* opart = kspart + 2 * 4 * 128;
    const int part = tid >> 7, jc = tid & 127;
    float St[32];
#pragma unroll
    for (int i = 0; i < 32; ++i) St[i] = 0.f;
    for (int tile = 0; tile < MSEQ / TS; ++tile) {
        __syncthreads();
        if (tid < 384) {
            for (int st = 0; st < TS; ++st) {
                const int n = tile * TS + st, t = dir ? MSEQ - 1 - n : n;
                float a = 0.f;
#pragma unroll
                for (int jj = 0; jj < 4; ++jj) { const int tt = t + jj - 2; if (tt >= 0 && tt < MSEQ) a += cw[jj] * bf2f(pre[(size_t)tt * 3072 + wh * 1024 + h * 128 + j]); }
                qs[(wh * TS + st) * 128 + j] = silu_f(a);
            }
        }
        __syncthreads();
        for (int rr = w; rr < 2 * TS; rr += NWAVES) { const int which = rr & 1, st = rr >> 1; const float a0 = qs[(which * TS + st) * 128 + lane], a1 = qs[(which * TS + st) * 128 + lane + 64];
            const float ss = wsum(a0 * a0 + a1 * a1); if (lane == 0) red[which * TS + st] = ss; }
        __syncthreads();
        for (int st = 0; st < TS; ++st) {
            const float qn = rsqrtf(red[st] + 1e-6f) * 0.08838834764831845f, kn = rsqrtf(red[TS + st] + 1e-6f);
            const int n = tile * TS + st, t = dir ? MSEQ - 1 - n : n;
            const float gg = GB[(size_t)t * 32 + dir * 8 + h], beta = GB[(size_t)t * 32 + 16 + dir * 8 + h];
            const float dec = __expf(gg);
            const LAS float* kk = qs + (TS + st) * 128 + 32 * part; const LAS float* qq = qs + st * 128 + 32 * part;
            float ksp = 0.f;
#pragma unroll
            for (int i = 0; i < 32; ++i) ksp += kk[i] * St[i];
            kspart[((st & 1) * 4 + part) * 128 + jc] = ksp;
            __syncthreads();
            const LAS float* kp = kspart + (st & 1) * 4 * 128 + jc;
            const float kS = ((kp[0] + kp[128]) + (kp[256] + kp[384])) * kn * dec;
            const float vn = beta * (qs[(2 * TS + st) * 128 + jc] - kS) * kn;
            float ov = 0.f;
#pragma unroll
            for (int i = 0; i < 32; ++i) { St[i] = dec * St[i] + kk[i] * vn; ov += qq[i] * St[i]; }
            opart[(st * 4 + part) * 128 + jc] = ov * qn;
        }
        __syncthreads();
        for (int e = tid; e < TS * 128; e += NTHR) { const int st = e >> 7, c = e & 127; const LAS float* op = opart + st * 4 * 128 + c;
            const int n = tile * TS + st, t = dir ? MSEQ - 1 - n : n;
            od[(size_t)t * MD + h * 128 + c] = (bf16)f2bf((op[0] + op[128]) + (op[256] + op[384])); }
    }
}
__device__ __forceinline__ void gdn_gate(Ctx& F) {
    PHASE_IDS(F);
    const unsigned* of = (const unsigned*)(F.ws + WS_OF); const unsigned* ob = (const unsigned*)(F.ws + WS_OB); const unsigned* z = (const unsigned*)(F.ws + WS_Z);
    unsigned* on = (unsigned*)(F.ws + WS_ON); const float* og = F.in[12];
    const float g0 = og[2 * lane], g1 = og[2 * lane + 1];
    for (int it = gw; it < MT * 8; it += F.NGW) {
        const size_t idx = (size_t)it * 64 + lane;
        const unsigned a = of[idx], bb = ob[idx], zz = z[idx];
        const float o0 = __uint_as_float(a << 16) + __uint_as_float(bb << 16), o1 = __uint_as_float(a & 0xffff0000u) + __uint_as_float(bb & 0xffff0000u);
        const float rs = rsqrtf(wsum(o0 * o0 + o1 * o1) * (1.f / 128.f) + 1e-6f);
        on[idx] = pk2(o0 * rs * g0 * silu_f(__uint_as_float(zz << 16)), o1 * rs * g1 * silu_f(__uint_as_float(zz & 0xffff0000u)));
    }
}

constexpr size_t WS_HALO = 228 * MiB;
constexpr size_t WS_REC = 233 * MiB;
constexpr int REC_BYTES = 13312;
constexpr int PQT = 0, PKT = 17408, PSC = 34816, PLB = 36864, PLB_STRIDE = 8704;
typedef short v4i16_t __attribute__((ext_vector_type(4)));

__device__ __forceinline__ int tri_off(int i) { const int a = (i - 1) >> 2, r = (i - 1) & 3; return 4 * (a + 1) * (2 * a + r); }
__device__ __forceinline__ int img_off(int i, int j) {
    const int mt = i >> 4, ks = j >> 5, f = mt < 2 ? mt : 2 + (mt - 2) * 2 + ks, cc = j & 31, g = (cc & 15) >> 2, jj = (cc & 3) + ((cc >> 4) << 2);
    return f * 1024 + ((g * 16 + (i & 15)) * 8 + jj) * 2;
}
__device__ __forceinline__ void gdn_prep(Ctx& F) {
    PHASE_IDS(F);
    LAS unsigned char* L = F.lds + RING_OFF;
    bf16* QKV = (bf16*)(F.ws + WS_QKVPRE); const bf16* HALO = (const bf16*)(F.ws + WS_HALO); const float* GB = (const float*)(F.ws + WS_GB);
    unsigned char* REC = F.ws + WS_REC; const float* convw = F.in[9];
    for (int batch = blockIdx.x; batch < 512; batch += F.G) {
        const int b = batch >> 8, h = (batch >> 5) & 7, n0 = (batch & 31) * 4;
#pragma unroll 1
        for (int c4 = 0; c4 < 4; ++c4) {
            const int n = n0 + c4, t0 = n * 64;
            const int tidc = opq(tid), lanec = tidc & 63, g4 = lanec >> 4, l16 = lanec & 15;
            const int rg = tidc / 48, rem = tidc - 48 * rg, which = rem >> 4, c16 = rem & 15;
            const int col = which * 1024 + h * 128 + c16 * 8;
            v4u in[11];
            if (tidc < 384) {
#pragma unroll
                for (int ri = 0; ri < 11; ++ri) { const int lr = 8 * rg - 2 + ri; const bf16* src = nullptr;
                    if (lr >= 0 && lr < 64) src = QKV + ((size_t)(b * MSEQ + t0 + lr) * 3072 + col);
                    else if (lr < 0) { if (n > 0) src = HALO + ((size_t)((b * 128 + n - 1) * 3 + (lr + 3)) * 3072 + col); }
                    else { if (n < 127) src = HALO + ((size_t)((b * 128 + n + 1) * 3) * 3072 + col); }
                    in[ri] = src ? *(const GAS v4u*)src : (v4u){0u, 0u, 0u, 0u}; }
            }
            __syncthreads();
            if (tidc < 384) {
                float cw[4][8];
#pragma unroll
                for (int jj = 0; jj < 4; ++jj) { const GAS f32x4* p = (const GAS f32x4*)(convw + jj * 3072 + col); const f32x4 a = p[0], bq = p[1];
                    cw[jj][0] = a.x; cw[jj][1] = a.y; cw[jj][2] = a.z; cw[jj][3] = a.w; cw[jj][4] = bq.x; cw[jj][5] = bq.y; cw[jj][6] = bq.z; cw[jj][7] = bq.w; }
#pragma unroll
                for (int r = 0; r < 8; ++r) {
                    float o[8];
#pragma unroll
                    for (int c = 0; c < 8; ++c) o[c] = 0.f;
#pragma unroll
                    for (int jj = 0; jj < 4; ++jj) { const v4u x = in[r + jj];
                        o[0] += cw[jj][0] * __uint_as_float(x.x << 16); o[1] += cw[jj][1] * __uint_as_float(x.x & 0xffff0000u);
                        o[2] += cw[jj][2] * __uint_as_float(x.y << 16); o[3] += cw[jj][3] * __uint_as_float(x.y & 0xffff0000u);
                        o[4] += cw[jj][4] * __uint_as_float(x.z << 16); o[5] += cw[jj][5] * __uint_as_float(x.z & 0xffff0000u);
                        o[6] += cw[jj][6] * __uint_as_float(x.w << 16); o[7] += cw[jj][7] * __uint_as_float(x.w & 0xffff0000u); }
                    float ss = 0.f;
#pragma unroll
                    for (int c = 0; c < 8; ++c) { o[c] = silu_f(o[c]); ss += o[c] * o[c]; }
                    ss += __shfl_xor(ss, 1); ss += __shfl_xor(ss, 2); ss += __shfl_xor(ss, 4); ss += __shfl_xor(ss, 8);
                    const float sc = which == 0 ? rsqrtf(ss + 1e-6f) * 0.08838834764831845f : (which == 1 ? rsqrtf(ss + 1e-6f) : 1.f);
                    v4u w; w.x = pk2(o[0] * sc, o[1] * sc); w.y = pk2(o[2] * sc, o[3] * sc); w.z = pk2(o[4] * sc, o[5] * sc); w.w = pk2(o[6] * sc, o[7] * sc);
                    const int lr = 8 * rg + r;
                    *(GAS v4u*)(QKV + ((size_t)(b * MSEQ + t0 + lr) * 3072 + col)) = w;
                    if (which < 2) *(LAS v4u*)(L + (which ? PKT : PQT) + lr * 272 + c16 * 16) = w;
                }
            }
            if (wave < 2) {
                const int dir = wave, lane = lanec, tok = b * MSEQ + t0 + (dir ? 63 - lane : lane);
                const float gv = GB[(size_t)tok * 32 + dir * 8 + h], bv = GB[(size_t)tok * 32 + 16 + dir * 8 + h];
                float x = gv;
#pragma unroll
                for (int o = 1; o < 64; o <<= 1) { const float t = __shfl_up(x, o); if (lane >= o) x += t; }
                const float gl = __shfl(x, 63);
                LAS float* sc = (LAS float*)(L + PSC);
                sc[dir * 64 + lane] = x; sc[128 + dir * 64 + lane] = bv;
                float* rs = (float*)(REC + (size_t)((((b * 8 + h) * 2 + dir) * 128) + n) * REC_BYTES + 12288);
                const float eg = __expf(x);
                rs[lane] = bv * eg; rs[64 + lane] = bv; rs[128 + lane] = eg; rs[192 + lane] = __expf(gl - x);
            }
            __syncthreads();
            {
                const int m = wave >> 2, mt = wave & 3;
                const LAS float* sc = (const LAS float*)(L + PSC);
                bf16x8 afr[4];
#pragma unroll
                for (int ks = 0; ks < 4; ++ks) afr[ks] = *(const LAS bf16x8*)(L + (m ? PQT : PKT) + (16 * mt + l16) * 272 + (32 * ks + 8 * g4) * 2);
                LAS float* Lb0 = (LAS float*)(L + PLB + (c4 * 2) * PLB_STRIDE); LAS float* Lb1 = (LAS float*)(L + PLB + (c4 * 2 + 1) * PLB_STRIDE);
                bf16* im0 = (bf16*)(REC + (size_t)((((b * 8 + h) * 2 + 0) * 128) + n) * REC_BYTES + 6144);
                bf16* im1 = (bf16*)(REC + (size_t)((((b * 8 + h) * 2 + 1) * 128) + n) * REC_BYTES + 6144);
#pragma unroll
                for (int nt = 0; nt < 4; ++nt) {
                    pg8::f32x4 acc = {0.f, 0.f, 0.f, 0.f};
#pragma unroll
                    for (int ks = 0; ks < 4; ++ks) { const bf16x8 bfr = *(const LAS bf16x8*)(L + PKT + (16 * nt + l16) * 272 + (32 * ks + 8 * g4) * 2);
                        acc = __builtin_amdgcn_mfma_f32_16x16x32_bf16(afr[ks], bfr, acc, 0, 0, 0); }
                    const int j = 16 * nt + l16, jp = 63 - j;
                    const float gc0j = sc[j], gc1jp = sc[64 + jp];
#pragma unroll
                    for (int r = 0; r < 4; ++r) { const int i = 16 * mt + 4 * g4 + r, ip = 63 - i; const float val = acc[r];
                        if (m == 0) {
                            if (i > j) Lb0[tri_off(i) + j] = sc[128 + i] * val * __expf(sc[i] - gc0j);
                            else if (i < j) Lb1[tri_off(ip) + jp] = sc[192 + ip] * val * __expf(sc[64 + ip] - gc1jp);
                        } else {
                            if ((j >> 5) <= (i >> 5)) im0[img_off(i, j) >> 1] = (bf16)f2bf(i >= j ? val * __expf(sc[i] - gc0j) : 0.f);
                            if ((jp >> 5) <= (ip >> 5)) im1[img_off(ip, jp) >> 1] = (bf16)f2bf(ip >= jp ? val * __expf(sc[64 + ip] - gc1jp) : 0.f);
                        }
                    }
                }
            }
        }
        __syncthreads();
        {
            const int c4 = wave >> 1, dir = wave & 1, n = n0 + c4, lane = opq(tid) & 63;
            LAS float* Lb = (LAS float*)(L + PLB + wave * PLB_STRIDE);
            float x[64];
#pragma unroll
            for (int i = 0; i < 64; ++i) {
                const int off = tri_off(i);
                int dep = 0; if (i > 0) asm volatile("" : "+v"(dep) : "v"(x[i > 0 ? i - 1 : 0]));
                const LAS float* Lr = Lb + off + dep;
                float a0 = (i == lane) ? 1.f : 0.f, a1 = 0.f, a2 = 0.f, a3 = 0.f;
#pragma unroll
                for (int jb = 0; jb < (i + 3) / 4; ++jb) { const f32x4 l4 = *(const LAS f32x4*)(Lr + 4 * jb);
                    if (4 * jb + 0 < i) a0 -= l4.x * x[4 * jb + 0];
                    if (4 * jb + 1 < i) a1 -= l4.y * x[4 * jb + 1];
                    if (4 * jb + 2 < i) a2 -= l4.z * x[4 * jb + 2];
                    if (4 * jb + 3 < i) a3 -= l4.w * x[4 * jb + 3]; }
                x[i] = (a0 + a1) + (a2 + a3);
            }
            LDS_WAIT(); asm volatile("" ::: "memory");
            LAS bf16* stg = (LAS bf16*)Lb;
            const int cc = lane & 31, gq = (cc & 15) >> 2, jj = (cc & 3) + ((cc >> 4) << 2), ksl = lane >> 5;
#pragma unroll
            for (int i = 0; i < 64; ++i) { const int mt = i >> 4;
                if (ksl <= (i >> 5)) { const int f = mt < 2 ? mt : 2 + (mt - 2) * 2 + ksl; stg[f * 512 + (gq * 16 + (i & 15)) * 8 + jj] = (bf16)f2bf(x[i]); } }
            LDS_WAIT(); asm volatile("" ::: "memory");
            unsigned char* rec = REC + (size_t)((((b * 8 + h) * 2 + dir) * 128) + n) * REC_BYTES;
#pragma unroll
            for (int it = 0; it < 6; ++it) *(GAS v4u*)(rec + (it * 64 + lane) * 16) = *(const LAS v4u*)((LAS unsigned char*)Lb + (it * 64 + lane) * 16);
            LDS_WAIT(); asm volatile("" ::: "memory");
        }
        __syncthreads();
    }
}

constexpr int SKT = 0, SQT = 16384, SVT = 32768, SRC = 36864, SBUF = 50176;
__device__ __forceinline__ int kswz(int row) { return ((row & 7) << 1) | ((row >> 3) & 1); }
__device__ __forceinline__ void gdn_scan(Ctx& F) {
    PHASE_IDS(F);
    if (blockIdx.x >= 128) return;
    const int xcd = blockIdx.x & 7, idx = blockIdx.x >> 3, sp = idx & 3, sq = xcd * 4 + (idx >> 2), b = sq >> 4, h = (sq >> 1) & 7, dir = sq & 1;
    LAS unsigned char* L = F.lds + RING_OFF;
    const bf16* QKV = (const bf16*)(F.ws + WS_QKVPRE) + (size_t)b * MSEQ * 3072 + h * 128;
    const unsigned char* REC = F.ws + WS_REC + (size_t)(((b * 8 + h) * 2 + dir) * 128) * REC_BYTES;
    bf16* od = (bf16*)(F.ws + (dir ? WS_OB : WS_OF)) + (size_t)b * MSEQ * MD + h * 128 + sp * 32;
    const int g4 = lane >> 4, l16 = lane & 15;
    auto issue = [&](int s) {
        const int n = dir ? 127 - s : s, t0 = n * 64; LAS unsigned char* buf = L + (s & 1) * SBUF;
#pragma unroll
        for (int k = 0; k < 7; ++k) { const int d = wave + 8 * k; if (d >= 49) break;
            const void* src;
            if (d < 32) { const int dd = d & 15, row = 4 * dd + g4, G = l16 ^ kswz(row), tok = t0 + (dir ? 63 - row : row);
                src = QKV + (size_t)tok * 3072 + (d < 16 ? 1024 : 0) + G * 8; }
            else if (d < 36) { const int row = 16 * (d - 32) + (lane >> 2), tok = t0 + (dir ? 63 - row : row);
                src = QKV + (size_t)tok * 3072 + 2048 + sp * 32 + (lane & 3) * 8; }
            else src = REC + (size_t)n * REC_BYTES + (d - 36) * 1024 + lane * 16;
            const int loff = d < 16 ? SKT + d * 1024 : (d < 32 ? SQT + (d - 16) * 1024 : (d < 36 ? SVT + (d - 32) * 1024 : SRC + (d - 36) * 1024));
            __builtin_amdgcn_global_load_lds((const unsigned*)src, (LAS unsigned*)(buf + loff), 16, 0, 0); }
    };
    pg8::f32x4 S[8]; bf16x8 Sb[4];
#pragma unroll
    for (int i = 0; i < 8; ++i) S[i] = (pg8::f32x4){0.f, 0.f, 0.f, 0.f};
#pragma unroll
    for (int i = 0; i < 4; ++i) Sb[i] = (bf16x8){0, 0, 0, 0, 0, 0, 0, 0};
    issue(0);
    asm volatile("s_waitcnt vmcnt(0)" ::: "memory"); __syncthreads();
    for (int s = 0; s < 128; ++s) {
        if (s + 1 < 128) issue(s + 1);
        if (wave < 2) {
            const LAS unsigned char* buf = L + (s & 1) * SBUF; const int n = dir ? 127 - s : s, t0 = n * 64;
            const LAS float* scl = (const LAS float*)(buf + SRC + 12288);
            auto rowfrag = [&](int tile_off, int mt, int ks) -> bf16x8 {
                const int row = 16 * mt + l16, sw = kswz(row);
                const LAS unsigned char* rp = buf + tile_off + row * 256 + (g4 & 1) * 8;
                const u32x2_t lo = *(const LAS u32x2_t*)(rp + (((4 * ks + (g4 >> 1)) ^ sw) << 4)), hi = *(const LAS u32x2_t*)(rp + (((4 * ks + 2 + (g4 >> 1)) ^ sw) << 4));
                v4u t; t.x = lo.x; t.y = lo.y; t.z = hi.x; t.w = hi.y; return __builtin_bit_cast(bf16x8, t); };
            auto pack = [&](const pg8::f32x4& a, const pg8::f32x4& c) -> bf16x8 { v4u t; t.x = pk2(a[0], a[1]); t.y = pk2(a[2], a[3]); t.z = pk2(c[0], c[1]); t.w = pk2(c[2], c[3]); return __builtin_bit_cast(bf16x8, t); };
            pg8::f32x4 P[4], O[4];
#pragma unroll
            for (int mt = 0; mt < 4; ++mt) { P[mt] = (pg8::f32x4){0.f, 0.f, 0.f, 0.f}; O[mt] = (pg8::f32x4){0.f, 0.f, 0.f, 0.f};
#pragma unroll
                for (int ks = 0; ks < 4; ++ks) { P[mt] = __builtin_amdgcn_mfma_f32_16x16x32_bf16(rowfrag(SKT, mt, ks), Sb[ks], P[mt], 0, 0, 0);
                                                 O[mt] = __builtin_amdgcn_mfma_f32_16x16x32_bf16(rowfrag(SQT, mt, ks), Sb[ks], O[mt], 0, 0, 0); } }
            pg8::f32x4 R[4];
#pragma unroll
            for (int mt = 0; mt < 4; ++mt) { const f32x4 cv = *(const LAS f32x4*)(scl + 16 * mt + 4 * g4), bv = *(const LAS f32x4*)(scl + 64 + 16 * mt + 4 * g4);
#pragma unroll
                for (int r = 0; r < 4; ++r) { const int row = 16 * mt + 4 * g4 + r;
                    const float vv = bf2f(*(const LAS unsigned short*)(buf + SVT + row * 64 + (16 * wave + l16) * 2));
                    R[mt][r] = bv[r] * vv - cv[r] * P[mt][r]; } }
            bf16x8 rb[2] = {pack(R[0], R[1]), pack(R[2], R[3])};
            pg8::f32x4 VN[4];
#pragma unroll
            for (int mt = 0; mt < 4; ++mt) { VN[mt] = (pg8::f32x4){0.f, 0.f, 0.f, 0.f};
#pragma unroll
                for (int ks = 0; ks <= (mt >> 1); ++ks) { const int f = mt < 2 ? mt : 2 + (mt - 2) * 2 + ks;
                    VN[mt] = __builtin_amdgcn_mfma_f32_16x16x32_bf16(*(const LAS bf16x8*)(buf + SRC + f * 1024 + lane * 16), rb[ks], VN[mt], 0, 0, 0); } }
            bf16x8 vb[2] = {pack(VN[0], VN[1]), pack(VN[2], VN[3])};
            pg8::f32x4 VS[4];
#pragma unroll
            for (int mt = 0; mt < 4; ++mt) { const f32x4 egv = *(const LAS f32x4*)(scl + 128 + 16 * mt + 4 * g4), ekv = *(const LAS f32x4*)(scl + 192 + 16 * mt + 4 * g4);
                pg8::f32x4 o;
#pragma unroll
                for (int r = 0; r < 4; ++r) { o[r] = egv[r] * O[mt][r]; VS[mt][r] = ekv[r] * VN[mt][r]; }
#pragma unroll
                for (int ks = 0; ks <= (mt >> 1); ++ks) { const int f = mt < 2 ? mt : 2 + (mt - 2) * 2 + ks;
                    o = __builtin_amdgcn_mfma_f32_16x16x32_bf16(*(const LAS bf16x8*)(buf + SRC + 6144 + f * 1024 + lane * 16), vb[ks], o, 0, 0, 0); }
#pragma unroll
                for (int r = 0; r < 4; ++r) { const int row = 16 * mt + 4 * g4 + r, tok = t0 + (dir ? 63 - row : row);
                    od[(size_t)tok * MD + 16 * wave + l16] = (bf16)f2bf(o[r]); } }
            bf16x8 vsb[2] = {pack(VS[0], VS[1]), pack(VS[2], VS[3])};
            const float dd = scl[128 + 63];
#pragma unroll
            for (int dt = 0; dt < 8; ++dt) {
                pg8::f32x4 acc = S[dt] * dd;
#pragma unroll
                for (int ks = 0; ks < 2; ++ks) {
                    const int q = l16 >> 2, p = l16 & 3, r0 = 32 * ks + 4 * g4 + q, r1 = r0 + 16;
                    const LAS unsigned char* a0 = buf + SKT + r0 * 256 + (((2 * dt + (p >> 1)) ^ kswz(r0)) << 4) + (p & 1) * 8;
                    const LAS unsigned char* a1 = buf + SKT + r1 * 256 + (((2 * dt + (p >> 1)) ^ kswz(r1)) << 4) + (p & 1) * 8;
                    const v4i16_t lo = __builtin_amdgcn_ds_read_tr16_b64_v4i16((LAS v4i16_t*)a0), hi = __builtin_amdgcn_ds_read_tr16_b64_v4i16((LAS v4i16_t*)a1);
                    const bf16x8 afr = {lo[0], lo[1], lo[2], lo[3], hi[0], hi[1], hi[2], hi[3]};
                    acc = __builtin_amdgcn_mfma_f32_16x16x32_bf16(afr, vsb[ks], acc, 0, 0, 0);
                }
                S[dt] = acc;
            }
#pragma unroll
            for (int ks = 0; ks < 4; ++ks) Sb[ks] = pack(S[2 * ks], S[2 * ks + 1]);
        }
        asm volatile("s_waitcnt vmcnt(0)" ::: "memory"); __syncthreads();
    }
}

typedef float f32x16 __attribute__((ext_vector_type(16)));
constexpr int AKT = 0, AVT = 49152;
__device__ __forceinline__ void attn_mfma(Ctx& F) {
    PHASE_IDS(F);
    LAS unsigned char* L = F.lds + RING_OFF;
    const bf16* Q = (const bf16*)(F.ws + WS_Q); const bf16* K = (const bf16*)(F.ws + WS_K); const bf16* V = (const bf16*)(F.ws + WS_V); bf16* AO = (bf16*)(F.ws + WS_AO);
    const float M2 = 8.0f * LOG2E;
    const int r32 = lane & 31, hh = lane >> 5, G4 = lane >> 4, li = lane & 15;
    for (int unit = blockIdx.x; unit < 512; unit += F.G) {
        const int b = unit >> 8, g = (unit >> 6) & 3, n = unit & 63;
#pragma unroll
        for (int k = 0; k < 12; ++k) { const int d = wave + 8 * k, dd = d < 48 ? d : d - 48, row = 8 * dd + (lane >> 3), pos = lane & 7;
            int s = 128 * n - 128 + row; s = s < 0 ? 0 : (s > MSEQ - 1 ? MSEQ - 1 : s);
            const int Gs = d < 48 ? (pos ^ ((row >> 1) & 7)) : (pos ^ (((row >> 1) & 1) << 2));
            const bf16* src = (d < 48 ? K : V) + (size_t)(b * MSEQ + s) * 256 + g * 64 + Gs * 8;
            __builtin_amdgcn_global_load_lds((const unsigned*)src, (LAS unsigned*)(L + (d < 48 ? AKT : AVT) + dd * 1024), 16, 0, 0); }
        asm volatile("s_waitcnt vmcnt(0)" ::: "memory"); __syncthreads();
        const int head = 4 * g + (wave >> 1), qh = wave & 1;
        const float slope2 = exp2f(-8.0f * (float)(head + 1) / 16.0f) * LOG2E;
        const float sinkt = exp2f(F.in[6][head] * LOG2E - M2);
        const int wlo = n == 0 ? 128 : 0, whi = n == 63 ? 256 : 384;
#pragma unroll 1
        for (int qt = 0; qt < 2; ++qt) {
            const int qi = 64 * qh + 32 * qt + r32; const size_t tok = (size_t)b * MSEQ + 128 * n + qi;
            bf16x8 qf[4];
#pragma unroll
            for (int ks = 0; ks < 4; ++ks) qf[ks] = *(const GAS bf16x8*)(Q + tok * 1024 + head * 64 + 16 * ks + 8 * hh);
            f32x16 O0, O1; float lsum = 0.f;
#pragma unroll
            for (int i = 0; i < 16; ++i) { O0[i] = 0.f; O1[i] = 0.f; }
#pragma unroll 1
            for (int kt9 = 0; kt9 < 9; ++kt9) {
                const int kt = 2 * qh + qt + kt9;
                f32x16 S;
#pragma unroll
                for (int i = 0; i < 16; ++i) S[i] = 0.f;
                const int krow = 32 * kt + r32;
#pragma unroll
                for (int ks = 0; ks < 4; ++ks) { const bf16x8 kf = *(const LAS bf16x8*)(L + AKT + krow * 128 + (((2 * ks + hh) ^ ((krow >> 1) & 7)) << 4));
                    S = __builtin_amdgcn_mfma_f32_32x32x16_bf16(kf, qf[ks], S, 0, 0, 0); }
                const int dbase = 128 + qi - 32 * kt - 4 * hh;
                float P[16];
#pragma unroll
                for (int r = 0; r < 16; ++r) { const int kk = (r & 3) + 8 * (r >> 2); const int dl = dbase - kk, dist = dl < 0 ? -dl : dl, w = 32 * kt + 4 * hh + kk;
                    const bool ok = dist <= 128 && w >= wlo && w < whi;
                    const float p = ok ? exp2f(S[r] - slope2 * (float)dist - M2) : 0.f; P[r] = p; lsum += p; }
#pragma unroll
                for (int s = 0; s < 2; ++s) {
                    v4u t; t.x = pk2(P[8 * s], P[8 * s + 1]); t.y = pk2(P[8 * s + 2], P[8 * s + 3]); t.z = pk2(P[8 * s + 4], P[8 * s + 5]); t.w = pk2(P[8 * s + 6], P[8 * s + 7]);
                    const bf16x8 pb = __builtin_bit_cast(bf16x8, t);
                    const int q = li >> 2, p = li & 3, row0 = 32 * kt + 16 * s + 4 * hh + q, row1 = row0 + 8;
#pragma unroll
                    for (int dt = 0; dt < 2; ++dt) { const int Gv = 4 * dt + 2 * (G4 & 1) + (p >> 1);
                        const v4i16_t lo = __builtin_amdgcn_ds_read_tr16_b64_v4i16((LAS v4i16_t*)(L + AVT + row0 * 128 + ((Gv ^ (((row0 >> 1) & 1) << 2)) << 4) + (p & 1) * 8));
                        const v4i16_t hi = __builtin_amdgcn_ds_read_tr16_b64_v4i16((LAS v4i16_t*)(L + AVT + row1 * 128 + ((Gv ^ (((row1 >> 1) & 1) << 2)) << 4) + (p & 1) * 8));
                        const bf16x8 vf = {lo[0], lo[1], lo[2], lo[3], hi[0], hi[1], hi[2], hi[3]};
                        if (dt == 0) O0 = __builtin_amdgcn_mfma_f32_32x32x16_bf16(vf, pb, O0, 0, 0, 0); else O1 = __builtin_amdgcn_mfma_f32_32x32x16_bf16(vf, pb, O1, 0, 0, 0); }
                }
            }
            lsum += __shfl_xor(lsum, 32);
            const float inv = 1.f / (lsum + sinkt);
            bf16* op = AO + tok * 1024 + head * 64 + 4 * hh;
#pragma unroll
            for (int rg = 0; rg < 4; ++rg) {
                u32x2_t a, c; a.x = pk2(O0[4 * rg] * inv, O0[4 * rg + 1] * inv); a.y = pk2(O0[4 * rg + 2] * inv, O0[4 * rg + 3] * inv);
                c.x = pk2(O1[4 * rg] * inv, O1[4 * rg + 1] * inv); c.y = pk2(O1[4 * rg + 2] * inv, O1[4 * rg + 3] * inv);
                *(GAS u32x2_t*)(op + 8 * rg) = a; *(GAS u32x2_t*)(op + 32 + 8 * rg) = c; }
        }
        __syncthreads();
    }
}
struct Args { const float* in[21]; float* out; unsigned char* ws; int mask, li; };
__global__ void __launch_bounds__(NTHR, 2) mk_fwd(Args args) {
    extern __shared__ __attribute__((aligned(16))) unsigned char lds[];
    Ctx F;
    F.lds = (LAS unsigned char*)lds;
    F.MISC = (volatile LAS unsigned*)(F.lds + MISC_OFF);
    F.G = gridDim.x; { const int bx = blockIdx.x; const int vcu = (F.G % 8 == 0) ? (bx % 8) * (F.G / 8) + bx / 8 : bx; F.gwb = vcu * NWAVES; F.NGW = F.G * NWAVES; }
    F.wv = __builtin_amdgcn_readfirstlane((int)(threadIdx.x >> 6));
    F.ws = args.ws; F.out = args.out; F.ctl = (gu32*)(args.ws + WS_CTL);
#pragma unroll
    for (int i = 0; i < 21; ++i) F.in[i] = args.in[i];
    for (int u = threadIdx.x; u < (LDS_BYTES - LDSCTL_OFF) / 4; u += NTHR) ((LAS unsigned*)(F.lds + LDSCTL_OFF))[u] = 0u;
    __syncthreads();
    XcdBarrier bar = xcd_barrier_post((unsigned*)(F.ctl + CW_BAR) + args.li * XCD_BAR_WORDS, F.MISC + 8);
    const int mask = args.mask;
    const LAS int* tab = (const LAS int*)(F.lds + MOETAB_OFF);
#pragma unroll 1
    for (int ph = 0; ph < 17; ++ph) {
        if (!((mask >> ph) & 1)) continue;
        const int layer = ph >= 13 ? 1 : 0;
        int sel = ph >= 13 ? ph - 9 : (ph == 12 ? 3 : ph);
        asm volatile("" : "+s"(sel));
        switch (sel) {
        case 0: p0_prologue(F); break;
        case 1: {
            pg8::Gemm g{(const pg8::bf16_t*)(F.ws + WS_XN), (const pg8::bf16_t*)(F.ws + WS_WQKV), MT, 1536, MD}; pg8::StaticOrder S; S.init(MT, 1536, F.G, (int)blockIdx.x);
            pg8::EpiQKV E{(pg8::bf16_t*)(F.ws + WS_Q), (pg8::bf16_t*)(F.ws + WS_K), (pg8::bf16_t*)(F.ws + WS_V), F.in[4], F.in[5], QSCALE};
            pg8::gemm_phase<pg8::EpiQKV, pg8::StaticOrder, true, true>(F.lds + RING_OFF, g, S, E, F.wv * 64 + lane_id());
        } break;
        case 2: attn_mfma(F); break;
        case 3: {
            pg8::Gemm g{(const pg8::bf16_t*)(F.ws + (ph == 3 ? WS_AO : WS_ON)), (const pg8::bf16_t*)(F.ws + (ph == 3 ? WS_WAO : WS_WGO)), MT, MD, MD}; pg8::StaticOrder S; S.init(MT, MD, F.G, (int)blockIdx.x);
            pg8::EpiResF32 E{ph == 3 ? F.in[0] : F.out, F.out, MD};
            pg8::gemm_phase<pg8::EpiResF32, pg8::StaticOrder, true, true>(F.lds + RING_OFF, g, S, E, F.wv * 64 + lane_id());
            if (ph != 3) moe_convert(F, 1, F.gwb + F.wv, F.NGW);
        } break;
        case 4: p4_router(F, layer); break;
        case 5: {
            moe_tables(F, layer, 2);
            pg8::Gemm g{(const pg8::bf16_t*)(F.ws + WS_XN), (const pg8::bf16_t*)(F.ws + WS_WGU), MT, 512, MD};
            pg8::MoeOrder S{tab, 2, F.G, (int)blockIdx.x, (const int*)(F.ws + WS_LIST), (unsigned)(MD * 2)};
            pg8::EpiGateUp E{(pg8::bf16_t*)(F.ws + WS_H), (const float*)(F.ws + WS_GLIST), tab};
            pg8::gemm_phase<pg8::EpiGateUp, pg8::MoeOrder, true, true, true>(F.lds + RING_OFF, g, S, E, F.wv * 64 + lane_id());
        } break;
        case 6: {
            moe_tables(F, layer, 4);
            pg8::Gemm g{(const pg8::bf16_t*)(F.ws + WS_H), (const pg8::bf16_t*)(F.ws + WS_WD), 40960, 1024, 256};
            pg8::MoeOrder S{tab, 4, F.G, (int)blockIdx.x, (const int*)(F.ws + WS_LIST), 512u};
            pg8::EpiY E{(pg8::bf16_t*)(F.ws + WS_Y)};
            pg8::gemm_phase<pg8::EpiY, pg8::MoeOrder, true, true, false>(F.lds + RING_OFF, g, S, E, F.wv * 64 + lane_id());
        } break;
        case 7: moe_tables(F, layer, 4); if (layer == 0) p7_combine<true>(F); else p7_combine<false>(F); break;
        case 8: {
            pg8::Gemm g{(const pg8::bf16_t*)(F.ws + WS_XN), (const pg8::bf16_t*)(F.ws + WS_WGIN), MT, 4096, MD}; pg8::StaticOrder S; S.init(MT, 4096, F.G, (int)blockIdx.x);
            pg8::EpiGdnIn E{(pg8::bf16_t*)(F.ws + WS_QKVPRE), (pg8::bf16_t*)(F.ws + WS_Z), (pg8::bf16_t*)(F.ws + WS_HALO)};
            pg8::gemm_phase<pg8::EpiGdnIn, pg8::StaticOrder, true, true>(F.lds + RING_OFF, g, S, E, F.wv * 64 + lane_id());
        } break;
        case 9: gdn_prep(F); break;
        case 10: gdn_scan(F); break;
        default: gdn_gate(F); break;
        }
        if ((mask >> (ph + 1)) != 0) xcd_barrier(bar, F.wv == 0 && lane_id() == 0);
    }
}

extern "C" void kernel_launch(void* const* d_in, const int* in_sizes, int n_in, void* d_out, int out_size, void* d_ws, size_t ws_size, hipStream_t stream) {
    static int grid = 0;
    if (grid == 0) {
        int dev = 0, cus = 0;
        if (hipGetDevice(&dev) != hipSuccess || hipDeviceGetAttribute(&cus, hipDeviceAttributeMultiprocessorCount, dev) != hipSuccess) { fprintf(stderr, "kernel_launch: device query failed\n"); grid = -1; return; }
        if (hipFuncSetAttribute((const void*)mk_fwd, hipFuncAttributeMaxDynamicSharedMemorySize, LDS_BYTES) != hipSuccess) { fprintf(stderr, "kernel_launch: hipFuncSetAttribute failed\n"); grid = -1; return; }
        (void)hipGetLastError();
        grid = cus;
        if (ws_size < WS_END) { fprintf(stderr, "kernel_launch: workspace too small\n"); }
    }
    if (grid < 0) return;
    (void)hipMemsetAsync((char*)d_ws + WS_CTL, 0, CTL_ZERO_BYTES, stream);
    Args a{};
    for (int i = 0; i < 21; ++i) a.in[i] = (const float*)d_in[i];
    a.out = (float*)d_out; a.ws = (unsigned char*)d_ws; a.mask = 0x1ffff; a.li = 0;
    hipLaunchKernelGGL(mk_fwd, dim3(grid), dim3(NTHR), LDS_BYTES, stream, a);
}
```

```cpp
#include <hip/hip_runtime.h>
#include <cstdio>
#include <cstdint>
namespace pg8 {
#define PG8_LAS __attribute__((address_space(3)))
typedef unsigned short bf16_t;
typedef short bf16x8 __attribute__((ext_vector_type(8)));
typedef float f32x4 __attribute__((ext_vector_type(4)));
typedef unsigned u32x4 __attribute__((ext_vector_type(4)));
constexpr int BM = 256, BK = 64, HALF = 128, HTB = HALF * BK * 2  , STAGE_BYTES = 8 * HTB, NXCD = 8, WGM = 8;

__host__ __device__ __forceinline__ int lds_byte(int r, int c) { const int st = (r >> 4) * 2 + (c >> 5), rr = r & 15, cc = c & 31, ob = rr * 64 + cc * 2; return st * 1024 + (ob ^ (((ob >> 9) & 1) << 5)); }
__host__ __device__ __forceinline__ void stage_rc(int b, int& R, int& C) { const int st = b / 1024, sb = b % 1024, swz = sb ^ (((sb >> 9) & 1) << 5); R = (st >> 1) * 16 + swz / 64; C = (st & 1) * 32 + (swz % 64) / 2; }
__host__ __device__ __forceinline__ int perm32(int rho) { const int n = rho >> 4, i = rho & 15; return 8 * (i >> 2) + 4 * n + (i & 3); }

struct Unit { int pm, pn; };
struct Gemm { const bf16_t* A; const bf16_t* Bt; int M, N, K; };

struct StaticOrder {
    int nM, nN, nwg, G, c;
    __host__ __device__ void init(int M, int N, int G_, int c_) { nM = M / BM; nN = N / BM; nwg = nM * nN; G = G_; c = c_; }
    __host__ __device__ bool next(int i, Unit& u) const {
        const long L = (long)i * G + c; if (L >= nwg) return false;
        int wgid = (int)L; { const int q = nwg / NXCD, r = nwg % NXCD, xcd = wgid % NXCD, off = wgid / NXCD; wgid = (xcd < r ? xcd * (q + 1) : r * (q + 1) + (xcd - r) * q) + off; }
        const int nig = WGM * nN, gid = wgid / nig, fm = gid * WGM, gsz = (nM - fm) < WGM ? (nM - fm) : WGM;
        u.pm = fm + ((wgid % nig) % gsz); u.pn = (wgid % nig) / gsz; return true;
    }
    __device__ __forceinline__ void a_ready(const Unit&) const {}
    __device__ __forceinline__ void done(const Unit&) const {}
};

__device__ __forceinline__ unsigned cvt_pk_bf16(float lo, float hi) { unsigned r; asm volatile("v_cvt_pk_bf16_f32 %0, %1, %2" : "=v"(r) : "v"(lo), "v"(hi)); return r; }
typedef unsigned u32x4 __attribute__((ext_vector_type(4)));
struct EpiQKV {
    static constexpr bool PERM = true, AFTER_DRAIN = false;
    bf16_t *Q, *K, *V; const float *qg, *kg; float qscale;
    __device__ __forceinline__ void operator()(const f32x4 (&acc)[2][2][4][2], const Unit& u, int wr, int wc, int fr, int fq) const {
        const int row0 = u.pm * BM + wr * 64 + fr;
        bf16_t* dst; int ld; const float* gain; float sc; bool norm;
        if (u.pn < 4) { dst = Q + (u.pn * 4 + wc) * 64; ld = 1024; gain = qg; sc = qscale; norm = true; }
        else if (u.pn == 4) { dst = K + wc * 64; ld = 256; gain = kg; sc = 1.f; norm = true; }
        else { dst = V + wc * 64; ld = 256; gain = qg; sc = 1.f; norm = false; }
        f32x4 gv[2][2];
#pragma unroll
        for (int bj = 0; bj < 2; ++bj)
#pragma unroll
            for (int n = 0; n < 2; ++n) { const f32x4 g4 = *(const f32x4*)(gain + 32 * bj + 8 * fq + 4 * n); gv[bj][n] = norm ? g4 * sc : (f32x4){1.f, 1.f, 1.f, 1.f}; }
#pragma unroll
        for (int ai = 0; ai < 2; ++ai)
#pragma unroll
            for (int m = 0; m < 4; ++m) {
                float ss = 0.f;
#pragma unroll
                for (int bj = 0; bj < 2; ++bj)
#pragma unroll
                    for (int n = 0; n < 2; ++n) { const f32x4 x = acc[ai][bj][m][n]; ss += (x[0] * x[0] + x[1] * x[1]) + (x[2] * x[2] + x[3] * x[3]); }
                ss += __shfl_xor(ss, 16); ss += __shfl_xor(ss, 32);
                const float rs = norm ? rsqrtf(ss * (1.0f / 64.0f) + 1e-6f) : 1.f;
                bf16_t* rowp = dst + (size_t)(row0 + ai * HALF + m * 16) * ld + 8 * fq;
#pragma unroll
                for (int bj = 0; bj < 2; ++bj) { const f32x4 v0 = acc[ai][bj][m][0] * rs * gv[bj][0], v1 = acc[ai][bj][m][1] * rs * gv[bj][1];
                    u32x4 w; w.x = cvt_pk_bf16(v0[0], v0[1]); w.y = cvt_pk_bf16(v0[2], v0[3]); w.z = cvt_pk_bf16(v1[0], v1[1]); w.w = cvt_pk_bf16(v1[2], v1[3]);
                    *(u32x4*)(rowp + 32 * bj) = w; }
            }
    }
};
struct EpiResF32 {
    static constexpr bool PERM = false, AFTER_DRAIN = false;
    const float* base; float* out; int ldc;
    __device__ __forceinline__ void operator()(const f32x4 (&acc)[2][2][4][2], const Unit& u, int wr, int wc, int fr, int fq) const {
        const int row0 = u.pm * BM + wr * 64 + fr, col0 = u.pn * BM + wc * 32 + 4 * fq;
#pragma unroll
        for (int ai = 0; ai < 2; ++ai)
#pragma unroll
            for (int m = 0; m < 4; ++m) { const size_t off = (size_t)(row0 + ai * HALF + m * 16) * ldc + col0;
#pragma unroll
                for (int bj = 0; bj < 2; ++bj)
#pragma unroll
                    for (int n = 0; n < 2; ++n) { const size_t o = off + bj * HALF + n * 16; const f32x4 b = *(const f32x4*)(base + o); *(f32x4*)(out + o) = b + acc[ai][bj][m][n]; } }
    }
};

constexpr int MOE_CAP = 16384;
struct MoeOrder {
    const PG8_LAS int* tab; int npn, G, c; const int* list; unsigned rowbytes;
    __device__ __forceinline__ bool next(int i, Unit& u) const {
        const int L = i * G + c; if (L >= tab[65 + 32]) return false;
        int e = 0;
        for (int j = 1; j < 32; ++j) e = (L >= tab[65 + j]) ? j : e;
        const int local = L - tab[65 + e], mt = local / npn, pnl = local - mt * npn;
        u.pm = (tab[32 + e] >> 8) + mt; u.pn = e * npn + pnl; return true;
    }
    __device__ __forceinline__ unsigned rowoff(const Unit& u, int r) const {
        const int e = u.pn >> 1, idx = u.pm * 256 - tab[32 + e] + r;
        const int tok = idx < tab[e] ? list[e * MOE_CAP + idx] : 0;
        return (unsigned)tok * rowbytes;
    }
    __device__ __forceinline__ void a_ready(const Unit&) const {}
    __device__ __forceinline__ void done(const Unit&) const {}
};
struct EpiGateUp {
    static constexpr bool PERM = true, AFTER_DRAIN = false;
    bf16_t* H; const float* glist; const PG8_LAS int* tab;
    __device__ __forceinline__ void operator()(const f32x4 (&acc)[2][2][4][2], const Unit& u, int wr, int wc, int fr, int fq) const {
        const int e = u.pn >> 1, pnl = u.pn & 1, row0 = u.pm * BM + wr * 64 + fr, li0 = row0 - tab[32 + e], cnt = tab[e];
#pragma unroll
        for (int ai = 0; ai < 2; ++ai)
#pragma unroll
            for (int m = 0; m < 4; ++m) { const int li = li0 + ai * HALF + m * 16; const float gw = li < cnt ? glist[e * MOE_CAP + li] : 0.f;
                f32x4 h[2];
#pragma unroll
                for (int n = 0; n < 2; ++n)
#pragma unroll
                    for (int i = 0; i < 4; ++i) { const float g = acc[ai][0][m][n][i], uu = acc[ai][1][m][n][i]; h[n][i] = g * __builtin_amdgcn_rcpf(1.f + __expf(-g)) * uu * gw; }
                u32x4 w; w.x = cvt_pk_bf16(h[0][0], h[0][1]); w.y = cvt_pk_bf16(h[0][2], h[0][3]); w.z = cvt_pk_bf16(h[1][0], h[1][1]); w.w = cvt_pk_bf16(h[1][2], h[1][3]);
                *(u32x4*)(H + (size_t)(row0 + ai * HALF + m * 16) * 256 + 128 * pnl + 32 * wc + 8 * fq) = w; }
    }
};
struct EpiY {
    static constexpr bool PERM = true, AFTER_DRAIN = false;
    bf16_t* Y;
    __device__ __forceinline__ void operator()(const f32x4 (&acc)[2][2][4][2], const Unit& u, int wr, int wc, int fr, int fq) const {
        const int row0 = u.pm * BM + wr * 64 + fr, col0 = (u.pn & 3) * BM + wc * 32 + 8 * fq;
#pragma unroll
        for (int ai = 0; ai < 2; ++ai)
#pragma unroll
            for (int m = 0; m < 4; ++m) { bf16_t* rowp = Y + (size_t)(row0 + ai * HALF + m * 16) * 1024 + col0;
#pragma unroll
                for (int bj = 0; bj < 2; ++bj) { const f32x4 v0 = acc[ai][bj][m][0], v1 = acc[ai][bj][m][1];
                    u32x4 w; w.x = cvt_pk_bf16(v0[0], v0[1]); w.y = cvt_pk_bf16(v0[2], v0[3]); w.z = cvt_pk_bf16(v1[0], v1[1]); w.w = cvt_pk_bf16(v1[2], v1[3]);
                    *(u32x4*)(rowp + bj * HALF) = w; } }
    }
};

struct EpiGdnIn {
    static constexpr bool PERM = true, AFTER_DRAIN = false;
    bf16_t *QKV, *Z, *HALO;
    __device__ __forceinline__ void operator()(const f32x4 (&acc)[2][2][4][2], const Unit& u, int wr, int wc, int fr, int fq) const {
        const int row0 = u.pm * BM + wr * 64 + fr;
        bf16_t* dst; int ld;
        if (u.pn < 12) { dst = QKV + u.pn * BM; ld = 3072; } else { dst = Z + (u.pn - 12) * BM; ld = 1024; }
        dst += wc * 32 + 8 * fq;
#pragma unroll
        for (int ai = 0; ai < 2; ++ai)
#pragma unroll
            for (int m = 0; m < 4; ++m) { bf16_t* rowp = dst + (size_t)(row0 + ai * HALF + m * 16) * ld;
#pragma unroll
                for (int bj = 0; bj < 2; ++bj) { const f32x4 v0 = acc[ai][bj][m][0], v1 = acc[ai][bj][m][1];
                    u32x4 w; w.x = cvt_pk_bf16(v0[0], v0[1]); w.y = cvt_pk_bf16(v0[2], v0[3]); w.z = cvt_pk_bf16(v1[0], v1[1]); w.w = cvt_pk_bf16(v1[2], v1[3]);
                    *(u32x4*)(rowp + bj * HALF) = w;
                    if (u.pn < 12 && ((m == 0 && fr == 0) || (m == 3 && fr >= 14))) { const int row = row0 + ai * HALF + m * 16, slot = m == 0 ? 0 : fr - 13;
                        *(u32x4*)(HALO + ((size_t)(row >> 6) * 3 + slot) * 3072 + u.pn * BM + wc * 32 + 8 * fq + bj * HALF) = w; } } }
    }
};
template <class Epi, class Sched, bool ALIGN_EPI = false, bool SP2 = false, bool GATHER = false>
__device__ __forceinline__ void gemm_phase(PG8_LAS unsigned char* lds, const Gemm g, const Sched& S, const Epi& E, int tid_in) {
    int tid_ = tid_in; asm volatile("" : "+v"(tid_));
    const int tid = tid_, wid = __builtin_amdgcn_readfirstlane(tid >> 6), lane = tid & 63, wr = wid >> 2, wc = wid & 3, fr = lane & 15, fq = lane >> 4;
    int K_ = g.K; asm volatile("" : "+s"(K_));
    const int K = K_, nt = K / BK;
    unsigned voffA[2], voffB[2];
#pragma unroll
    for (int i = 0; i < 2; ++i) { int R, C; stage_rc(tid * 16 + i * 8192, R, C); const int Rb = Epi::PERM ? ((R & ~31) + perm32(R & 31)) : R;
        voffA[i] = (unsigned)(R * K + C) * 2u; voffB[i] = (unsigned)(Rb * K + C) * 2u; }
    const size_t kstep = (size_t)(BK * 2);
    const size_t hstep = (size_t)HALF * K * 2; const size_t hstepA = GATHER ? (size_t)0 : hstep;
    const size_t tstep = 2 * hstep;
    const unsigned ldsw = (unsigned)wid * 1024u;
    const int aoff = lds_byte(wr * 64 + fr, fq * 8), boff = lds_byte(wc * 32 + fr, fq * 8);
#define PG8_SA(b, h) (((b) * 2 + (h)) * HTB)
#define PG8_SB(b, h) ((4 + (b) * 2 + (h)) * HTB)
#define PG8_STAGE(bufoff, gbase, voff) do { _Pragma("unroll") for (int _i = 0; _i < 2; ++_i) \
        __builtin_amdgcn_global_load_lds((const unsigned*)((const char*)(gbase) + (voff)[_i]), (PG8_LAS unsigned*)(lds + (bufoff) + ldsw + _i * 8192), 16, 0, 0); } while (0)
#define PG8_LDA(dst, b, h) do { _Pragma("unroll") for (int m = 0; m < 4; ++m) _Pragma("unroll") for (int k = 0; k < 2; ++k) dst[m][k] = *(const PG8_LAS bf16x8*)(lds + PG8_SA(b, h) + aoff + m * 2048 + k * 1024); } while (0)
#define PG8_LDB(dst, b, h) do { _Pragma("unroll") for (int n = 0; n < 2; ++n) _Pragma("unroll") for (int k = 0; k < 2; ++k) dst[n][k] = *(const PG8_LAS bf16x8*)(lds + PG8_SB(b, h) + boff + n * 2048 + k * 1024); } while (0)
#define PG8_MMA(ai, bj, At, Bt) do { __builtin_amdgcn_s_setprio(1); _Pragma("unroll") for (int m = 0; m < 4; ++m) _Pragma("unroll") for (int n = 0; n < 2; ++n) _Pragma("unroll") for (int k = 0; k < 2; ++k) \
        acc[ai][bj][m][n] = __builtin_amdgcn_mfma_f32_16x16x32_bf16(Bt[n][k], At[m][k], acc[ai][bj][m][n], 0, 0, 0); __builtin_amdgcn_s_setprio(0); } while (0)
#define PG8_WAIT_V(n) asm volatile("s_waitcnt vmcnt(" #n ")" ::: "memory")
#define PG8_WAIT_L(n) asm volatile("s_waitcnt lgkmcnt(" #n ")" ::: "memory")
#define PG8_BAR __builtin_amdgcn_s_barrier()
#define PG8_SCHED __builtin_amdgcn_sched_barrier(0)
    Unit cur, nxt; int ui = 0;
    if (!S.next(0, cur)) return;
    f32x4 acc[2][2][4][2];
#pragma unroll
    for (int a = 0; a < 2; ++a)
#pragma unroll
        for (int b = 0; b < 2; ++b)
#pragma unroll
            for (int m = 0; m < 4; ++m)
#pragma unroll
                for (int n = 0; n < 2; ++n) acc[a][b][m][n] = (f32x4){0.f, 0.f, 0.f, 0.f};
    bf16x8 At[4][2], B0[2][2], B1[2][2];
    const char* cA = (const char*)g.A + (GATHER ? (size_t)0 : (size_t)cur.pm * tstep);
    unsigned vC[2][2];
    PG8_LAS unsigned* vNl = (PG8_LAS unsigned*)(lds + STAGE_BYTES + 2048) + tid;
#pragma unroll
    for (int h = 0; h < 2; ++h)
#pragma unroll
        for (int i = 0; i < 2; ++i) { if constexpr (GATHER) { int R, C; stage_rc(tid * 16 + i * 8192, R, C); vC[h][i] = S.rowoff(cur, 128 * h + R) + (unsigned)C * 2u; vNl[(h * 2 + i) * 512] = vC[h][i]; } else vC[h][i] = voffA[i]; }
    const char* cB = (const char*)g.Bt + (size_t)cur.pn * tstep;
    S.a_ready(cur);
    if constexpr (SP2) {
        PG8_STAGE(PG8_SB(0, 0), cB, voffB); PG8_STAGE(PG8_SB(0, 1), cB + hstep, voffB); PG8_STAGE(PG8_SA(0, 0), cA, vC[0]); PG8_STAGE(PG8_SA(0, 1), cA + hstepA, vC[1]);
        if (wr == 1) PG8_BAR;
        PG8_WAIT_V(2); PG8_BAR;
        PG8_STAGE(PG8_SB(1, 0), cB + kstep, voffB); PG8_STAGE(PG8_SA(1, 0), cA + kstep, vC[0]); PG8_STAGE(PG8_SB(1, 1), cB + hstep + kstep, voffB);
        PG8_WAIT_V(6); PG8_BAR;
    } else {
        PG8_STAGE(PG8_SB(0, 0), cB, voffB); PG8_STAGE(PG8_SA(0, 0), cA, vC[0]); PG8_STAGE(PG8_SB(0, 1), cB + hstep, voffB); PG8_STAGE(PG8_SA(0, 1), cA + hstepA, vC[1]);
        if (wr == 1) PG8_BAR;
        PG8_WAIT_V(4); PG8_BAR;
        PG8_STAGE(PG8_SB(1, 0), cB + kstep, voffB); PG8_STAGE(PG8_SA(1, 0), cA + kstep, vC[0]); PG8_STAGE(PG8_SB(1, 1), cB + hstep + kstep, voffB);
        PG8_WAIT_V(6); PG8_BAR;
    }
    for (;;) {
        const bool has_next = S.next(ui + 1, nxt);
        const char* nA = (has_next && !GATHER) ? (const char*)g.A + (size_t)nxt.pm * tstep : cA;
        if constexpr (GATHER) { if (has_next) {
#pragma unroll
            for (int h = 0; h < 2; ++h)
#pragma unroll
                for (int i = 0; i < 2; ++i) { int R, C; stage_rc(tid * 16 + i * 8192, R, C); vNl[(h * 2 + i) * 512] = S.rowoff(nxt, 128 * h + R) + (unsigned)C * 2u; } } }
        const char* nB = has_next ? (const char*)g.Bt + (size_t)nxt.pn * tstep : cB;
        for (int t = 0; t < nt; t += 2) {
            const bool last = (t == nt - 2);
            const char* a1 = cA + (size_t)(t + 1) * kstep;
            const char* a2 = last ? nA : cA + (size_t)(t + 2) * kstep; const char* b2 = last ? nB : cB + (size_t)(t + 2) * kstep;
            const char* a3 = a2 + kstep; const char* b3 = b2 + kstep;
            unsigned v2[2][2];
#pragma unroll
            for (int h = 0; h < 2; ++h)
#pragma unroll
                for (int i = 0; i < 2; ++i) { if constexpr (GATHER) { v2[h][i] = vC[h][i]; if (last) v2[h][i] = vNl[(h * 2 + i) * 512]; } else v2[h][i] = vC[h][i]; }
            if (last && has_next) S.a_ready(nxt);
            if constexpr (SP2) {
            PG8_LDB(B0, 0, 0); PG8_LDB(B1, 0, 1); PG8_SCHED; PG8_LDA(At, 0, 0); PG8_STAGE(PG8_SA(1, 1), a1 + hstepA, vC[1]);
            PG8_WAIT_V(8); PG8_WAIT_L(0); PG8_BAR; PG8_MMA(0, 0, At, B0); PG8_MMA(0, 1, At, B1); PG8_BAR; PG8_SCHED;
            PG8_LDA(At, 0, 1); PG8_STAGE(PG8_SB(0, 0), b2, voffB); PG8_STAGE(PG8_SB(0, 1), b2 + hstep, voffB); PG8_STAGE(PG8_SA(0, 0), a2, v2[0]);
            PG8_WAIT_V(8); PG8_WAIT_L(0); PG8_BAR; PG8_MMA(1, 0, At, B0); PG8_MMA(1, 1, At, B1); PG8_BAR; PG8_SCHED;
            PG8_LDB(B0, 1, 0); PG8_LDB(B1, 1, 1); PG8_SCHED; PG8_LDA(At, 1, 0); PG8_STAGE(PG8_SA(0, 1), a2 + hstepA, v2[1]);
            PG8_WAIT_V(8); PG8_WAIT_L(0); PG8_BAR; PG8_MMA(0, 0, At, B0); PG8_MMA(0, 1, At, B1); PG8_BAR; PG8_SCHED;
            PG8_LDA(At, 1, 1); PG8_STAGE(PG8_SB(1, 0), b3, voffB); PG8_STAGE(PG8_SB(1, 1), b3 + hstep, voffB); PG8_STAGE(PG8_SA(1, 0), a3, v2[0]);
            PG8_WAIT_V(8); PG8_WAIT_L(0); PG8_BAR; PG8_MMA(1, 0, At, B0); PG8_MMA(1, 1, At, B1); PG8_BAR; PG8_SCHED;
            } else {
            PG8_LDB(B0, 0, 0); PG8_SCHED; PG8_LDA(At, 0, 0); PG8_STAGE(PG8_SA(1, 1), a1 + hstepA, vC[1]);
            PG8_WAIT_L(8); PG8_BAR; PG8_WAIT_L(0); PG8_MMA(0, 0, At, B0); PG8_BAR; PG8_SCHED;
            PG8_LDB(B1, 0, 1); PG8_STAGE(PG8_SB(0, 0), b2, voffB);
            PG8_BAR; PG8_WAIT_L(0); PG8_MMA(0, 1, At, B1); PG8_BAR;
            PG8_LDA(At, 0, 1); PG8_STAGE(PG8_SA(0, 0), a2, v2[0]);
            PG8_BAR; PG8_WAIT_L(0); PG8_MMA(1, 0, At, B0); PG8_BAR; PG8_SCHED;
            PG8_STAGE(PG8_SB(0, 1), b2 + hstep, voffB);
            PG8_WAIT_V(6); PG8_BAR; PG8_MMA(1, 1, At, B1); PG8_BAR;
            PG8_LDB(B0, 1, 0); PG8_SCHED; PG8_LDA(At, 1, 0); PG8_STAGE(PG8_SA(0, 1), a2 + hstepA, v2[1]);
            PG8_WAIT_L(8); PG8_BAR; PG8_WAIT_L(0); PG8_MMA(0, 0, At, B0); PG8_BAR; PG8_SCHED;
            PG8_LDB(B1, 1, 1); PG8_STAGE(PG8_SB(1, 0), b3, voffB);
            PG8_BAR; PG8_WAIT_L(0); PG8_MMA(0, 1, At, B1); PG8_BAR;
            PG8_LDA(At, 1, 1); PG8_STAGE(PG8_SA(1, 0), a3, v2[0]);
            PG8_BAR; PG8_WAIT_L(0); PG8_MMA(1, 0, At, B0); PG8_BAR; PG8_SCHED;
            PG8_STAGE(PG8_SB(1, 1), b3 + hstep, voffB);
            PG8_WAIT_V(6); PG8_BAR; PG8_MMA(1, 1, At, B1); PG8_BAR;
            }
        }
        if constexpr (ALIGN_EPI) { if (wr == 0) PG8_BAR; }
        if constexpr (!Epi::AFTER_DRAIN) { E(acc, cur, wr, wc, fr, fq); S.done(cur); }
        if (!has_next) break;
#pragma unroll
        for (int a = 0; a < 2; ++a)
#pragma unroll
            for (int b = 0; b < 2; ++b)
#pragma unroll
                for (int m = 0; m < 4; ++m)
#pragma unroll
                    for (int n = 0; n < 2; ++n) acc[a][b][m][n] = (f32x4){0.f, 0.f, 0.f, 0.f};
        cur = nxt; cA = nA; cB = nB; ++ui;
#pragma unroll
        for (int h = 0; h < 2; ++h)
#pragma unroll
            for (int i = 0; i < 2; ++i) { if constexpr (GATHER) vC[h][i] = vNl[(h * 2 + i) * 512]; }
        if constexpr (ALIGN_EPI) { if (wr == 1) PG8_BAR; }
    }
    PG8_WAIT_V(0);
    if constexpr (!ALIGN_EPI) { if (wr == 0) PG8_BAR; }
    PG8_BAR;
    if constexpr (Epi::AFTER_DRAIN) { E.fused(acc, cur, wr, wc, fr, fq, lds, wid, lane); S.done(cur); }
#undef PG8_SA
#undef PG8_SB
#undef PG8_STAGE
#undef PG8_LDA
#undef PG8_LDB
#undef PG8_MMA
#undef PG8_WAIT_V
#undef PG8_WAIT_L
#undef PG8_BAR
#undef PG8_SCHED
}
}
#define GAS __attribute__((address_space(1)))
#define LAS __attribute__((address_space(3)))
typedef unsigned short bf16;
typedef unsigned v4u __attribute__((ext_vector_type(4)));
typedef float f32x4 __attribute__((ext_vector_type(4)));
typedef short bf16x8 __attribute__((ext_vector_type(8)));
typedef GAS unsigned gu32;
typedef GAS unsigned long long gu64;
#define RLX_AGENT __ATOMIC_RELAXED, __HIP_MEMORY_SCOPE_AGENT
#define LDS_WAIT() asm volatile("s_waitcnt lgkmcnt(0)" ::: "memory")
#define VM_WAIT() asm volatile("s_waitcnt vmcnt(0)" ::: "memory")
__device__ __forceinline__ unsigned long long rt() { return __builtin_amdgcn_s_memrealtime(); }
typedef float f32x2_cv __attribute__((ext_vector_type(2))); typedef __bf16 bf16x2_cv __attribute__((ext_vector_type(2)));
__device__ __forceinline__ unsigned pk2(float lo, float hi) { f32x2_cv v = {lo, hi}; bf16x2_cv b = __builtin_convertvector(v, bf16x2_cv); return __builtin_bit_cast(unsigned, b); }
__device__ __forceinline__ unsigned f2bf(float f) { return pk2(f, f) & 0xffffu; }


#define XB_TMO      128
#define XB_XCNT(j)  (256  + 64 * (j))
#define XB_XSUB(j)  (1280 + 64 * (j))
#define XB_XGEN(j)  (2304 + 64 * (j))
#define XB_TOP      3328
#define XB_TOPGEN   3392
#define XCD_BAR_WORDS 3456
#define XB_SPIN_CAP (1u << 18)

__device__ __forceinline__ unsigned xb_ld(unsigned* p)              { return __hip_atomic_load(p, __ATOMIC_RELAXED, __HIP_MEMORY_SCOPE_AGENT); }
__device__ __forceinline__ unsigned xb_add(unsigned* p, unsigned v) { return __hip_atomic_fetch_add(p, v, __ATOMIC_RELAXED, __HIP_MEMORY_SCOPE_AGENT); }
__device__ __forceinline__ unsigned xb_xcc_id() { return (unsigned)__builtin_amdgcn_s_getreg((3 << 11) | 20) & 0xFu; }
#define XB_SPIN(cond, bar) do { unsigned _sp = 0; while (cond) { __builtin_amdgcn_s_sleep(1); \
    if ((++_sp & 255u) == 0u) { if (xb_ld(&(bar)[XB_TMO])) break; if (_sp > XB_SPIN_CAP) { atomicAdd(&(bar)[XB_TMO], 1u); break; } } } } while (0)

struct XcdBarrier {
    unsigned* bar; unsigned x;
    volatile LAS unsigned* st;
};

__device__ __forceinline__ XcdBarrier xcd_barrier_post(unsigned* bar, volatile LAS unsigned* st) {
    XcdBarrier b; b.bar = bar; b.x = xb_xcc_id(); b.st = st;
    if (threadIdx.x == 0) (void)xb_add(&bar[XB_XCNT(b.x)], 1u);
    return b;
}
__device__ __forceinline__ void xcd_barrier_complete(unsigned* bar, unsigned x, unsigned& nloc, unsigned& nx) {
    const unsigned G = gridDim.x * gridDim.y * gridDim.z;
    unsigned sum, cnt, mine, sp = 0u;
    for (;;) {
        sum = 0u; cnt = 0u; mine = 0u;
#pragma unroll
        for (unsigned j = 0; j < 16; ++j) { const unsigned c = xb_ld(&bar[XB_XCNT(j)]); sum += c; cnt += (c > 0u) ? 1u : 0u; mine = (j == x) ? c : mine; }
        if (sum == G) break;
        __builtin_amdgcn_s_sleep(1);
        if ((++sp & 255u) == 0u) { if (xb_ld(&bar[XB_TMO])) break; if (sp > XB_SPIN_CAP) { atomicAdd(&bar[XB_TMO], 1u); break; } }
    }
    nloc = mine > 0u ? mine : 1u; nx = cnt > 0u ? cnt : 1u;
}

__device__ __forceinline__ void xcd_barrier(const XcdBarrier& b, bool is_t0) {
    asm volatile("s_waitcnt vmcnt(0)" ::: "memory");
    __syncthreads();
    if (is_t0) {
        unsigned* bar = b.bar;
        __builtin_amdgcn_s_waitcnt(0);
        unsigned nloc = b.st[0], nx = b.st[1];
        if (nloc == 0u) { xcd_barrier_complete(bar, b.x, nloc, nx); b.st[0] = nloc; b.st[1] = nx; }
        const unsigned old = xb_add(&bar[XB_XSUB(b.x)], 1u);
        const unsigned gen = old / nloc;
        if (old + 1u == (gen + 1u) * nloc) {
            __builtin_amdgcn_fence(__ATOMIC_RELEASE, "agent");
            asm volatile("s_waitcnt vmcnt(0)" ::: "memory");
            const unsigned og = xb_add(&bar[XB_TOP], 1u);
            const unsigned tg = og / nx;
            if (og + 1u == (tg + 1u) * nx) xb_add(&bar[XB_TOPGEN], 1u);
            else XB_SPIN(xb_ld(&bar[XB_TOPGEN]) == tg, bar);
            __builtin_amdgcn_fence(__ATOMIC_ACQUIRE, "agent");
            xb_add(&bar[XB_XGEN(b.x)], 1u);
            asm volatile("s_waitcnt vmcnt(0)" ::: "memory");
        } else {
            XB_SPIN(xb_ld(&bar[XB_XGEN(b.x)]) == gen, bar);
            __builtin_amdgcn_fence(__ATOMIC_ACQUIRE, "agent");
            asm volatile("s_waitcnt vmcnt(0)" ::: "memory");
        }
    }
    __syncthreads();
}
constexpr int NWAVES = 8, NTHR = NWAVES * 64;
constexpr int MB = 2, MSEQ = 8192, MD = 1024, MT = MB * MSEQ;
constexpr float LOG2E = 1.4426950408889634f;
constexpr float QSCALE = 0.125f * LOG2E;
constexpr size_t MiB = 1u << 20;
constexpr size_t WS_CTL = 0, CTL_ZERO_BYTES = 1 * MiB;
constexpr size_t WS_WQKV = 1 * MiB;
constexpr size_t WS_WAO = 4 * MiB;
constexpr size_t WS_WGIN = 6 * MiB;
constexpr size_t WS_WAB = 14 * MiB;
constexpr size_t WS_WGO = 15 * MiB;
constexpr size_t WS_WR = 17 * MiB;
constexpr size_t WS_WGU = 18 * MiB;
constexpr size_t WS_WD = 50 * MiB;
constexpr size_t WS_XN = 66 * MiB;
constexpr size_t WS_LIST = 98 * MiB;
constexpr size_t WS_GLIST = 100 * MiB;
constexpr size_t WS_TOKSLOT = 102 * MiB;
constexpr size_t WS_H = 104 * MiB;
constexpr size_t WS_Y = 124 * MiB;
constexpr size_t WS_Q = 98 * MiB;
constexpr size_t WS_K = 130 * MiB;
constexpr size_t WS_V = 138 * MiB;
constexpr size_t WS_AO = 146 * MiB;
constexpr size_t WS_QKVPRE = 98 * MiB;
constexpr size_t WS_Z = 194 * MiB;
constexpr size_t WS_GB = 226 * MiB;
constexpr size_t WS_OF = 66 * MiB;
constexpr size_t WS_OB = 18 * MiB;
constexpr size_t WS_ON = 98 * MiB;
constexpr size_t WS_END = 285 * MiB;
constexpr int CW_TMO = 0, CW_CODE = 1, CW_BAR = 4096, CW_CNT = 16384;
constexpr int RING_OFF = 0, RING_BYTES = 153600, LDSCTL_OFF = RING_BYTES, MISC_OFF = LDSCTL_OFF + 320, MOETAB_OFF = LDSCTL_OFF + 1024, LDS_BYTES = 163840;

__device__ __forceinline__ float bf2f(unsigned short v) { return __uint_as_float((unsigned)v << 16); }
__device__ __forceinline__ float wsum(float v) {
#pragma unroll
    for (int o = 1; o < 64; o <<= 1) v += __shfl_xor(v, o);
    return v;
}
__device__ __forceinline__ float wmax(float v) {
#pragma unroll
    for (int o = 1; o < 64; o <<= 1) v = fmaxf(v, __shfl_xor(v, o));
    return v;
}
__device__ __forceinline__ float silu_f(float x) { return x * __builtin_amdgcn_rcpf(1.f + __expf(-x)); }
typedef unsigned u32x2_t __attribute__((ext_vector_type(2)));
__device__ __forceinline__ int opq(int x) { asm volatile("" : "+v"(x)); return x; }
__device__ __forceinline__ int lane_id() { return (int)__builtin_amdgcn_mbcnt_hi(~0u, __builtin_amdgcn_mbcnt_lo(~0u, 0u)); }
__device__ __forceinline__ int opqs(int x) { asm volatile("" : "+s"(x)); return x; }
#define PHASE_IDS(F) const int wave = opqs((F).wv), lane = opq(lane_id()), tid = wave * 64 + lane, gw = (F).gwb + wave; (void)tid; (void)lane; (void)wave; (void)gw

struct Ctx {
    LAS unsigned char* lds;
    volatile LAS unsigned* MISC;
    gu32* ctl;
    int G, gwb, NGW, wv;
    const float* in[21];
    float* out; unsigned char* ws;
};

template <class RowMap>
__device__ __forceinline__ void transpose_item(const float* W, int ldw, int K, bf16* WT, RowMap rm, LAS float* scr, int kb, int nb, int lane) {
    const int k0 = 64 * kb, n0 = 32 * nb;
#pragma unroll 8
    for (int i = 0; i < 32; ++i) { const int kk = 2 * i + (lane >> 5); scr[kk * 33 + (lane & 31)] = W[(size_t)(k0 + kk) * ldw + n0 + (lane & 31)]; }
    LDS_WAIT(); asm volatile("" ::: "memory");
    const int c = lane & 7;
#pragma unroll
    for (int j = 0; j < 4; ++j) { const int n = (lane >> 3) + 8 * j; const LAS float* s = scr + (8 * c) * 33 + n;
        v4u o; o.x = pk2(s[0 * 33], s[1 * 33]); o.y = pk2(s[2 * 33], s[3 * 33]); o.z = pk2(s[4 * 33], s[5 * 33]); o.w = pk2(s[6 * 33], s[7 * 33]);
        *(GAS v4u*)(WT + (size_t)rm(n0 + n) * K + k0 + 8 * c) = o; }
    LDS_WAIT(); asm volatile("" ::: "memory");
}
__device__ __forceinline__ void rms_row_to_bf16(const float* xrow, const float* g, bf16* orow, int lane) {
    const GAS f32x4* xr = (const GAS f32x4*)xrow + lane; const GAS f32x4* gr = (const GAS f32x4*)g + lane;
    f32x4 v[4]; float s = 0.f;
#pragma unroll
    for (int j = 0; j < 4; ++j) { v[j] = xr[64 * j]; s += (v[j].x * v[j].x + v[j].y * v[j].y) + (v[j].z * v[j].z + v[j].w * v[j].w); }
    const float rs = rsqrtf(wsum(s) * (1.f / MD) + 1e-6f);
    GAS unsigned long long* o8 = (GAS unsigned long long*)orow + lane;
#pragma unroll
    for (int j = 0; j < 4; ++j) { const f32x4 gg = gr[64 * j]; o8[64 * j] = (unsigned long long)pk2(v[j].x * rs * gg.x, v[j].y * rs * gg.y) | ((unsigned long long)pk2(v[j].z * rs * gg.z, v[j].w * rs * gg.w) << 32); }
}
__device__ __forceinline__ int qkv_rowmap(int c) { const int cl = c & 255; return (c & ~255) + ((cl >> 5) & 1) * 128 + (cl >> 6) * 32 + (cl & 31); }

__device__ __forceinline__ void moe_convert(Ctx& F, int layer, int widx, int wcnt) {
    PHASE_IDS(F);
    LAS float* scr = (LAS float*)(F.lds + RING_OFF + wave * 16384);
    const float* Wg = F.in[18] + (size_t)layer * 32 * MD * 256; const float* Wu = F.in[19] + (size_t)layer * 32 * MD * 256; const float* Wd = F.in[20] + (size_t)layer * 32 * 256 * MD;
    bf16* WGU = (bf16*)(F.ws + WS_WGU); bf16* WD = (bf16*)(F.ws + WS_WD);
    for (int it = widx; it < 32 * 384; it += wcnt) {
        const int e = it / 384, r = it % 384;
        if (r < 128) transpose_item(Wg + (size_t)e * MD * 256, 256, MD, WGU, [e](int f) { return e * 512 + ((f >> 7) << 8) + (f & 127); }, scr, r >> 3, r & 7, lane);
        else if (r < 256) transpose_item(Wu + (size_t)e * MD * 256, 256, MD, WGU, [e](int f) { return e * 512 + ((f >> 7) << 8) + 128 + (f & 127); }, scr, (r - 128) >> 3, (r - 128) & 7, lane);
        else transpose_item(Wd + (size_t)e * 256 * MD, MD, 256, WD, [e](int d) { return e * 1024 + d; }, scr, (r - 256) >> 5, (r - 256) & 31, lane);
    }
}
__device__ __forceinline__ void p0_prologue(Ctx& F) {
    PHASE_IDS(F);
    LAS float* scr = (LAS float*)(F.lds + RING_OFF + wave * 16384);
    constexpr int I_QKV = 16 * 48, I_AO = 16 * 32, I_GIN = 16 * 128, I_AB = 16, I_GO = 16 * 32;
    for (int it = gw; it < I_QKV + I_AO + I_GIN + I_AB + I_GO; it += F.NGW) {
        int r = it;
        if (r < I_QKV) { transpose_item(F.in[3], 1536, MD, (bf16*)(F.ws + WS_WQKV), [](int c) { return qkv_rowmap(c); }, scr, r / 48, r % 48, lane); continue; } r -= I_QKV;
        if (r < I_AO) { transpose_item(F.in[7], MD, MD, (bf16*)(F.ws + WS_WAO), [](int c) { return c; }, scr, r >> 5, r & 31, lane); continue; } r -= I_AO;
        if (r < I_GIN) { transpose_item(F.in[8], 4128, MD, (bf16*)(F.ws + WS_WGIN), [](int c) { return c; }, scr, r >> 7, r & 127, lane); continue; } r -= I_GIN;
        if (r < I_AB) { transpose_item(F.in[8], 4128, MD, (bf16*)(F.ws + WS_WAB), [](int c) { return c - 4096; }, scr, r, 128, lane); continue; } r -= I_AB;
        transpose_item(F.in[13], MD, MD, (bf16*)(F.ws + WS_WGO), [](int c) { return c; }, scr, r >> 5, r & 31, lane);
    }
    for (int layer = 0; layer < 2; ++layer) { bf16* wr = (bf16*)(F.ws + WS_WR + (size_t)layer * 131072); const float* wg = F.in[14] + (size_t)layer * MD * 4; const float* we = F.in[16] + (size_t)layer * MD * 32;
        for (int idx = gw * 64 + lane; idx < 48 * MD; idx += F.NGW * 64) { const int r = idx >> 10, k = idx & 1023;
            const float v = r < 4 ? wg[k * 4 + r] : (r < 36 ? we[k * 32 + (r - 4)] : 0.f); wr[idx] = (bf16)f2bf(v); } }
    moe_convert(F, 0, gw, F.NGW);
    for (int m = gw; m < MT; m += F.NGW) rms_row_to_bf16(F.in[0] + (size_t)m * MD, F.in[1], (bf16*)(F.ws + WS_XN) + (size_t)m * MD, lane);
}

__device__ __forceinline__ void attn_simple(Ctx& F) {
    PHASE_IDS(F);
    LAS float* qs = (LAS float*)(F.lds + RING_OFF + wave * 2048);
    LAS float* ps = qs + 64;
    const bf16* Q = (const bf16*)(F.ws + WS_Q); const bf16* K = (const bf16*)(F.ws + WS_K); const bf16* V = (const bf16*)(F.ws + WS_V); bf16* AO = (bf16*)(F.ws + WS_AO);
    const float* sink = F.in[6];
    for (int item = gw; item < MT * 16; item += F.NGW) {
        const int t = item >> 4, h = item & 15, b = t / MSEQ, tt = t % MSEQ, g = h >> 2;
        const float slope2 = exp2f(-8.0f * (float)(h + 1) / 16.0f) * LOG2E;
        qs[lane] = bf2f(Q[(size_t)t * 1024 + h * 64 + lane]);
        LDS_WAIT(); asm volatile("" ::: "memory");
        float sc[5]; bool valid[5]; float mx = -INFINITY;
#pragma unroll
        for (int i = 0; i < 5; ++i) {
            const int j = lane + 64 * i, s = tt - 128 + j;
            valid[i] = (j <= 256) && s >= 0 && s < MSEQ; sc[i] = -INFINITY;
            if (valid[i]) {
                const GAS v4u* kp = (const GAS v4u*)(K + (size_t)(b * MSEQ + s) * 256 + g * 64);
                float dot = 0.f;
#pragma unroll
                for (int d = 0; d < 8; ++d) { const v4u kv = kp[d];
                    dot += qs[8 * d + 0] * __uint_as_float(kv.x << 16) + qs[8 * d + 1] * __uint_as_float(kv.x & 0xffff0000u) + qs[8 * d + 2] * __uint_as_float(kv.y << 16) + qs[8 * d + 3] * __uint_as_float(kv.y & 0xffff0000u)
                         + qs[8 * d + 4] * __uint_as_float(kv.z << 16) + qs[8 * d + 5] * __uint_as_float(kv.z & 0xffff0000u) + qs[8 * d + 6] * __uint_as_float(kv.w << 16) + qs[8 * d + 7] * __uint_as_float(kv.w & 0xffff0000u); }
                const int dist = tt > s ? tt - s : s - tt;
                sc[i] = dot - slope2 * (float)dist; mx = fmaxf(mx, sc[i]);
            }
        }
        const float sk2 = sink[h] * LOG2E;
        const float m = fmaxf(wmax(mx), sk2);
        float psum = 0.f;
#pragma unroll
        for (int i = 0; i < 5; ++i) { const float p = valid[i] ? exp2f(sc[i] - m) : 0.f; ps[i * 64 + lane] = p; psum += p; }
        const float denom = wsum(psum) + exp2f(sk2 - m);
        LDS_WAIT(); asm volatile("" ::: "memory");
        float acc = 0.f;
        for (int j = 0; j <= 256; ++j) { const int s = tt - 128 + j; if (s >= 0 && s < MSEQ) acc += ps[j] * bf2f(V[(size_t)(b * MSEQ + s) * 256 + g * 64 + lane]); }
        AO[(size_t)t * 1024 + h * 64 + lane] = (bf16)f2bf(acc / denom);
        LDS_WAIT(); asm volatile("" ::: "memory");
    }
}

__device__ __forceinline__ void moe_tables(Ctx& F, int layer, int npn) {
    PHASE_IDS(F);
    LAS int* tab = (LAS int*)(F.lds + MOETAB_OFF);
    __syncthreads();
    if (tid < 32) tab[tid] = (int)__hip_atomic_load(F.ctl + CW_CNT + 64 * layer + tid, RLX_AGENT);
    __syncthreads();
    if (tid == 0) { int seg = 0, ub = 0; for (int e = 0; e < 32; ++e) { tab[32 + e] = seg; tab[65 + e] = ub; const int mt = (tab[e] + 255) >> 8; seg += mt << 8; ub += mt * npn; } tab[64] = seg; tab[97] = ub; }
    __syncthreads();
}
__device__ __forceinline__ void wg_self_visible(Ctx& F) {
    PHASE_IDS(F);
    VM_WAIT(); __syncthreads();
    if (tid == 0) { __builtin_amdgcn_fence(__ATOMIC_ACQUIRE, "agent"); VM_WAIT(); }
    __syncthreads();
}
__device__ __forceinline__ void p4_router(Ctx& F, int layer) {
    PHASE_IDS(F);
    const float* X = F.out; const float* g = F.in[2] + (size_t)layer * MD; bf16* XN = (bf16*)(F.ws + WS_XN);
    const bf16* Wr = (const bf16*)(F.ws + WS_WR + (size_t)layer * 131072);
    const float* bg = F.in[15] + layer * 4; const float* be = F.in[17] + layer * 32;
    gu32* cnt = F.ctl + CW_CNT + 64 * layer;
    int* list = (int*)(F.ws + WS_LIST); float* glist = (float*)(F.ws + WS_GLIST); int* tokslot = (int*)(F.ws + WS_TOKSLOT);
    LAS float* lg = (LAS float*)(F.lds + RING_OFF);
    const int w = wave, fr = lane & 15, fq = lane >> 4;
    for (int rb = blockIdx.x; rb < MT / 64; rb += F.G) {
        const int row0 = rb * 64;
        for (int r = 0; r < 8; ++r) { const size_t row = (size_t)(row0 + 8 * w + r); rms_row_to_bf16(X + row * MD, g, XN + row * MD, lane); }
        wg_self_visible(F);
        if (w < 4) {
            pg8::f32x4 acc[3] = {{0.f, 0.f, 0.f, 0.f}, {0.f, 0.f, 0.f, 0.f}, {0.f, 0.f, 0.f, 0.f}};
            const bf16* arow = XN + (size_t)(row0 + 16 * w + fr) * MD + 8 * fq; const bf16* brow = Wr + (size_t)fr * MD + 8 * fq;
#pragma unroll 4
            for (int ks = 0; ks < 32; ++ks) {
                const bf16x8 a = *(const GAS bf16x8*)(arow + 32 * ks);
#pragma unroll
                for (int nt = 0; nt < 3; ++nt) { const bf16x8 b = *(const GAS bf16x8*)(brow + (size_t)nt * 16 * MD + 32 * ks); acc[nt] = __builtin_amdgcn_mfma_f32_16x16x32_bf16(b, a, acc[nt], 0, 0, 0); }
            }
#pragma unroll
            for (int nt = 0; nt < 3; ++nt)
#pragma unroll
                for (int r = 0; r < 4; ++r) lg[(16 * w + fr) * 49 + 16 * nt + 4 * fq + r] = acc[nt][r];
        }
        __syncthreads();
        if (tid < 64) {
            const LAS float* l = lg + tid * 49; const int tok = row0 + tid;
            float gl[4]; for (int i = 0; i < 4; ++i) gl[i] = l[i] + bg[i];
            int gi = 0; float gm = gl[0];
            for (int i = 1; i < 4; ++i) if (gl[i] > gm) { gm = gl[i]; gi = i; }
            float gs = 0.f; for (int i = 0; i < 4; ++i) gs += __expf(gl[i] - gm);
            const float gprob = 1.f / gs;
            int e1 = 0, e2 = -1; float m1 = -INFINITY, m2 = -INFINITY;
            for (int i = 0; i < 8; ++i) { const float v = l[4 + gi * 8 + i] + be[gi * 8 + i]; if (v > m1) { m2 = m1; e2 = e1; m1 = v; e1 = i; } else if (v > m2) { m2 = v; e2 = i; } }
            const float p2 = __expf(m2 - m1), inv = 1.f / (1.f + p2);
            const int x1 = gi * 8 + e1, x2 = gi * 8 + e2;
            const unsigned pos1 = __hip_atomic_fetch_add(cnt + x1, 1u, RLX_AGENT), pos2 = __hip_atomic_fetch_add(cnt + x2, 1u, RLX_AGENT);
            list[x1 * 16384 + pos1] = tok; glist[x1 * 16384 + pos1] = gprob * inv;
            list[x2 * 16384 + pos2] = tok; glist[x2 * 16384 + pos2] = gprob * p2 * inv;
            tokslot[tok * 2] = (x1 << 16) | (int)pos1; tokslot[tok * 2 + 1] = (x2 << 16) | (int)pos2;
        }
        __syncthreads();
    }
}
template <bool NEXT>
__device__ __forceinline__ void p7_combine(Ctx& F) {
    PHASE_IDS(F);
    const LAS int* tab = (const LAS int*)(F.lds + MOETAB_OFF);
    const int* tokslot = (const int*)(F.ws + WS_TOKSLOT); const bf16* Y = (const bf16*)(F.ws + WS_Y); float* X = F.out;
    bf16* XN = (bf16*)(F.ws + WS_XN); const float* gn = F.in[1] + MD;
    const int w = wave, fr = lane & 15, fq = lane >> 4;
    for (int rb = blockIdx.x; rb < MT / 64; rb += F.G) {
        const int row0 = rb * 64;
        for (int r = 0; r < 8; ++r) {
            const int t = row0 + 8 * w + r;
            const int s0 = tokslot[t * 2], s1 = tokslot[t * 2 + 1];
            const size_t y0 = (size_t)(tab[32 + (s0 >> 16)] + (s0 & 0xffff)), y1 = (size_t)(tab[32 + (s1 >> 16)] + (s1 & 0xffff));
            GAS f32x4* xr = (GAS f32x4*)(X + (size_t)t * MD) + lane;
            const GAS u32x2_t* a = (const GAS u32x2_t*)(Y + y0 * MD) + lane; const GAS u32x2_t* b = (const GAS u32x2_t*)(Y + y1 * MD) + lane;
            f32x4 v[4]; float ss = 0.f;
#pragma unroll
            for (int j = 0; j < 4; ++j) { v[j] = xr[64 * j]; const u32x2_t p = a[64 * j], q = b[64 * j];
                v[j].x += __uint_as_float(p.x << 16) + __uint_as_float(q.x << 16); v[j].y += __uint_as_float(p.x & 0xffff0000u) + __uint_as_float(q.x & 0xffff0000u);
                v[j].z += __uint_as_float(p.y << 16) + __uint_as_float(q.y << 16); v[j].w += __uint_as_float(p.y & 0xffff0000u) + __uint_as_float(q.y & 0xffff0000u);
                xr[64 * j] = v[j]; ss += (v[j].x * v[j].x + v[j].y * v[j].y) + (v[j].z * v[j].z + v[j].w * v[j].w); }
            if constexpr (NEXT) {
                const float rs = rsqrtf(wsum(ss) * (1.f / MD) + 1e-6f);
                GAS unsigned long long* o8 = (GAS unsigned long long*)(XN + (size_t)t * MD) + lane; const GAS f32x4* gr = (const GAS f32x4*)gn + lane;
#pragma unroll
                for (int j = 0; j < 4; ++j) { const f32x4 gg = gr[64 * j]; o8[64 * j] = (unsigned long long)pk2(v[j].x * rs * gg.x, v[j].y * rs * gg.y) | ((unsigned long long)pk2(v[j].z * rs * gg.z, v[j].w * rs * gg.w) << 32); }
            }
        }
        if constexpr (NEXT) {
            wg_self_visible(F);
            if (w < 4) {
                const bf16* Wab = (const bf16*)(F.ws + WS_WAB); float* GB = (float*)(F.ws + WS_GB);
                pg8::f32x4 acc[2] = {{0.f, 0.f, 0.f, 0.f}, {0.f, 0.f, 0.f, 0.f}};
                const bf16* arow = XN + (size_t)(row0 + 16 * w + fr) * MD + 8 * fq; const bf16* brow = Wab + (size_t)fr * MD + 8 * fq;
#pragma unroll 4
                for (int ks = 0; ks < 32; ++ks) {
                    const bf16x8 a = *(const GAS bf16x8*)(arow + 32 * ks);
#pragma unroll
                    for (int nt = 0; nt < 2; ++nt) { const bf16x8 b = *(const GAS bf16x8*)(brow + (size_t)nt * 16 * MD + 32 * ks); acc[nt] = __builtin_amdgcn_mfma_f32_16x16x32_bf16(b, a, acc[nt], 0, 0, 0); }
                }
                const int tok = row0 + 16 * w + fr;
#pragma unroll
                for (int r = 0; r < 4; ++r) { const int c = 4 * fq + r;
                    const float xx = acc[0][r] + F.in[11][c]; const float sp = fmaxf(xx, 0.f) + log1pf(__expf(-fabsf(xx)));
                    GB[(size_t)tok * 32 + c] = -__expf(F.in[10][c]) * sp;
                    GB[(size_t)tok * 32 + 16 + c] = 1.f / (1.f + __expf(-acc[1][r])); }
            }
        }
    }
}

__device__ __forceinline__ void gdn_scan_naive(Ctx& F) {
    PHASE_IDS(F);
    constexpr int TS = 16;
    const int sq = blockIdx.x, b = sq >> 4, h = (sq >> 1) & 7, dir = sq & 1, w = wave;
    LAS float* qs = (LAS float*)(F.lds + RING_OFF);
    LAS float* red = qs + 3 * TS * 128;
    const bf16* pre = (const bf16*)(F.ws + WS_QKVPRE) + (size_t)b * MSEQ * 3072;
    const float* GB = (const float*)(F.ws + WS_GB) + (size_t)b * MSEQ * 32;
    bf16* od = (bf16*)(F.ws + (dir ? WS_OB : WS_OF)) + (size_t)b * MSEQ * MD;
    const float* convw = F.in[9];
    const int wh = tid >> 7, j = tid & 127;
    float cw[4] = {0.f, 0.f, 0.f, 0.f};
    if (tid < 384) {
#pragma unroll
        for (int jj = 0; jj < 4; ++jj) cw[jj] = convw[jj * 3072 + wh * 1024 + h * 128 + j]; }
    LAS float* kspart = red + 2 * TS;
    LAS float* opart = kspart + 2 * 4 * 128;
    const int part = tid >> 7, jc = tid & 127;
    float St[32];
#pragma unroll
    for (int i = 0; i < 32; ++i) St[i] = 0.f;
    for (int tile = 0; tile < MSEQ / TS; ++tile) {
        __syncthreads();
        if (tid < 384) {
            for (int st = 0; st < TS; ++st) {
                const int n = tile * TS + st, t = dir ? MSEQ - 1 - n : n;
                float a = 0.f;
#pragma unroll
                for (int jj = 0; jj < 4; ++jj) { const int tt = t + jj - 2; if (tt >= 0 && tt < MSEQ) a += cw[jj] * bf2f(pre[(size_t)tt * 3072 + wh * 1024 + h * 128 + j]); }
                qs[(wh * TS + st) * 128 + j] = silu_f(a);
            }
        }
        __syncthreads();
        for (int rr = w; rr < 2 * TS; rr += NWAVES) { const int which = rr & 1, st = rr >> 1; const float a0 = qs[(which * TS + st) * 128 + lane], a1 = qs[(which * TS + st) * 128 + lane + 64];
            const float ss = wsum(a0 * a0 + a1 * a1); if (lane == 0) red[which * TS + st] = ss; }
        __syncthreads();
        for (int st = 0; st < TS; ++st) {
            const float qn = rsqrtf(red[st] + 1e-6f) * 0.08838834764831845f, kn = rsqrtf(red[TS + st] + 1e-6f);
            const int n = tile * TS + st, t = dir ? MSEQ - 1 - n : n;
            const float gg = GB[(size_t)t * 32 + dir * 8 + h], beta = GB[(size_t)t * 32 + 16 + dir * 8 + h];
            const float dec = __expf(gg);
            const LAS float* kk = qs + (TS + st) * 128 + 32 * part; const LAS float* qq = qs + st * 128 + 32 * part;
            float ksp = 0.f;
#pragma unroll
            for (int i = 0; i < 32; ++i) ksp += kk[i] * St[i];
            kspart[((st & 1) * 4 + part) * 128 + jc] = ksp;
            __syncthreads();
            const LAS float* kp = kspart + (st & 1) * 4 * 128 + jc;
            const float kS = ((kp[0] + kp[128]) + (kp[256] + kp[384])) * kn * dec;
            const float vn = beta * (qs[(2 * TS + st) * 128 + jc] - kS) * kn;
            float ov = 0.f;
#pragma unroll
            for (int i = 0; i < 32; ++i) { St[i] = dec * St[i] + kk[i] * vn; ov += qq[i] * St[i]; }
            opart[(st * 4 + part) * 128 + jc] = ov * qn;
        }
        __syncthreads();
        for (int e = tid; e < TS * 128; e += NTHR) { const int st = e >> 7, c = e & 127; const LAS float* op = opart + st * 4 * 128 + c;
            const int n = tile * TS + st, t = dir ? MSEQ - 1 - n : n;
            od[(size_t)t * MD + h * 128 + c] = (bf16)f2bf((op[0] + op[128]) + (op[256] + op[384])); }
    }
}
__device__ __forceinline__ void gdn_gate(Ctx& F) {
    PHASE_IDS(F);
    const unsigned* of = (const unsigned*)(F.ws + WS_OF); const unsigned* ob = (const unsigned*)(F.ws + WS_OB); const unsigned* z = (const unsigned*)(F.ws + WS_Z);
    unsigned* on = (unsigned*)(F.ws + WS_ON); const float* og = F.in[12];
    const float g0 = og[2 * lane], g1 = og[2 * lane + 1];
    for (int it = gw; it < MT * 8; it += F.NGW) {
        const size_t idx = (size_t)it * 64 + lane;
        const unsigned a = of[idx], bb = ob[idx], zz = z[idx];
        const float o0 = __uint_as_float(a << 16) + __uint_as_float(bb << 16), o1 = __uint_as_float(a & 0xffff0000u) + __uint_as_float(bb & 0xffff0000u);
        const float rs = rsqrtf(wsum(o0 * o0 + o1 * o1) * (1.f / 128.f) + 1e-6f);
        on[idx] = pk2(o0 * rs * g0 * silu_f(__uint_as_float(zz << 16)), o1 * rs * g1 * silu_f(__uint_as_float(zz & 0xffff0000u)));
    }
}

constexpr size_t WS_HALO = 228 * MiB;
constexpr size_t WS_REC = 233 * MiB;
constexpr int REC_BYTES = 13312;
constexpr int PQT = 0, PKT = 17408, PSC = 34816, PLB = 36864, PLB_STRIDE = 8704;
typedef short v4i16_t __attribute__((ext_vector_type(4)));

__device__ __forceinline__ int tri_off(int i) { const int a = (i - 1) >> 2, r = (i - 1) & 3; return 4 * (a + 1) * (2 * a + r); }
__device__ __forceinline__ int img_off(int i, int j) {
    const int mt = i >> 4, ks = j >> 5, f = mt < 2 ? mt : 2 + (mt - 2) * 2 + ks, cc = j & 31, g = (cc & 15) >> 2, jj = (cc & 3) + ((cc >> 4) << 2);
    return f * 1024 + ((g * 16 + (i & 15)) * 8 + jj) * 2;
}
__device__ __forceinline__ void gdn_prep(Ctx& F) {
    PHASE_IDS(F);
    LAS unsigned char* L = F.lds + RING_OFF;
    bf16* QKV = (bf16*)(F.ws + WS_QKVPRE); const bf16* HALO = (const bf16*)(F.ws + WS_HALO); const float* GB = (const float*)(F.ws + WS_GB);
    unsigned char* REC = F.ws + WS_REC; const float* convw = F.in[9];
    for (int batch = blockIdx.x; batch < 512; batch += F.G) {
        const int b = batch >> 8, h = (batch >> 5) & 7, n0 = (batch & 31) * 4;
#pragma unroll 1
        for (int c4 = 0; c4 < 4; ++c4) {
            const int n = n0 + c4, t0 = n * 64;
            const int tidc = opq(tid), lanec = tidc & 63, g4 = lanec >> 4, l16 = lanec & 15;
            const int rg = tidc / 48, rem = tidc - 48 * rg, which = rem >> 4, c16 = rem & 15;
            const int col = which * 1024 + h * 128 + c16 * 8;
            v4u in[11];
            if (tidc < 384) {
#pragma unroll
                for (int ri = 0; ri < 11; ++ri) { const int lr = 8 * rg - 2 + ri; const bf16* src = nullptr;
                    if (lr >= 0 && lr < 64) src = QKV + ((size_t)(b * MSEQ + t0 + lr) * 3072 + col);
                    else if (lr < 0) { if (n > 0) src = HALO + ((size_t)((b * 128 + n - 1) * 3 + (lr + 3)) * 3072 + col); }
                    else { if (n < 127) src = HALO + ((size_t)((b * 128 + n + 1) * 3) * 3072 + col); }
                    in[ri] = src ? *(const GAS v4u*)src : (v4u){0u, 0u, 0u, 0u}; }
            }
            __syncthreads();
            if (tidc < 384) {
                float cw[4][8];
#pragma unroll
                for (int jj = 0; jj < 4; ++jj) { const GAS f32x4* p = (const GAS f32x4*)(convw + jj * 3072 + col); const f32x4 a = p[0], bq = p[1];
                    cw[jj][0] = a.x; cw[jj][1] = a.y; cw[jj][2] = a.z; cw[jj][3] = a.w; cw[jj][4] = bq.x; cw[jj][5] = bq.y; cw[jj][6] = bq.z; cw[jj][7] = bq.w; }
#pragma unroll
                for (int r = 0; r < 8; ++r) {
                    float o[8];
#pragma unroll
                    for (int c = 0; c < 8; ++c) o[c] = 0.f;
#pragma unroll
                    for (int jj = 0; jj < 4; ++jj) { const v4u x = in[r + jj];
                        o[0] += cw[jj][0] * __uint_as_float(x.x << 16); o[1] += cw[jj][1] * __uint_as_float(x.x & 0xffff0000u);
                        o[2] += cw[jj][2] * __uint_as_float(x.y << 16); o[3] += cw[jj][3] * __uint_as_float(x.y & 0xffff0000u);
                        o[4] += cw[jj][4] * __uint_as_float(x.z << 16); o[5] += cw[jj][5] * __uint_as_float(x.z & 0xffff0000u);
                        o[6] += cw[jj][6] * __uint_as_float(x.w << 16); o[7] += cw[jj][7] * __uint_as_float(x.w & 0xffff0000u); }
                    float ss = 0.f;
#pragma unroll
                    for (int c = 0; c < 8; ++c) { o[c] = silu_f(o[c]); ss += o[c] * o[c]; }
                    ss += __shfl_xor(ss, 1); ss += __shfl_xor(ss, 2); ss += __shfl_xor(ss, 4); ss += __shfl_xor(ss, 8);
                    const float sc = which == 0 ? rsqrtf(ss + 1e-6f) * 0.08838834764831845f : (which == 1 ? rsqrtf(ss + 1e-6f) : 1.f);
                    v4u w; w.x = pk2(o[0] * sc, o[1] * sc); w.y = pk2(o[2] * sc, o[3] * sc); w.z = pk2(o[4] * sc, o[5] * sc); w.w = pk2(o[6] * sc, o[7] * sc);
                    const int lr = 8 * rg + r;
                    *(GAS v4u*)(QKV + ((size_t)(b * MSEQ + t0 + lr) * 3072 + col)) = w;
                    if (which < 2) *(LAS v4u*)(L + (which ? PKT : PQT) + lr * 272 + c16 * 16) = w;
                }
            }
            if (wave < 2) {
                const int dir = wave, lane = lanec, tok = b * MSEQ + t0 + (dir ? 63 - lane : lane);
                const float gv = GB[(size_t)tok * 32 + dir * 8 + h], bv = GB[(size_t)tok * 32 + 16 + dir * 8 + h];
                float x = gv;
#pragma unroll
                for (int o = 1; o < 64; o <<= 1) { const float t = __shfl_up(x, o); if (lane >= o) x += t; }
                const float gl = __shfl(x, 63);
                LAS float* sc = (LAS float*)(L + PSC);
                sc[dir * 64 + lane] = x; sc[128 + dir * 64 + lane] = bv;
                float* rs = (float*)(REC + (size_t)((((b * 8 + h) * 2 + dir) * 128) + n) * REC_BYTES + 12288);
                const float eg = __expf(x);
                rs[lane] = bv * eg; rs[64 + lane] = bv; rs[128 + lane] = eg; rs[192 + lane] = __expf(gl - x);
            }
            __syncthreads();
            {
                const int m = wave >> 2, mt = wave & 3;
                const LAS float* sc = (const LAS float*)(L + PSC);
                bf16x8 afr[4];
#pragma unroll
                for (int ks = 0; ks < 4; ++ks) afr[ks] = *(const LAS bf16x8*)(L + (m ? PQT : PKT) + (16 * mt + l16) * 272 + (32 * ks + 8 * g4) * 2);
                LAS float* Lb0 = (LAS float*)(L + PLB + (c4 * 2) * PLB_STRIDE); LAS float* Lb1 = (LAS float*)(L + PLB + (c4 * 2 + 1) * PLB_STRIDE);
                bf16* im0 = (bf16*)(REC + (size_t)((((b * 8 + h) * 2 + 0) * 128) + n) * REC_BYTES + 6144);
                bf16* im1 = (bf16*)(REC + (size_t)((((b * 8 + h) * 2 + 1) * 128) + n) * REC_BYTES + 6144);
#pragma unroll
                for (int nt = 0; nt < 4; ++nt) {
                    pg8::f32x4 acc = {0.f, 0.f, 0.f, 0.f};
#pragma unroll
                    for (int ks = 0; ks < 4; ++ks) { const bf16x8 bfr = *(const LAS bf16x8*)(L + PKT + (16 * nt + l16) * 272 + (32 * ks + 8 * g4) * 2);
                        acc = __builtin_amdgcn_mfma_f32_16x16x32_bf16(afr[ks], bfr, acc, 0, 0, 0); }
                    const int j = 16 * nt + l16, jp = 63 - j;
                    const float gc0j = sc[j], gc1jp = sc[64 + jp];
#pragma unroll
                    for (int r = 0; r < 4; ++r) { const int i = 16 * mt + 4 * g4 + r, ip = 63 - i; const float val = acc[r];
                        if (m == 0) {
                            if (i > j) Lb0[tri_off(i) + j] = sc[128 + i] * val * __expf(sc[i] - gc0j);
                            else if (i < j) Lb1[tri_off(ip) + jp] = sc[192 + ip] * val * __expf(sc[64 + ip] - gc1jp);
                        } else {
                            if ((j >> 5) <= (i >> 5)) im0[img_off(i, j) >> 1] = (bf16)f2bf(i >= j ? val * __expf(sc[i] - gc0j) : 0.f);
                            if ((jp >> 5) <= (ip >> 5)) im1[img_off(ip, jp) >> 1] = (bf16)f2bf(ip >= jp ? val * __expf(sc[64 + ip] - gc1jp) : 0.f);
                        }
                    }
                }
            }
        }
        __syncthreads();
        {
            const int c4 = wave >> 1, dir = wave & 1, n = n0 + c4, lane = opq(tid) & 63;
            LAS float* Lb = (LAS float*)(L + PLB + wave * PLB_STRIDE);
            float x[64];
#pragma unroll
            for (int i = 0; i < 64; ++i) {
                const int off = tri_off(i);
                int dep = 0; if (i > 0) asm volatile("" : "+v"(dep) : "v"(x[i > 0 ? i - 1 : 0]));
                const LAS float* Lr = Lb + off + dep;
                float a0 = (i == lane) ? 1.f : 0.f, a1 = 0.f, a2 = 0.f, a3 = 0.f;
#pragma unroll
                for (int jb = 0; jb < (i + 3) / 4; ++jb) { const f32x4 l4 = *(const LAS f32x4*)(Lr + 4 * jb);
                    if (4 * jb + 0 < i) a0 -= l4.x * x[4 * jb + 0];
                    if (4 * jb + 1 < i) a1 -= l4.y * x[4 * jb + 1];
                    if (4 * jb + 2 < i) a2 -= l4.z * x[4 * jb + 2];
                    if (4 * jb + 3 < i) a3 -= l4.w * x[4 * jb + 3]; }
                x[i] = (a0 + a1) + (a2 + a3);
            }
            LDS_WAIT(); asm volatile("" ::: "memory");
            LAS bf16* stg = (LAS bf16*)Lb;
            const int cc = lane & 31, gq = (cc & 15) >> 2, jj = (cc & 3) + ((cc >> 4) << 2), ksl = lane >> 5;
#pragma unroll
            for (int i = 0; i < 64; ++i) { const int mt = i >> 4;
                if (ksl <= (i >> 5)) { const int f = mt < 2 ? mt : 2 + (mt - 2) * 2 + ksl; stg[f * 512 + (gq * 16 + (i & 15)) * 8 + jj] = (bf16)f2bf(x[i]); } }
            LDS_WAIT(); asm volatile("" ::: "memory");
            unsigned char* rec = REC + (size_t)((((b * 8 + h) * 2 + dir) * 128) + n) * REC_BYTES;
#pragma unroll
            for (int it = 0; it < 6; ++it) *(GAS v4u*)(rec + (it * 64 + lane) * 16) = *(const LAS v4u*)((LAS unsigned char*)Lb + (it * 64 + lane) * 16);
            LDS_WAIT(); asm volatile("" ::: "memory");
        }
        __syncthreads();
    }
}

constexpr int SKT = 0, SQT = 16384, SVT = 32768, SRC = 36864, SBUF = 50176;
__device__ __forceinline__ void glds16_asm(const void* gsrc, unsigned lds_dst) { unsigned keep;
    asm volatile("s_mov_b32 %0, m0\n\ts_mov_b32 m0, %2\n\ts_nop 0\n\tglobal_load_lds_dwordx4 %1, off\n\ts_mov_b32 m0, %0" : "=&s"(keep) : "v"(gsrc), "s"(lds_dst) : "memory"); }
__device__ __forceinline__ int kswz(int row) { return ((row & 7) << 1) | ((row >> 3) & 1); }
__device__ __forceinline__ void gdn_scan(Ctx& F) {
    PHASE_IDS(F);
    if (blockIdx.x >= 128) return;
    const int xcd = blockIdx.x & 7, idx = blockIdx.x >> 3, sp = idx & 3, sq = xcd * 4 + (idx >> 2), b = sq >> 4, h = (sq >> 1) & 7, dir = sq & 1;
    LAS unsigned char* L = F.lds + RING_OFF;
    const bf16* QKV = (const bf16*)(F.ws + WS_QKVPRE) + (size_t)b * MSEQ * 3072 + h * 128;
    const unsigned char* REC = F.ws + WS_REC + (size_t)(((b * 8 + h) * 2 + dir) * 128) * REC_BYTES;
    bf16* od = (bf16*)(F.ws + (dir ? WS_OB : WS_OF)) + (size_t)b * MSEQ * MD + h * 128 + sp * 32;
    const int g4 = lane >> 4, l16 = lane & 15;
    const unsigned lbase = (unsigned)(size_t)L;
    auto issue = [&](int s) {
        const int n = dir ? 127 - s : s, t0 = n * 64;
        const int ln = opq(lane), lg4 = ln >> 4, ll16 = ln & 15;
#pragma unroll
        for (int k = 0; k < 7; ++k) { const int d = wave + 8 * k; if (d >= 49) break;
            const void* src;
            if (d < 32) { const int dd = d & 15, row = 4 * dd + lg4, G = ll16 ^ kswz(row), tok = t0 + (dir ? 63 - row : row);
                src = QKV + (size_t)tok * 3072 + (d < 16 ? 1024 : 0) + G * 8; }
            else if (d < 36) { const int row = 16 * (d - 32) + (ln >> 2), tok = t0 + (dir ? 63 - row : row);
                src = QKV + (size_t)tok * 3072 + 2048 + sp * 32 + (ln & 3) * 8; }
            else src = REC + (size_t)n * REC_BYTES + (d - 36) * 1024 + ln * 16;
            const int loff = d < 16 ? SKT + d * 1024 : (d < 32 ? SQT + (d - 16) * 1024 : (d < 36 ? SVT + (d - 32) * 1024 : SRC + (d - 36) * 1024));
            glds16_asm(src, (unsigned)__builtin_amdgcn_readfirstlane((int)(lbase + (unsigned)((s % 3) * SBUF + loff)))); }
    };
    pg8::f32x4 S[8]; bf16x8 Sb[4];
#pragma unroll
    for (int i = 0; i < 8; ++i) S[i] = (pg8::f32x4){0.f, 0.f, 0.f, 0.f};
#pragma unroll
    for (int i = 0; i < 4; ++i) Sb[i] = (bf16x8){0, 0, 0, 0, 0, 0, 0, 0};
    unsigned baseA[4], baseE[4];
    { const int fA = kswz(l16), rl = 4 * g4 + (l16 >> 2), fE = kswz(rl);
#pragma unroll
      for (int k = 0; k < 4; ++k) { baseA[k] = (unsigned)(l16 * 256 + (((4 * k + g4) ^ fA) << 4)); baseE[k] = (unsigned)(rl * 256 + (((4 * k + (l16 & 3)) ^ fE) << 4)); } }
    const unsigned baseV = (unsigned)(SVT + 4 * g4 * 64 + (16 * wave + l16) * 2), baseS = (unsigned)(SRC + 12288 + 16 * g4), baseI = (unsigned)(SRC + lane * 16), baseO = (unsigned)(SVT + lane * 64 + wave * 32);
    issue(0); issue(1);
    if (wave == 0) asm volatile("s_waitcnt vmcnt(7)" ::: "memory"); else asm volatile("s_waitcnt vmcnt(6)" ::: "memory");
    __builtin_amdgcn_s_barrier();
    v4u ost0 = {0u, 0u, 0u, 0u}, ost1 = {0u, 0u, 0u, 0u};
    for (int s = 0; s <= 128; ++s) {
        if (wave < 2 && s > 0) { const int n = dir ? 128 - s : s - 1, tok = n * 64 + (dir ? 63 - lane : lane);
            GAS v4u* op = (GAS v4u*)(od + (size_t)tok * MD + 16 * wave); op[0] = ost0; op[1] = ost1; }
        if (s == 128) break;
        if (s + 2 < 128) issue(s + 2);
        if (wave < 2) {
            const LAS unsigned char* buf = L + (s % 3) * SBUF;
            auto pack = [&](const pg8::f32x4& a, const pg8::f32x4& c) -> bf16x8 { v4u t; t.x = pk2(a[0], a[1]); t.y = pk2(a[2], a[3]); t.z = pk2(c[0], c[1]); t.w = pk2(c[2], c[3]); return __builtin_bit_cast(bf16x8, t); };
#define SCAN_F() __builtin_amdgcn_sched_barrier(0)
#define SCAN_LD(FK, FQ, mt) do { _Pragma("unroll") for (int ks = 0; ks < 4; ++ks) { FK[ks] = *(const LAS bf16x8*)(buf + baseA[ks] + SKT + (mt) * 4096); FQ[ks] = *(const LAS bf16x8*)(buf + baseA[ks] + SQT + (mt) * 4096); } } while (0)
#define SCAN_MM(FK, FQ, mt) do { P[mt] = (pg8::f32x4){0.f, 0.f, 0.f, 0.f}; O[mt] = (pg8::f32x4){0.f, 0.f, 0.f, 0.f}; _Pragma("unroll") for (int ks = 0; ks < 4; ++ks) { \
                P[mt] = __builtin_amdgcn_mfma_f32_16x16x32_bf16(FK[ks], Sb[ks], P[mt], 0, 0, 0); O[mt] = __builtin_amdgcn_mfma_f32_16x16x32_bf16(FQ[ks], Sb[ks], O[mt], 0, 0, 0); } } while (0)
#define SCAN_LDE(E, dt) do { _Pragma("unroll") for (int ks = 0; ks < 2; ++ks) { const LAS unsigned char* a0_ = buf + baseE[(dt) >> 1] + SKT + ks * 8192 + ((dt) & 1) * 8; \
                E[2 * ks] = __builtin_amdgcn_ds_read_tr16_b64_v4i16((LAS v4i16_t*)a0_); E[2 * ks + 1] = __builtin_amdgcn_ds_read_tr16_b64_v4i16((LAS v4i16_t*)(a0_ + 4096)); } } while (0)
#define SCAN_MME(E, dt) do { pg8::f32x4 acc_ = S[dt] * dd; _Pragma("unroll") for (int ks = 0; ks < 2; ++ks) { const bf16x8 afr_ = {E[2 * ks][0], E[2 * ks][1], E[2 * ks][2], E[2 * ks][3], E[2 * ks + 1][0], E[2 * ks + 1][1], E[2 * ks + 1][2], E[2 * ks + 1][3]}; \
                acc_ = __builtin_amdgcn_mfma_f32_16x16x32_bf16(afr_, vsb[ks], acc_, 0, 0, 0); } S[dt] = acc_; } while (0)
            pg8::f32x4 P[4], O[4];
            bf16x8 fk0[4], fq0[4], fk1[4], fq1[4];
            SCAN_LD(fk0, fq0, 0); SCAN_F();
            SCAN_LD(fk1, fq1, 1); SCAN_F(); SCAN_MM(fk0, fq0, 0);
            SCAN_LD(fk0, fq0, 2); SCAN_F(); SCAN_MM(fk1, fq1, 1);
            SCAN_LD(fk1, fq1, 3); SCAN_F(); SCAN_MM(fk0, fq0, 2);
            f32x4 cv[4], bv[4]; unsigned short vv[4][4]; bf16x8 Tf[6];
#pragma unroll
            for (int mt = 0; mt < 4; ++mt) { cv[mt] = *(const LAS f32x4*)(buf + baseS + mt * 64); bv[mt] = *(const LAS f32x4*)(buf + baseS + 256 + mt * 64);
#pragma unroll
                for (int r = 0; r < 4; ++r) vv[mt][r] = *(const LAS unsigned short*)(buf + baseV + mt * 1024 + r * 64); }
#pragma unroll
            for (int f = 0; f < 6; ++f) Tf[f] = *(const LAS bf16x8*)(buf + baseI + f * 1024);
            SCAN_F(); SCAN_MM(fk1, fq1, 3);
            f32x4 egv[4], ekv[4]; bf16x8 If[6]; v4i16_t e0[4], e1[4];
#pragma unroll
            for (int mt = 0; mt < 4; ++mt) { egv[mt] = *(const LAS f32x4*)(buf + baseS + 512 + mt * 64); ekv[mt] = *(const LAS f32x4*)(buf + baseS + 768 + mt * 64); }
#pragma unroll
            for (int f = 0; f < 6; ++f) If[f] = *(const LAS bf16x8*)(buf + baseI + 6144 + f * 1024);
            const float dd = *(const LAS float*)(buf + SRC + 12288 + 4 * (128 + 63));
            SCAN_LDE(e0, 0);
            SCAN_F();
            pg8::f32x4 R[4];
#pragma unroll
            for (int mt = 0; mt < 4; ++mt)
#pragma unroll
                for (int r = 0; r < 4; ++r) R[mt][r] = bv[mt][r] * bf2f(vv[mt][r]) - cv[mt][r] * P[mt][r];
            bf16x8 rb[2] = {pack(R[0], R[1]), pack(R[2], R[3])};
            pg8::f32x4 VN[4];
#pragma unroll
            for (int mt = 0; mt < 4; ++mt) { VN[mt] = (pg8::f32x4){0.f, 0.f, 0.f, 0.f};
#pragma unroll
                for (int ks = 0; ks <= (mt >> 1); ++ks) { const int f = mt < 2 ? mt : 2 + (mt - 2) * 2 + ks; VN[mt] = __builtin_amdgcn_mfma_f32_16x16x32_bf16(Tf[f], rb[ks], VN[mt], 0, 0, 0); } }
            bf16x8 vb[2] = {pack(VN[0], VN[1]), pack(VN[2], VN[3])};
            pg8::f32x4 VS[4];
#pragma unroll
            for (int mt = 0; mt < 4; ++mt)
#pragma unroll
                for (int r = 0; r < 4; ++r) VS[mt][r] = ekv[mt][r] * VN[mt][r];
            bf16x8 vsb[2] = {pack(VS[0], VS[1]), pack(VS[2], VS[3])};
            SCAN_LDE(e1, 1); SCAN_F(); SCAN_MME(e0, 0);
#pragma unroll
            for (int mt = 0; mt < 4; ++mt) { pg8::f32x4 o;
#pragma unroll
                for (int r = 0; r < 4; ++r) o[r] = egv[mt][r] * O[mt][r];
#pragma unroll
                for (int ks = 0; ks <= (mt >> 1); ++ks) { const int f = mt < 2 ? mt : 2 + (mt - 2) * 2 + ks; o = __builtin_amdgcn_mfma_f32_16x16x32_bf16(If[f], vb[ks], o, 0, 0, 0); }
#pragma unroll
                for (int r = 0; r < 4; ++r) *(LAS unsigned short*)((LAS unsigned char*)buf + baseV + mt * 1024 + r * 64) = (unsigned short)f2bf(o[r]); }
            SCAN_LDE(e0, 2); SCAN_F(); SCAN_MME(e1, 1);
            SCAN_LDE(e1, 3); SCAN_F(); SCAN_MME(e0, 2);
            SCAN_LDE(e0, 4); SCAN_F(); SCAN_MME(e1, 3);
            SCAN_LDE(e1, 5); SCAN_F(); SCAN_MME(e0, 4);
            SCAN_LDE(e0, 6); SCAN_F(); SCAN_MME(e1, 5);
            SCAN_LDE(e1, 7); SCAN_F(); SCAN_MME(e0, 6);
            SCAN_F(); SCAN_MME(e1, 7);
#undef SCAN_F
#undef SCAN_LD
#undef SCAN_MM
#undef SCAN_LDE
#undef SCAN_MME
#pragma unroll
            for (int ks = 0; ks < 4; ++ks) Sb[ks] = pack(S[2 * ks], S[2 * ks + 1]);
            asm volatile("s_waitcnt lgkmcnt(0)" ::: "memory");
            ost0 = *(const LAS v4u*)(buf + baseO); ost1 = *(const LAS v4u*)(buf + baseO + 16);
        }
        if (s + 2 < 128) { if (wave == 0) asm volatile("s_waitcnt vmcnt(7) lgkmcnt(0)" ::: "memory"); else asm volatile("s_waitcnt vmcnt(6) lgkmcnt(0)" ::: "memory"); }
        else asm volatile("s_waitcnt vmcnt(0) lgkmcnt(0)" ::: "memory");
        __builtin_amdgcn_s_barrier();
    }
}

typedef float f32x16 __attribute__((ext_vector_type(16)));
constexpr int AKT = 0, AVT = 49152;
__device__ __forceinline__ void attn_mfma(Ctx& F) {
    PHASE_IDS(F);
    LAS unsigned char* L = F.lds + RING_OFF;
    const bf16* Q = (const bf16*)(F.ws + WS_Q); const bf16* K = (const bf16*)(F.ws + WS_K); const bf16* V = (const bf16*)(F.ws + WS_V); bf16* AO = (bf16*)(F.ws + WS_AO);
    const float M2 = 8.0f * LOG2E;
    const int r32 = lane & 31, hh = lane >> 5, G4 = lane >> 4, li = lane & 15;
    for (int unit = blockIdx.x; unit < 512; unit += F.G) {
        const int b = unit >> 8, g = (unit >> 6) & 3, n = unit & 63;
#pragma unroll
        for (int k = 0; k < 12; ++k) { const int d = wave + 8 * k, dd = d < 48 ? d : d - 48, row = 8 * dd + (lane >> 3), pos = lane & 7;
            int s = 128 * n - 128 + row; s = s < 0 ? 0 : (s > MSEQ - 1 ? MSEQ - 1 : s);
            const int Gs = d < 48 ? (pos ^ ((row >> 1) & 7)) : (pos ^ (((row >> 1) & 1) << 2));
            const bf16* src = (d < 48 ? K : V) + (size_t)(b * MSEQ + s) * 256 + g * 64 + Gs * 8;
            __builtin_amdgcn_global_load_lds((const unsigned*)src, (LAS unsigned*)(L + (d < 48 ? AKT : AVT) + dd * 1024), 16, 0, 0); }
        asm volatile("s_waitcnt vmcnt(0)" ::: "memory"); __syncthreads();
        const int head = 4 * g + (wave >> 1), qh = wave & 1;
        const float slope2 = exp2f(-8.0f * (float)(head + 1) / 16.0f) * LOG2E;
        const float sinkt = exp2f(F.in[6][head] * LOG2E - M2);
        const float wlo = n == 0 ? 128.f : 0.f, whi = n == 63 ? 256.f : 384.f; const bool edge = (n == 0) || (n == 63);
#pragma unroll 1
        for (int qt = 0; qt < 2; ++qt) {
            const int qi = 64 * qh + 32 * qt + r32; const size_t tok = (size_t)b * MSEQ + 128 * n + qi;
            bf16x8 qf[4];
#pragma unroll
            for (int ks = 0; ks < 4; ++ks) qf[ks] = *(const GAS bf16x8*)(Q + tok * 1024 + head * 64 + 16 * ks + 8 * hh);
            f32x16 O0, O1; float lsum = 0.f;
#pragma unroll
            for (int i = 0; i < 16; ++i) { O0[i] = 0.f; O1[i] = 0.f; }
#pragma unroll 1
            for (int kt9 = 0; kt9 < 9; ++kt9) {
                const int kt = 2 * qh + qt + kt9;
                f32x16 S;
#pragma unroll
                for (int i = 0; i < 16; ++i) S[i] = -M2;
                const int krow = 32 * kt + r32;
#pragma unroll
                for (int ks = 0; ks < 4; ++ks) { const bf16x8 kf = *(const LAS bf16x8*)(L + AKT + krow * 128 + (((2 * ks + hh) ^ ((krow >> 1) & 7)) << 4));
                    S = __builtin_amdgcn_mfma_f32_32x32x16_bf16(kf, qf[ks], S, 0, 0, 0); }
                const float fb = (float)(128 + qi - 32 * kt - 4 * hh);
                float P[16];
                if (kt9 >= 1 && kt9 <= 7 && !edge) {
#pragma unroll
                    for (int r = 0; r < 16; ++r) { const float kk = (float)((r & 3) + 8 * (r >> 2));
                        const float p = __builtin_amdgcn_exp2f(S[r] - slope2 * __builtin_fabsf(fb - kk)); P[r] = p; lsum += p; }
                } else {
                    const float wb = (float)(32 * kt + 4 * hh);
#pragma unroll
                    for (int r = 0; r < 16; ++r) { const float kk = (float)((r & 3) + 8 * (r >> 2)); const float dist = __builtin_fabsf(fb - kk), w = wb + kk;
                        const bool ok = dist <= 128.f && w >= wlo && w < whi;
                        const float p = ok ? __builtin_amdgcn_exp2f(S[r] - slope2 * dist) : 0.f; P[r] = p; lsum += p; }
                }
#pragma unroll
                for (int s = 0; s < 2; ++s) {
                    v4u t; t.x = pk2(P[8 * s], P[8 * s + 1]); t.y = pk2(P[8 * s + 2], P[8 * s + 3]); t.z = pk2(P[8 * s + 4], P[8 * s + 5]); t.w = pk2(P[8 * s + 6], P[8 * s + 7]);
                    const bf16x8 pb = __builtin_bit_cast(bf16x8, t);
                    const int q = li >> 2, p = li & 3, row0 = 32 * kt + 16 * s + 4 * hh + q, row1 = row0 + 8;
#pragma unroll
                    for (int dt = 0; dt < 2; ++dt) { const int Gv = 4 * dt + 2 * (G4 & 1) + (p >> 1);
                        const v4i16_t lo = __builtin_amdgcn_ds_read_tr16_b64_v4i16((LAS v4i16_t*)(L + AVT + row0 * 128 + ((Gv ^ (((row0 >> 1) & 1) << 2)) << 4) + (p & 1) * 8));
                        const v4i16_t hi = __builtin_amdgcn_ds_read_tr16_b64_v4i16((LAS v4i16_t*)(L + AVT + row1 * 128 + ((Gv ^ (((row1 >> 1) & 1) << 2)) << 4) + (p & 1) * 8));
                        const bf16x8 vf = {lo[0], lo[1], lo[2], lo[3], hi[0], hi[1], hi[2], hi[3]};
                        if (dt == 0) O0 = __builtin_amdgcn_mfma_f32_32x32x16_bf16(vf, pb, O0, 0, 0, 0); else O1 = __builtin_amdgcn_mfma_f32_32x32x16_bf16(vf, pb, O1, 0, 0, 0); }
                }
            }
            lsum += __shfl_xor(lsum, 32);
            const float inv = 1.f / (lsum + sinkt);
            bf16* op = AO + tok * 1024 + head * 64 + 4 * hh;
#pragma unroll
            for (int rg = 0; rg < 4; ++rg) {
                u32x2_t a, c; a.x = pk2(O0[4 * rg] * inv, O0[4 * rg + 1] * inv); a.y = pk2(O0[4 * rg + 2] * inv, O0[4 * rg + 3] * inv);
                c.x = pk2(O1[4 * rg] * inv, O1[4 * rg + 1] * inv); c.y = pk2(O1[4 * rg + 2] * inv, O1[4 * rg + 3] * inv);
                *(GAS u32x2_t*)(op + 8 * rg) = a; *(GAS u32x2_t*)(op + 32 + 8 * rg) = c; }
        }
        __syncthreads();
    }
}
struct Args { const float* in[21]; float* out; unsigned char* ws; int mask, rep; };
__global__ void __launch_bounds__(NTHR, 2) mk_fwd(Args args) {
    extern __shared__ __attribute__((aligned(16))) unsigned char lds[];
    Ctx F;
    F.lds = (LAS unsigned char*)lds;
    F.MISC = (volatile LAS unsigned*)(F.lds + MISC_OFF);
    F.G = gridDim.x; { const int bx = blockIdx.x; const int vcu = (F.G % 8 == 0) ? (bx % 8) * (F.G / 8) + bx / 8 : bx; F.gwb = vcu * NWAVES; F.NGW = F.G * NWAVES; }
    F.wv = __builtin_amdgcn_readfirstlane((int)(threadIdx.x >> 6));
    F.ws = args.ws; F.out = args.out; F.ctl = (gu32*)(args.ws + WS_CTL);
#pragma unroll
    for (int i = 0; i < 21; ++i) F.in[i] = args.in[i];
    for (int u = threadIdx.x; u < (LDS_BYTES - LDSCTL_OFF) / 4; u += NTHR) ((LAS unsigned*)(F.lds + LDSCTL_OFF))[u] = 0u;
    __syncthreads();
    XcdBarrier bar = xcd_barrier_post((unsigned*)(F.ctl + CW_BAR), F.MISC + 8);
    const int mask = args.mask;
    const LAS int* tab = (const LAS int*)(F.lds + MOETAB_OFF);
#pragma unroll 1
    for (int ph = 0; ph < 17; ++ph) {
        if (!((mask >> ph) & 1)) continue;
        const int layer = ph >= 13 ? 1 : 0;
        for (int rr = 0, nrep = (args.rep >> ph) & 1; rr <= nrep; ++rr) {
        if (rr) xcd_barrier(bar, F.wv == 0 && lane_id() == 0);
        int sel = ph >= 13 ? ph - 9 : (ph == 12 ? 3 : ph);
        asm volatile("" : "+s"(sel));
        switch (sel) {
        case 0: p0_prologue(F); break;
        case 1: {
            pg8::Gemm g{(const pg8::bf16_t*)(F.ws + WS_XN), (const pg8::bf16_t*)(F.ws + WS_WQKV), MT, 1536, MD}; pg8::StaticOrder S; S.init(MT, 1536, F.G, (int)blockIdx.x);
            pg8::EpiQKV E{(pg8::bf16_t*)(F.ws + WS_Q), (pg8::bf16_t*)(F.ws + WS_K), (pg8::bf16_t*)(F.ws + WS_V), F.in[4], F.in[5], QSCALE};
            pg8::gemm_phase<pg8::EpiQKV, pg8::StaticOrder, true, true>(F.lds + RING_OFF, g, S, E, F.wv * 64 + lane_id());
        } break;
        case 2: attn_mfma(F); break;
        case 3: {
            pg8::Gemm g{(const pg8::bf16_t*)(F.ws + (ph == 3 ? WS_AO : WS_ON)), (const pg8::bf16_t*)(F.ws + (ph == 3 ? WS_WAO : WS_WGO)), MT, MD, MD}; pg8::StaticOrder S; S.init(MT, MD, F.G, (int)blockIdx.x);
            pg8::EpiResF32 E{ph == 3 ? F.in[0] : F.out, F.out, MD};
            pg8::gemm_phase<pg8::EpiResF32, pg8::StaticOrder, true, true>(F.lds + RING_OFF, g, S, E, F.wv * 64 + lane_id());
            if (ph != 3) moe_convert(F, 1, F.gwb + F.wv, F.NGW);
        } break;
        case 4: p4_router(F, layer); break;
        case 5: {
            moe_tables(F, layer, 2);
            pg8::Gemm g{(const pg8::bf16_t*)(F.ws + WS_XN), (const pg8::bf16_t*)(F.ws + WS_WGU), MT, 512, MD};
            pg8::MoeOrder S{tab, 2, F.G, (int)blockIdx.x, (const int*)(F.ws + WS_LIST), (unsigned)(MD * 2)};
            pg8::EpiGateUp E{(pg8::bf16_t*)(F.ws + WS_H), (const float*)(F.ws + WS_GLIST), tab};
            pg8::gemm_phase<pg8::EpiGateUp, pg8::MoeOrder, true, true, true>(F.lds + RING_OFF, g, S, E, F.wv * 64 + lane_id());
        } break;
        case 6: {
            moe_tables(F, layer, 4);
            pg8::Gemm g{(const pg8::bf16_t*)(F.ws + WS_H), (const pg8::bf16_t*)(F.ws + WS_WD), 40960, 1024, 256};
            pg8::MoeOrder S{tab, 4, F.G, (int)blockIdx.x, (const int*)(F.ws + WS_LIST), 512u};
            pg8::EpiY E{(pg8::bf16_t*)(F.ws + WS_Y)};
            pg8::gemm_phase<pg8::EpiY, pg8::MoeOrder, true, true, false>(F.lds + RING_OFF, g, S, E, F.wv * 64 + lane_id());
        } break;
        case 7: moe_tables(F, layer, 4); if (layer == 0) p7_combine<true>(F); else p7_combine<false>(F); break;
        case 8: {
            pg8::Gemm g{(const pg8::bf16_t*)(F.ws + WS_XN), (const pg8::bf16_t*)(F.ws + WS_WGIN), MT, 4096, MD}; pg8::StaticOrder S; S.init(MT, 4096, F.G, (int)blockIdx.x);
            pg8::EpiGdnIn E{(pg8::bf16_t*)(F.ws + WS_QKVPRE), (pg8::bf16_t*)(F.ws + WS_Z), (pg8::bf16_t*)(F.ws + WS_HALO)};
            pg8::gemm_phase<pg8::EpiGdnIn, pg8::StaticOrder, true, true>(F.lds + RING_OFF, g, S, E, F.wv * 64 + lane_id());
        } break;
        case 9: gdn_prep(F); break;
        case 10: gdn_scan(F); break;
        default: gdn_gate(F); break;
        }
        }
        if ((mask >> (ph + 1)) != 0) xcd_barrier(bar, F.wv == 0 && lane_id() == 0);
    }
}

#ifndef REP_PROBE
#define REP_PROBE 0
#endif
extern "C" void kernel_launch(void* const* d_in, const int* in_sizes, int n_in, void* d_out, int out_size, void* d_ws, size_t ws_size, hipStream_t stream) {
    static int grid = 0;
    if (grid == 0) {
        int dev = 0, cus = 0;
        if (hipGetDevice(&dev) != hipSuccess || hipDeviceGetAttribute(&cus, hipDeviceAttributeMultiprocessorCount, dev) != hipSuccess) { fprintf(stderr, "kernel_launch: device query failed\n"); grid = -1; return; }
        if (hipFuncSetAttribute((const void*)mk_fwd, hipFuncAttributeMaxDynamicSharedMemorySize, LDS_BYTES) != hipSuccess) { fprintf(stderr, "kernel_launch: hipFuncSetAttribute failed\n"); grid = -1; return; }
        (void)hipGetLastError();
        grid = cus;
        if (ws_size < WS_END) { fprintf(stderr, "kernel_launch: workspace too small\n"); }
    }
    if (grid < 0) return;
    (void)hipMemsetAsync((char*)d_ws + WS_CTL, 0, CTL_ZERO_BYTES, stream);
    Args a{};
    for (int i = 0; i < 21; ++i) a.in[i] = (const float*)d_in[i];
    a.out = (float*)d_out; a.ws = (unsigned char*)d_ws; a.mask = 0x1ffff; a.rep = REP_PROBE;
    hipLaunchKernelGGL(mk_fwd, dim3(grid), dim3(NTHR), LDS_BYTES, stream, a);
}
```

```cpp
#include <hip/hip_runtime.h>
#include <cstdio>
#include <cstdint>
namespace pg8 {
#define PG8_LAS __attribute__((address_space(3)))
typedef unsigned short bf16_t;
typedef short bf16x8 __attribute__((ext_vector_type(8)));
typedef float f32x4 __attribute__((ext_vector_type(4)));
typedef unsigned u32x4 __attribute__((ext_vector_type(4)));
constexpr int BM = 256, BK = 64, HALF = 128, HTB = HALF * BK * 2  , STAGE_BYTES = 8 * HTB, NXCD = 8, WGM = 8;

__host__ __device__ __forceinline__ int lds_byte(int r, int c) { const int st = (r >> 4) * 2 + (c >> 5), rr = r & 15, cc = c & 31, ob = rr * 64 + cc * 2; return st * 1024 + (ob ^ (((ob >> 9) & 1) << 5)); }
__host__ __device__ __forceinline__ void stage_rc(int b, int& R, int& C) { const int st = b / 1024, sb = b % 1024, swz = sb ^ (((sb >> 9) & 1) << 5); R = (st >> 1) * 16 + swz / 64; C = (st & 1) * 32 + (swz % 64) / 2; }
__host__ __device__ __forceinline__ int perm32(int rho) { const int n = rho >> 4, i = rho & 15; return 8 * (i >> 2) + 4 * n + (i & 3); }

struct Unit { int pm, pn; };
struct Gemm { const bf16_t* A; const bf16_t* Bt; int M, N, K; };

struct StaticOrder {
    int nM, nN, nwg, G, c;
    __host__ __device__ void init(int M, int N, int G_, int c_) { nM = M / BM; nN = N / BM; nwg = nM * nN; G = G_; c = c_; }
    __host__ __device__ bool next(int i, Unit& u) const {
        const long L = (long)i * G + c; if (L >= nwg) return false;
        int wgid = (int)L; { const int q = nwg / NXCD, r = nwg % NXCD, xcd = wgid % NXCD, off = wgid / NXCD; wgid = (xcd < r ? xcd * (q + 1) : r * (q + 1) + (xcd - r) * q) + off; }
        const int nig = WGM * nN, gid = wgid / nig, fm = gid * WGM, gsz = (nM - fm) < WGM ? (nM - fm) : WGM;
        u.pm = fm + ((wgid % nig) % gsz); u.pn = (wgid % nig) / gsz; return true;
    }
    __device__ __forceinline__ void a_ready(const Unit&) const {}
    __device__ __forceinline__ void done(const Unit&) const {}
};

__device__ __forceinline__ unsigned cvt_pk_bf16(float lo, float hi) { unsigned r; asm volatile("v_cvt_pk_bf16_f32 %0, %1, %2" : "=v"(r) : "v"(lo), "v"(hi)); return r; }
typedef unsigned u32x4 __attribute__((ext_vector_type(4)));
struct EpiQKV {
    static constexpr bool PERM = true, AFTER_DRAIN = false;
    bf16_t *Q, *K, *V; const float *qg, *kg; float qscale;
    __device__ __forceinline__ void operator()(const f32x4 (&acc)[2][2][4][2], const Unit& u, int wr, int wc, int fr, int fq) const {
        const int row0 = u.pm * BM + wr * 64 + fr;
        bf16_t* dst; int ld; const float* gain; float sc; bool norm;
        if (u.pn < 4) { dst = Q + (u.pn * 4 + wc) * 64; ld = 1024; gain = qg; sc = qscale; norm = true; }
        else if (u.pn == 4) { dst = K + wc * 64; ld = 256; gain = kg; sc = 1.f; norm = true; }
        else { dst = V + wc * 64; ld = 256; gain = qg; sc = 1.f; norm = false; }
        f32x4 gv[2][2];
#pragma unroll
        for (int bj = 0; bj < 2; ++bj)
#pragma unroll
            for (int n = 0; n < 2; ++n) { const f32x4 g4 = *(const f32x4*)(gain + 32 * bj + 8 * fq + 4 * n); gv[bj][n] = norm ? g4 * sc : (f32x4){1.f, 1.f, 1.f, 1.f}; }
#pragma unroll
        for (int ai = 0; ai < 2; ++ai)
#pragma unroll
            for (int m = 0; m < 4; ++m) {
                float ss = 0.f;
#pragma unroll
                for (int bj = 0; bj < 2; ++bj)
#pragma unroll
                    for (int n = 0; n < 2; ++n) { const f32x4 x = acc[ai][bj][m][n]; ss += (x[0] * x[0] + x[1] * x[1]) + (x[2] * x[2] + x[3] * x[3]); }
                ss += __shfl_xor(ss, 16); ss += __shfl_xor(ss, 32);
                const float rs = norm ? rsqrtf(ss * (1.0f / 64.0f) + 1e-6f) : 1.f;
                bf16_t* rowp = dst + (size_t)(row0 + ai * HALF + m * 16) * ld + 8 * fq;
#pragma unroll
                for (int bj = 0; bj < 2; ++bj) { const f32x4 v0 = acc[ai][bj][m][0] * rs * gv[bj][0], v1 = acc[ai][bj][m][1] * rs * gv[bj][1];
                    u32x4 w; w.x = cvt_pk_bf16(v0[0], v0[1]); w.y = cvt_pk_bf16(v0[2], v0[3]); w.z = cvt_pk_bf16(v1[0], v1[1]); w.w = cvt_pk_bf16(v1[2], v1[3]);
                    *(u32x4*)(rowp + 32 * bj) = w; }
            }
    }
};
struct EpiResF32 {
    static constexpr bool PERM = false, AFTER_DRAIN = false;
    const float* base; float* out; int ldc;
    __device__ __forceinline__ void operator()(const f32x4 (&acc)[2][2][4][2], const Unit& u, int wr, int wc, int fr, int fq) const {
        const int row0 = u.pm * BM + wr * 64 + fr, col0 = u.pn * BM + wc * 32 + 4 * fq;
#pragma unroll
        for (int ai = 0; ai < 2; ++ai)
#pragma unroll
            for (int m = 0; m < 4; ++m) { const size_t off = (size_t)(row0 + ai * HALF + m * 16) * ldc + col0;
#pragma unroll
                for (int bj = 0; bj < 2; ++bj)
#pragma unroll
                    for (int n = 0; n < 2; ++n) { const size_t o = off + bj * HALF + n * 16; const f32x4 b = *(const f32x4*)(base + o); *(f32x4*)(out + o) = b + acc[ai][bj][m][n]; } }
    }
};

constexpr int MOE_CAP = 16384;
struct MoeOrder {
    const PG8_LAS int* tab; int npn, G, c; const int* list; unsigned rowbytes;
    __device__ __forceinline__ bool next(int i, Unit& u) const {
        const int L = i * G + c; if (L >= tab[65 + 32]) return false;
        int e = 0;
        for (int j = 1; j < 32; ++j) e = (L >= tab[65 + j]) ? j : e;
        const int local = L - tab[65 + e], mt = local / npn, pnl = local - mt * npn;
        u.pm = (tab[32 + e] >> 8) + mt; u.pn = e * npn + pnl; return true;
    }
    __device__ __forceinline__ unsigned rowoff(const Unit& u, int r) const {
        const int e = u.pn >> 1, idx = u.pm * 256 - tab[32 + e] + r;
        const int tok = idx < tab[e] ? list[e * MOE_CAP + idx] : 0;
        return (unsigned)tok * rowbytes;
    }
    __device__ __forceinline__ void a_ready(const Unit&) const {}
    __device__ __forceinline__ void done(const Unit&) const {}
};
struct EpiGateUp {
    static constexpr bool PERM = true, AFTER_DRAIN = false;
    bf16_t* H; const float* glist; const PG8_LAS int* tab;
    __device__ __forceinline__ void operator()(const f32x4 (&acc)[2][2][4][2], const Unit& u, int wr, int wc, int fr, int fq) const {
        const int e = u.pn >> 1, pnl = u.pn & 1, row0 = u.pm * BM + wr * 64 + fr, li0 = row0 - tab[32 + e], cnt = tab[e];
#pragma unroll
        for (int ai = 0; ai < 2; ++ai)
#pragma unroll
            for (int m = 0; m < 4; ++m) { const int li = li0 + ai * HALF + m * 16; const float gw = li < cnt ? glist[e * MOE_CAP + li] : 0.f;
                f32x4 h[2];
#pragma unroll
                for (int n = 0; n < 2; ++n)
#pragma unroll
                    for (int i = 0; i < 4; ++i) { const float g = acc[ai][0][m][n][i], uu = acc[ai][1][m][n][i]; h[n][i] = g * __builtin_amdgcn_rcpf(1.f + __expf(-g)) * uu * gw; }
                u32x4 w; w.x = cvt_pk_bf16(h[0][0], h[0][1]); w.y = cvt_pk_bf16(h[0][2], h[0][3]); w.z = cvt_pk_bf16(h[1][0], h[1][1]); w.w = cvt_pk_bf16(h[1][2], h[1][3]);
                *(u32x4*)(H + (size_t)(row0 + ai * HALF + m * 16) * 256 + 128 * pnl + 32 * wc + 8 * fq) = w; }
    }
};
struct EpiY {
    static constexpr bool PERM = true, AFTER_DRAIN = false;
    bf16_t* Y;
    __device__ __forceinline__ void operator()(const f32x4 (&acc)[2][2][4][2], const Unit& u, int wr, int wc, int fr, int fq) const {
        const int row0 = u.pm * BM + wr * 64 + fr, col0 = (u.pn & 3) * BM + wc * 32 + 8 * fq;
#pragma unroll
        for (int ai = 0; ai < 2; ++ai)
#pragma unroll
            for (int m = 0; m < 4; ++m) { bf16_t* rowp = Y + (size_t)(row0 + ai * HALF + m * 16) * 1024 + col0;
#pragma unroll
                for (int bj = 0; bj < 2; ++bj) { const f32x4 v0 = acc[ai][bj][m][0], v1 = acc[ai][bj][m][1];
                    u32x4 w; w.x = cvt_pk_bf16(v0[0], v0[1]); w.y = cvt_pk_bf16(v0[2], v0[3]); w.z = cvt_pk_bf16(v1[0], v1[1]); w.w = cvt_pk_bf16(v1[2], v1[3]);
                    *(u32x4*)(rowp + bj * HALF) = w; } }
    }
};

struct EpiGdnIn {
    static constexpr bool PERM = true, AFTER_DRAIN = false;
    bf16_t *QKV, *Z, *HALO;
    __device__ __forceinline__ void operator()(const f32x4 (&acc)[2][2][4][2], const Unit& u, int wr, int wc, int fr, int fq) const {
        const int row0 = u.pm * BM + wr * 64 + fr;
        bf16_t* dst; int ld;
        if (u.pn < 12) { dst = QKV + u.pn * BM; ld = 3072; } else { dst = Z + (u.pn - 12) * BM; ld = 1024; }
        dst += wc * 32 + 8 * fq;
#pragma unroll
        for (int ai = 0; ai < 2; ++ai)
#pragma unroll
            for (int m = 0; m < 4; ++m) { bf16_t* rowp = dst + (size_t)(row0 + ai * HALF + m * 16) * ld;
#pragma unroll
                for (int bj = 0; bj < 2; ++bj) { const f32x4 v0 = acc[ai][bj][m][0], v1 = acc[ai][bj][m][1];
                    u32x4 w; w.x = cvt_pk_bf16(v0[0], v0[1]); w.y = cvt_pk_bf16(v0[2], v0[3]); w.z = cvt_pk_bf16(v1[0], v1[1]); w.w = cvt_pk_bf16(v1[2], v1[3]);
                    *(u32x4*)(rowp + bj * HALF) = w;
                    if (u.pn < 12 && ((m == 0 && fr == 0) || (m == 3 && fr >= 14))) { const int row = row0 + ai * HALF + m * 16, slot = m == 0 ? 0 : fr - 13;
                        *(u32x4*)(HALO + ((size_t)(row >> 6) * 3 + slot) * 3072 + u.pn * BM + wc * 32 + 8 * fq + bj * HALF) = w; } } }
    }
};
template <class Epi, class Sched, bool ALIGN_EPI = false, bool SP2 = false, bool GATHER = false>
__device__ __forceinline__ void gemm_phase(PG8_LAS unsigned char* lds, const Gemm g, const Sched& S, const Epi& E, int tid_in) {
    int tid_ = tid_in; asm volatile("" : "+v"(tid_));
    const int tid = tid_, wid = __builtin_amdgcn_readfirstlane(tid >> 6), lane = tid & 63, wr = wid >> 2, wc = wid & 3, fr = lane & 15, fq = lane >> 4;
    int K_ = g.K; asm volatile("" : "+s"(K_));
    const int K = K_, nt = K / BK;
    unsigned voffA[2], voffB[2];
#pragma unroll
    for (int i = 0; i < 2; ++i) { int R, C; stage_rc(tid * 16 + i * 8192, R, C); const int Rb = Epi::PERM ? ((R & ~31) + perm32(R & 31)) : R;
        voffA[i] = (unsigned)(R * K + C) * 2u; voffB[i] = (unsigned)(Rb * K + C) * 2u; }
    const size_t kstep = (size_t)(BK * 2);
    const size_t hstep = (size_t)HALF * K * 2; const size_t hstepA = GATHER ? (size_t)0 : hstep;
    const size_t tstep = 2 * hstep;
    const unsigned ldsw = (unsigned)wid * 1024u;
    const int aoff = lds_byte(wr * 64 + fr, fq * 8), boff = lds_byte(wc * 32 + fr, fq * 8);
#define PG8_SA(b, h) (((b) * 2 + (h)) * HTB)
#define PG8_SB(b, h) ((4 + (b) * 2 + (h)) * HTB)
#define PG8_STAGE(bufoff, gbase, voff) do { _Pragma("unroll") for (int _i = 0; _i < 2; ++_i) \
        __builtin_amdgcn_global_load_lds((const unsigned*)((const char*)(gbase) + (voff)[_i]), (PG8_LAS unsigned*)(lds + (bufoff) + ldsw + _i * 8192), 16, 0, 0); } while (0)
#define PG8_LDA(dst, b, h) do { _Pragma("unroll") for (int m = 0; m < 4; ++m) _Pragma("unroll") for (int k = 0; k < 2; ++k) dst[m][k] = *(const PG8_LAS bf16x8*)(lds + PG8_SA(b, h) + aoff + m * 2048 + k * 1024); } while (0)
#define PG8_LDB(dst, b, h) do { _Pragma("unroll") for (int n = 0; n < 2; ++n) _Pragma("unroll") for (int k = 0; k < 2; ++k) dst[n][k] = *(const PG8_LAS bf16x8*)(lds + PG8_SB(b, h) + boff + n * 2048 + k * 1024); } while (0)
#define PG8_MMA(ai, bj, At, Bt) do { __builtin_amdgcn_s_setprio(1); _Pragma("unroll") for (int m = 0; m < 4; ++m) _Pragma("unroll") for (int n = 0; n < 2; ++n) _Pragma("unroll") for (int k = 0; k < 2; ++k) \
        acc[ai][bj][m][n] = __builtin_amdgcn_mfma_f32_16x16x32_bf16(Bt[n][k], At[m][k], acc[ai][bj][m][n], 0, 0, 0); __builtin_amdgcn_s_setprio(0); } while (0)
#define PG8_WAIT_V(n) asm volatile("s_waitcnt vmcnt(" #n ")" ::: "memory")
#define PG8_WAIT_L(n) asm volatile("s_waitcnt lgkmcnt(" #n ")" ::: "memory")
#define PG8_BAR __builtin_amdgcn_s_barrier()
#define PG8_SCHED __builtin_amdgcn_sched_barrier(0)
    Unit cur, nxt; int ui = 0;
    if (!S.next(0, cur)) return;
    f32x4 acc[2][2][4][2];
#pragma unroll
    for (int a = 0; a < 2; ++a)
#pragma unroll
        for (int b = 0; b < 2; ++b)
#pragma unroll
            for (int m = 0; m < 4; ++m)
#pragma unroll
                for (int n = 0; n < 2; ++n) acc[a][b][m][n] = (f32x4){0.f, 0.f, 0.f, 0.f};
    bf16x8 At[4][2], B0[2][2], B1[2][2];
    const char* cA = (const char*)g.A + (GATHER ? (size_t)0 : (size_t)cur.pm * tstep);
    unsigned vC[2][2];
    PG8_LAS unsigned* vNl = (PG8_LAS unsigned*)(lds + STAGE_BYTES + 2048) + tid;
#pragma unroll
    for (int h = 0; h < 2; ++h)
#pragma unroll
        for (int i = 0; i < 2; ++i) { if constexpr (GATHER) { int R, C; stage_rc(tid * 16 + i * 8192, R, C); vC[h][i] = S.rowoff(cur, 128 * h + R) + (unsigned)C * 2u; vNl[(h * 2 + i) * 512] = vC[h][i]; } else vC[h][i] = voffA[i]; }
    const char* cB = (const char*)g.Bt + (size_t)cur.pn * tstep;
    S.a_ready(cur);
    if constexpr (SP2) {
        PG8_STAGE(PG8_SB(0, 0), cB, voffB); PG8_STAGE(PG8_SB(0, 1), cB + hstep, voffB); PG8_STAGE(PG8_SA(0, 0), cA, vC[0]); PG8_STAGE(PG8_SA(0, 1), cA + hstepA, vC[1]);
        if (wr == 1) PG8_BAR;
        PG8_WAIT_V(2); PG8_BAR;
        PG8_STAGE(PG8_SB(1, 0), cB + kstep, voffB); PG8_STAGE(PG8_SA(1, 0), cA + kstep, vC[0]); PG8_STAGE(PG8_SB(1, 1), cB + hstep + kstep, voffB);
        PG8_WAIT_V(6); PG8_BAR;
    } else {
        PG8_STAGE(PG8_SB(0, 0), cB, voffB); PG8_STAGE(PG8_SA(0, 0), cA, vC[0]); PG8_STAGE(PG8_SB(0, 1), cB + hstep, voffB); PG8_STAGE(PG8_SA(0, 1), cA + hstepA, vC[1]);
        if (wr == 1) PG8_BAR;
        PG8_WAIT_V(4); PG8_BAR;
        PG8_STAGE(PG8_SB(1, 0), cB + kstep, voffB); PG8_STAGE(PG8_SA(1, 0), cA + kstep, vC[0]); PG8_STAGE(PG8_SB(1, 1), cB + hstep + kstep, voffB);
        PG8_WAIT_V(6); PG8_BAR;
    }
    for (;;) {
        const bool has_next = S.next(ui + 1, nxt);
        const char* nA = (has_next && !GATHER) ? (const char*)g.A + (size_t)nxt.pm * tstep : cA;
        if constexpr (GATHER) { if (has_next) {
#pragma unroll
            for (int h = 0; h < 2; ++h)
#pragma unroll
                for (int i = 0; i < 2; ++i) { int R, C; stage_rc(tid * 16 + i * 8192, R, C); vNl[(h * 2 + i) * 512] = S.rowoff(nxt, 128 * h + R) + (unsigned)C * 2u; } } }
        const char* nB = has_next ? (const char*)g.Bt + (size_t)nxt.pn * tstep : cB;
        for (int t = 0; t < nt; t += 2) {
            const bool last = (t == nt - 2);
            const char* a1 = cA + (size_t)(t + 1) * kstep;
            const char* a2 = last ? nA : cA + (size_t)(t + 2) * kstep; const char* b2 = last ? nB : cB + (size_t)(t + 2) * kstep;
            const char* a3 = a2 + kstep; const char* b3 = b2 + kstep;
            unsigned v2[2][2];
#pragma unroll
            for (int h = 0; h < 2; ++h)
#pragma unroll
                for (int i = 0; i < 2; ++i) { if constexpr (GATHER) { v2[h][i] = vC[h][i]; if (last) v2[h][i] = vNl[(h * 2 + i) * 512]; } else v2[h][i] = vC[h][i]; }
            if (last && has_next) S.a_ready(nxt);
            if constexpr (SP2) {
            PG8_LDB(B0, 0, 0); PG8_LDB(B1, 0, 1); PG8_SCHED; PG8_LDA(At, 0, 0); PG8_STAGE(PG8_SA(1, 1), a1 + hstepA, vC[1]);
            PG8_WAIT_V(8); PG8_WAIT_L(0); PG8_BAR; PG8_MMA(0, 0, At, B0); PG8_MMA(0, 1, At, B1); PG8_BAR; PG8_SCHED;
            PG8_LDA(At, 0, 1); PG8_STAGE(PG8_SB(0, 0), b2, voffB); PG8_STAGE(PG8_SB(0, 1), b2 + hstep, voffB); PG8_STAGE(PG8_SA(0, 0), a2, v2[0]);
            PG8_WAIT_V(8); PG8_WAIT_L(0); PG8_BAR; PG8_MMA(1, 0, At, B0); PG8_MMA(1, 1, At, B1); PG8_BAR; PG8_SCHED;
            PG8_LDB(B0, 1, 0); PG8_LDB(B1, 1, 1); PG8_SCHED; PG8_LDA(At, 1, 0); PG8_STAGE(PG8_SA(0, 1), a2 + hstepA, v2[1]);
            PG8_WAIT_V(8); PG8_WAIT_L(0); PG8_BAR; PG8_MMA(0, 0, At, B0); PG8_MMA(0, 1, At, B1); PG8_BAR; PG8_SCHED;
            PG8_LDA(At, 1, 1); PG8_STAGE(PG8_SB(1, 0), b3, voffB); PG8_STAGE(PG8_SB(1, 1), b3 + hstep, voffB); PG8_STAGE(PG8_SA(1, 0), a3, v2[0]);
            PG8_WAIT_V(8); PG8_WAIT_L(0); PG8_BAR; PG8_MMA(1, 0, At, B0); PG8_MMA(1, 1, At, B1); PG8_BAR; PG8_SCHED;
            } else {
            PG8_LDB(B0, 0, 0); PG8_SCHED; PG8_LDA(At, 0, 0); PG8_STAGE(PG8_SA(1, 1), a1 + hstepA, vC[1]);
            PG8_WAIT_L(8); PG8_BAR; PG8_WAIT_L(0); PG8_MMA(0, 0, At, B0); PG8_BAR; PG8_SCHED;
            PG8_LDB(B1, 0, 1); PG8_STAGE(PG8_SB(0, 0), b2, voffB);
            PG8_BAR; PG8_WAIT_L(0); PG8_MMA(0, 1, At, B1); PG8_BAR;
            PG8_LDA(At, 0, 1); PG8_STAGE(PG8_SA(0, 0), a2, v2[0]);
            PG8_BAR; PG8_WAIT_L(0); PG8_MMA(1, 0, At, B0); PG8_BAR; PG8_SCHED;
            PG8_STAGE(PG8_SB(0, 1), b2 + hstep, voffB);
            PG8_WAIT_V(6); PG8_BAR; PG8_MMA(1, 1, At, B1); PG8_BAR;
            PG8_LDB(B0, 1, 0); PG8_SCHED; PG8_LDA(At, 1, 0); PG8_STAGE(PG8_SA(0, 1), a2 + hstepA, v2[1]);
            PG8_WAIT_L(8); PG8_BAR; PG8_WAIT_L(0); PG8_MMA(0, 0, At, B0); PG8_BAR; PG8_SCHED;
            PG8_LDB(B1, 1, 1); PG8_STAGE(PG8_SB(1, 0), b3, voffB);
            PG8_BAR; PG8_WAIT_L(0); PG8_MMA(0, 1, At, B1); PG8_BAR;
            PG8_LDA(At, 1, 1); PG8_STAGE(PG8_SA(1, 0), a3, v2[0]);
            PG8_BAR; PG8_WAIT_L(0); PG8_MMA(1, 0, At, B0); PG8_BAR; PG8_SCHED;
            PG8_STAGE(PG8_SB(1, 1), b3 + hstep, voffB);
            PG8_WAIT_V(6); PG8_BAR; PG8_MMA(1, 1, At, B1); PG8_BAR;
            }
        }
        if constexpr (ALIGN_EPI) { if (wr == 0) PG8_BAR; }
        if constexpr (!Epi::AFTER_DRAIN) { E(acc, cur, wr, wc, fr, fq); S.done(cur); }
        if (!has_next) break;
#pragma unroll
        for (int a = 0; a < 2; ++a)
#pragma unroll
            for (int b = 0; b < 2; ++b)
#pragma unroll
                for (int m = 0; m < 4; ++m)
#pragma unroll
                    for (int n = 0; n < 2; ++n) acc[a][b][m][n] = (f32x4){0.f, 0.f, 0.f, 0.f};
        cur = nxt; cA = nA; cB = nB; ++ui;
#pragma unroll
        for (int h = 0; h < 2; ++h)
#pragma unroll
            for (int i = 0; i < 2; ++i) { if constexpr (GATHER) vC[h][i] = vNl[(h * 2 + i) * 512]; }
        if constexpr (ALIGN_EPI) { if (wr == 1) PG8_BAR; }
    }
    PG8_WAIT_V(0);
    if constexpr (!ALIGN_EPI) { if (wr == 0) PG8_BAR; }
    PG8_BAR;
    if constexpr (Epi::AFTER_DRAIN) { E.fused(acc, cur, wr, wc, fr, fq, lds, wid, lane); S.done(cur); }
#undef PG8_SA
#undef PG8_SB
#undef PG8_STAGE
#undef PG8_LDA
#undef PG8_LDB
#undef PG8_MMA
#undef PG8_WAIT_V
#undef PG8_WAIT_L
#undef PG8_BAR
#undef PG8_SCHED
}
}
#define GAS __attribute__((address_space(1)))
#define LAS __attribute__((address_space(3)))
typedef unsigned short bf16;
typedef unsigned v4u __attribute__((ext_vector_type(4)));
typedef float f32x4 __attribute__((ext_vector_type(4)));
typedef short bf16x8 __attribute__((ext_vector_type(8)));
typedef GAS unsigned gu32;
typedef GAS unsigned long long gu64;
#define RLX_AGENT __ATOMIC_RELAXED, __HIP_MEMORY_SCOPE_AGENT
#define LDS_WAIT() asm volatile("s_waitcnt lgkmcnt(0)" ::: "memory")
#define VM_WAIT() asm volatile("s_waitcnt vmcnt(0)" ::: "memory")
__device__ __forceinline__ unsigned long long rt() { return __builtin_amdgcn_s_memrealtime(); }
typedef float f32x2_cv __attribute__((ext_vector_type(2))); typedef __bf16 bf16x2_cv __attribute__((ext_vector_type(2)));
__device__ __forceinline__ unsigned pk2(float lo, float hi) { f32x2_cv v = {lo, hi}; bf16x2_cv b = __builtin_convertvector(v, bf16x2_cv); return __builtin_bit_cast(unsigned, b); }
__device__ __forceinline__ unsigned f2bf(float f) { return pk2(f, f) & 0xffffu; }


#define XB_TMO      128
#define XB_XCNT(j)  (256  + 64 * (j))
#define XB_XSUB(j)  (1280 + 64 * (j))
#define XB_XGEN(j)  (2304 + 64 * (j))
#define XB_TOP      3328
#define XB_TOPGEN   3392
#define XCD_BAR_WORDS 3456
#define XB_SPIN_CAP (1u << 18)

__device__ __forceinline__ unsigned xb_ld(unsigned* p)              { return __hip_atomic_load(p, __ATOMIC_RELAXED, __HIP_MEMORY_SCOPE_AGENT); }
__device__ __forceinline__ unsigned xb_add(unsigned* p, unsigned v) { return __hip_atomic_fetch_add(p, v, __ATOMIC_RELAXED, __HIP_MEMORY_SCOPE_AGENT); }
__device__ __forceinline__ unsigned xb_xcc_id() { return (unsigned)__builtin_amdgcn_s_getreg((3 << 11) | 20) & 0xFu; }
#define XB_SPIN(cond, bar) do { unsigned _sp = 0; while (cond) { __builtin_amdgcn_s_sleep(1); \
    if ((++_sp & 255u) == 0u) { if (xb_ld(&(bar)[XB_TMO])) break; if (_sp > XB_SPIN_CAP) { atomicAdd(&(bar)[XB_TMO], 1u); break; } } } } while (0)

struct XcdBarrier {
    unsigned* bar; unsigned x;
    volatile LAS unsigned* st;
};

__device__ __forceinline__ XcdBarrier xcd_barrier_post(unsigned* bar, volatile LAS unsigned* st) {
    XcdBarrier b; b.bar = bar; b.x = xb_xcc_id(); b.st = st;
    if (threadIdx.x == 0) (void)xb_add(&bar[XB_XCNT(b.x)], 1u);
    return b;
}
__device__ __forceinline__ void xcd_barrier_complete(unsigned* bar, unsigned x, unsigned& nloc, unsigned& nx) {
    const unsigned G = gridDim.x * gridDim.y * gridDim.z;
    unsigned sum, cnt, mine, sp = 0u;
    for (;;) {
        sum = 0u; cnt = 0u; mine = 0u;
#pragma unroll
        for (unsigned j = 0; j < 16; ++j) { const unsigned c = xb_ld(&bar[XB_XCNT(j)]); sum += c; cnt += (c > 0u) ? 1u : 0u; mine = (j == x) ? c : mine; }
        if (sum == G) break;
        __builtin_amdgcn_s_sleep(1);
        if ((++sp & 255u) == 0u) { if (xb_ld(&bar[XB_TMO])) break; if (sp > XB_SPIN_CAP) { atomicAdd(&bar[XB_TMO], 1u); break; } }
    }
    nloc = mine > 0u ? mine : 1u; nx = cnt > 0u ? cnt : 1u;
}

__device__ __forceinline__ void xcd_barrier(const XcdBarrier& b, bool is_t0) {
    asm volatile("s_waitcnt vmcnt(0)" ::: "memory");
    __syncthreads();
    if (is_t0) {
        unsigned* bar = b.bar;
        __builtin_amdgcn_s_waitcnt(0);
        unsigned nloc = b.st[0], nx = b.st[1];
        if (nloc == 0u) { xcd_barrier_complete(bar, b.x, nloc, nx); b.st[0] = nloc; b.st[1] = nx; }
        const unsigned old = xb_add(&bar[XB_XSUB(b.x)], 1u);
        const unsigned gen = old / nloc;
        if (old + 1u == (gen + 1u) * nloc) {
            __builtin_amdgcn_fence(__ATOMIC_RELEASE, "agent");
            asm volatile("s_waitcnt vmcnt(0)" ::: "memory");
            const unsigned og = xb_add(&bar[XB_TOP], 1u);
            const unsigned tg = og / nx;
            if (og + 1u == (tg + 1u) * nx) xb_add(&bar[XB_TOPGEN], 1u);
            else XB_SPIN(xb_ld(&bar[XB_TOPGEN]) == tg, bar);
            __builtin_amdgcn_fence(__ATOMIC_ACQUIRE, "agent");
            xb_add(&bar[XB_XGEN(b.x)], 1u);
            asm volatile("s_waitcnt vmcnt(0)" ::: "memory");
        } else {
            XB_SPIN(xb_ld(&bar[XB_XGEN(b.x)]) == gen, bar);
            __builtin_amdgcn_fence(__ATOMIC_ACQUIRE, "agent");
            asm volatile("s_waitcnt vmcnt(0)" ::: "memory");
        }
    }
    __syncthreads();
}
constexpr int NWAVES = 8, NTHR = NWAVES * 64;
constexpr int MB = 2, MSEQ = 8192, MD = 1024, MT = MB * MSEQ;
constexpr float LOG2E = 1.4426950408889634f;
constexpr float QSCALE = 0.125f * LOG2E;
constexpr size_t MiB = 1u << 20;
constexpr size_t WS_CTL = 0, CTL_ZERO_BYTES = 1 * MiB;
constexpr size_t WS_WQKV = 1 * MiB;
constexpr size_t WS_WAO = 4 * MiB;
constexpr size_t WS_WGIN = 6 * MiB;
constexpr size_t WS_WAB = 14 * MiB;
constexpr size_t WS_WGO = 15 * MiB;
constexpr size_t WS_WR = 17 * MiB;
constexpr size_t WS_WGU = 18 * MiB;
constexpr size_t WS_WD = 50 * MiB;
constexpr size_t WS_XN = 66 * MiB;
constexpr size_t WS_LIST = 98 * MiB;
constexpr size_t WS_GLIST = 100 * MiB;
constexpr size_t WS_TOKSLOT = 102 * MiB;
constexpr size_t WS_H = 104 * MiB;
constexpr size_t WS_Y = 124 * MiB;
constexpr size_t WS_Q = 98 * MiB;
constexpr size_t WS_K = 130 * MiB;
constexpr size_t WS_V = 138 * MiB;
constexpr size_t WS_AO = 146 * MiB;
constexpr size_t WS_QKVPRE = 98 * MiB;
constexpr size_t WS_Z = 194 * MiB;
constexpr size_t WS_GB = 226 * MiB;
constexpr size_t WS_OF = 66 * MiB;
constexpr size_t WS_OB = 18 * MiB;
constexpr size_t WS_ON = 98 * MiB;
constexpr size_t WS_END = 285 * MiB;
constexpr int CW_TMO = 0, CW_CODE = 1, CW_BAR = 4096, CW_CNT = 16384;
constexpr int RING_OFF = 0, RING_BYTES = 153600, LDSCTL_OFF = RING_BYTES, MISC_OFF = LDSCTL_OFF + 320, MOETAB_OFF = LDSCTL_OFF + 1024, LDS_BYTES = 163840;

__device__ __forceinline__ float bf2f(unsigned short v) { return __uint_as_float((unsigned)v << 16); }
__device__ __forceinline__ float wsum(float v) {
#pragma unroll
    for (int o = 1; o < 64; o <<= 1) v += __shfl_xor(v, o);
    return v;
}
__device__ __forceinline__ float wmax(float v) {
#pragma unroll
    for (int o = 1; o < 64; o <<= 1) v = fmaxf(v, __shfl_xor(v, o));
    return v;
}
__device__ __forceinline__ float silu_f(float x) { return x * __builtin_amdgcn_rcpf(1.f + __expf(-x)); }
typedef unsigned u32x2_t __attribute__((ext_vector_type(2)));
__device__ __forceinline__ int opq(int x) { asm volatile("" : "+v"(x)); return x; }
__device__ __forceinline__ int lane_id() { return (int)__builtin_amdgcn_mbcnt_hi(~0u, __builtin_amdgcn_mbcnt_lo(~0u, 0u)); }
__device__ __forceinline__ int opqs(int x) { asm volatile("" : "+s"(x)); return x; }
#define PHASE_IDS(F) const int wave = opqs((F).wv), lane = opq(lane_id()), tid = wave * 64 + lane, gw = (F).gwb + wave; (void)tid; (void)lane; (void)wave; (void)gw

struct Ctx {
    LAS unsigned char* lds;
    volatile LAS unsigned* MISC;
    gu32* ctl;
    int G, gwb, NGW, wv;
    const float* in[21];
    float* out; unsigned char* ws;
};

template <class RowMap>
__device__ __forceinline__ void transpose_item(const float* W, int ldw, int K, bf16* WT, RowMap rm, LAS float* scr, int kb, int nb, int lane) {
    const int k0 = 64 * kb, n0 = 32 * nb;
    float tv[32];
#pragma unroll
    for (int i = 0; i < 32; ++i) tv[i] = W[(size_t)(k0 + 2 * i + (lane >> 5)) * ldw + n0 + (lane & 31)];
#pragma unroll
    for (int i = 0; i < 32; ++i) scr[(2 * i + (lane >> 5)) * 33 + (lane & 31)] = tv[i];
    LDS_WAIT(); asm volatile("" ::: "memory");
    const int c = lane & 7;
#pragma unroll
    for (int j = 0; j < 4; ++j) { const int n = (lane >> 3) + 8 * j; const LAS float* s = scr + (8 * c) * 33 + n;
        v4u o; o.x = pk2(s[0 * 33], s[1 * 33]); o.y = pk2(s[2 * 33], s[3 * 33]); o.z = pk2(s[4 * 33], s[5 * 33]); o.w = pk2(s[6 * 33], s[7 * 33]);
        *(GAS v4u*)(WT + (size_t)rm(n0 + n) * K + k0 + 8 * c) = o; }
    LDS_WAIT(); asm volatile("" ::: "memory");
}
__device__ __forceinline__ void rms_row_to_bf16(const float* xrow, const float* g, bf16* orow, int lane) {
    const GAS f32x4* xr = (const GAS f32x4*)xrow + lane; const GAS f32x4* gr = (const GAS f32x4*)g + lane;
    f32x4 v[4]; float s = 0.f;
#pragma unroll
    for (int j = 0; j < 4; ++j) { v[j] = xr[64 * j]; s += (v[j].x * v[j].x + v[j].y * v[j].y) + (v[j].z * v[j].z + v[j].w * v[j].w); }
    const float rs = rsqrtf(wsum(s) * (1.f / MD) + 1e-6f);
    GAS unsigned long long* o8 = (GAS unsigned long long*)orow + lane;
#pragma unroll
    for (int j = 0; j < 4; ++j) { const f32x4 gg = gr[64 * j]; o8[64 * j] = (unsigned long long)pk2(v[j].x * rs * gg.x, v[j].y * rs * gg.y) | ((unsigned long long)pk2(v[j].z * rs * gg.z, v[j].w * rs * gg.w) << 32); }
}
__device__ __forceinline__ int qkv_rowmap(int c) { const int cl = c & 255; return (c & ~255) + ((cl >> 5) & 1) * 128 + (cl >> 6) * 32 + (cl & 31); }

__device__ __forceinline__ void moe_convert(Ctx& F, int layer, int widx, int wcnt, int part) {
    PHASE_IDS(F);
    LAS float* scr = (LAS float*)(F.lds + RING_OFF + wave * 16384);
    const float* Wg = F.in[18] + (size_t)layer * 32 * MD * 256; const float* Wu = F.in[19] + (size_t)layer * 32 * MD * 256; const float* Wd = F.in[20] + (size_t)layer * 32 * 256 * MD;
    bf16* WGU = (bf16*)(F.ws + WS_WGU); bf16* WD = (bf16*)(F.ws + WS_WD);
    const int lo = part == 2 ? 6144 : 0, hi = part == 0 ? 12288 : (part == 1 ? 6144 : (part == 2 ? 12288 : (part == 3 ? 8192 : 4096)));
    for (int it = lo + widx; it < hi; it += wcnt) {
        int e, r;
        if (part < 3) { e = it / 384; r = it % 384; } else if (part == 3) { e = it >> 8; r = it & 255; } else { e = it >> 7; r = 256 + (it & 127); }
        if (r < 128) transpose_item(Wg + (size_t)e * MD * 256, 256, MD, WGU, [e](int f) { return e * 512 + ((f >> 7) << 8) + (f & 127); }, scr, r >> 3, r & 7, lane);
        else if (r < 256) transpose_item(Wu + (size_t)e * MD * 256, 256, MD, WGU, [e](int f) { return e * 512 + ((f >> 7) << 8) + 128 + (f & 127); }, scr, (r - 128) >> 3, (r - 128) & 7, lane);
        else transpose_item(Wd + (size_t)e * 256 * MD, MD, 256, WD, [e](int d) { return e * 1024 + d; }, scr, (r - 256) >> 5, (r - 256) & 31, lane);
    }
}
__device__ __forceinline__ void p0_prologue(Ctx& F) {
    PHASE_IDS(F);
    LAS float* scr = (LAS float*)(F.lds + RING_OFF + wave * 16384);
    constexpr int I_QKV = 16 * 48, I_AO = 16 * 32, I_GIN = 16 * 128, I_AB = 16, I_GO = 16 * 32;
    for (int it = gw; it < I_QKV + I_AO + I_GIN + I_AB + I_GO; it += F.NGW) {
        int r = it;
        if (r < I_QKV) { transpose_item(F.in[3], 1536, MD, (bf16*)(F.ws + WS_WQKV), [](int c) { return qkv_rowmap(c); }, scr, r / 48, r % 48, lane); continue; } r -= I_QKV;
        if (r < I_AO) { transpose_item(F.in[7], MD, MD, (bf16*)(F.ws + WS_WAO), [](int c) { return c; }, scr, r >> 5, r & 31, lane); continue; } r -= I_AO;
        if (r < I_GIN) { transpose_item(F.in[8], 4128, MD, (bf16*)(F.ws + WS_WGIN), [](int c) { return c; }, scr, r >> 7, r & 127, lane); continue; } r -= I_GIN;
        if (r < I_AB) { transpose_item(F.in[8], 4128, MD, (bf16*)(F.ws + WS_WAB), [](int c) { return c - 4096; }, scr, r, 128, lane); continue; } r -= I_AB;
        transpose_item(F.in[13], MD, MD, (bf16*)(F.ws + WS_WGO), [](int c) { return c; }, scr, r >> 5, r & 31, lane);
    }
    for (int layer = 0; layer < 2; ++layer) { bf16* wr = (bf16*)(F.ws + WS_WR + (size_t)layer * 131072); const float* wg = F.in[14] + (size_t)layer * MD * 4; const float* we = F.in[16] + (size_t)layer * MD * 32;
        for (int idx = gw * 64 + lane; idx < 48 * MD; idx += F.NGW * 64) { const int r = idx >> 10, k = idx & 1023;
            const float v = r < 4 ? wg[k * 4 + r] : (r < 36 ? we[k * 32 + (r - 4)] : 0.f); wr[idx] = (bf16)f2bf(v); } }
    moe_convert(F, 0, gw, F.NGW, 1);
    for (int m = gw; m < MT; m += F.NGW) rms_row_to_bf16(F.in[0] + (size_t)m * MD, F.in[1], (bf16*)(F.ws + WS_XN) + (size_t)m * MD, lane);
}

__device__ __forceinline__ void attn_simple(Ctx& F) {
    PHASE_IDS(F);
    LAS float* qs = (LAS float*)(F.lds + RING_OFF + wave * 2048);
    LAS float* ps = qs + 64;
    const bf16* Q = (const bf16*)(F.ws + WS_Q); const bf16* K = (const bf16*)(F.ws + WS_K); const bf16* V = (const bf16*)(F.ws + WS_V); bf16* AO = (bf16*)(F.ws + WS_AO);
    const float* sink = F.in[6];
    for (int item = gw; item < MT * 16; item += F.NGW) {
        const int t = item >> 4, h = item & 15, b = t / MSEQ, tt = t % MSEQ, g = h >> 2;
        const float slope2 = exp2f(-8.0f * (float)(h + 1) / 16.0f) * LOG2E;
        qs[lane] = bf2f(Q[(size_t)t * 1024 + h * 64 + lane]);
        LDS_WAIT(); asm volatile("" ::: "memory");
        float sc[5]; bool valid[5]; float mx = -INFINITY;
#pragma unroll
        for (int i = 0; i < 5; ++i) {
            const int j = lane + 64 * i, s = tt - 128 + j;
            valid[i] = (j <= 256) && s >= 0 && s < MSEQ; sc[i] = -INFINITY;
            if (valid[i]) {
                const GAS v4u* kp = (const GAS v4u*)(K + (size_t)(b * MSEQ + s) * 256 + g * 64);
                float dot = 0.f;
#pragma unroll
                for (int d = 0; d < 8; ++d) { const v4u kv = kp[d];
                    dot += qs[8 * d + 0] * __uint_as_float(kv.x << 16) + qs[8 * d + 1] * __uint_as_float(kv.x & 0xffff0000u) + qs[8 * d + 2] * __uint_as_float(kv.y << 16) + qs[8 * d + 3] * __uint_as_float(kv.y & 0xffff0000u)
                         + qs[8 * d + 4] * __uint_as_float(kv.z << 16) + qs[8 * d + 5] * __uint_as_float(kv.z & 0xffff0000u) + qs[8 * d + 6] * __uint_as_float(kv.w << 16) + qs[8 * d + 7] * __uint_as_float(kv.w & 0xffff0000u); }
                const int dist = tt > s ? tt - s : s - tt;
                sc[i] = dot - slope2 * (float)dist; mx = fmaxf(mx, sc[i]);
            }
        }
        const float sk2 = sink[h] * LOG2E;
        const float m = fmaxf(wmax(mx), sk2);
        float psum = 0.f;
#pragma unroll
        for (int i = 0; i < 5; ++i) { const float p = valid[i] ? exp2f(sc[i] - m) : 0.f; ps[i * 64 + lane] = p; psum += p; }
        const float denom = wsum(psum) + exp2f(sk2 - m);
        LDS_WAIT(); asm volatile("" ::: "memory");
        float acc = 0.f;
        for (int j = 0; j <= 256; ++j) { const int s = tt - 128 + j; if (s >= 0 && s < MSEQ) acc += ps[j] * bf2f(V[(size_t)(b * MSEQ + s) * 256 + g * 64 + lane]); }
        AO[(size_t)t * 1024 + h * 64 + lane] = (bf16)f2bf(acc / denom);
        LDS_WAIT(); asm volatile("" ::: "memory");
    }
}

__device__ __forceinline__ void moe_tables(Ctx& F, int layer, int npn) {
    PHASE_IDS(F);
    LAS int* tab = (LAS int*)(F.lds + MOETAB_OFF);
    __syncthreads();
    if (tid < 32) tab[tid] = (int)__hip_atomic_load(F.ctl + CW_CNT + 64 * layer + tid, RLX_AGENT);
    __syncthreads();
    if (tid == 0) { int seg = 0, ub = 0; for (int e = 0; e < 32; ++e) { tab[32 + e] = seg; tab[65 + e] = ub; const int mt = (tab[e] + 255) >> 8; seg += mt << 8; ub += mt * npn; } tab[64] = seg; tab[97] = ub; }
    __syncthreads();
}
__device__ __forceinline__ void wg_self_visible(Ctx& F) {
    PHASE_IDS(F);
    VM_WAIT(); __syncthreads();
    if (tid == 0) { __builtin_amdgcn_fence(__ATOMIC_ACQUIRE, "agent"); VM_WAIT(); }
    __syncthreads();
}
__device__ __forceinline__ void p4_router(Ctx& F, int layer) {
    PHASE_IDS(F);
    const float* X = F.out; const float* g = F.in[2] + (size_t)layer * MD; bf16* XN = (bf16*)(F.ws + WS_XN);
    const bf16* Wr = (const bf16*)(F.ws + WS_WR + (size_t)layer * 131072);
    const float* bg = F.in[15] + layer * 4; const float* be = F.in[17] + layer * 32;
    gu32* cnt = F.ctl + CW_CNT + 64 * layer;
    int* list = (int*)(F.ws + WS_LIST); float* glist = (float*)(F.ws + WS_GLIST); int* tokslot = (int*)(F.ws + WS_TOKSLOT);
    LAS float* lg = (LAS float*)(F.lds + RING_OFF);
    const int w = wave, fr = lane & 15, fq = lane >> 4;
    for (int rb = blockIdx.x; rb < MT / 64; rb += F.G) {
        const int row0 = rb * 64;
        for (int r = 0; r < 8; ++r) { const size_t row = (size_t)(row0 + 8 * w + r); rms_row_to_bf16(X + row * MD, g, XN + row * MD, lane); }
        wg_self_visible(F);
        if (w < 4) {
            pg8::f32x4 acc[3] = {{0.f, 0.f, 0.f, 0.f}, {0.f, 0.f, 0.f, 0.f}, {0.f, 0.f, 0.f, 0.f}};
            const bf16* arow = XN + (size_t)(row0 + 16 * w + fr) * MD + 8 * fq; const bf16* brow = Wr + (size_t)fr * MD + 8 * fq;
#pragma unroll 4
            for (int ks = 0; ks < 32; ++ks) {
                const bf16x8 a = *(const GAS bf16x8*)(arow + 32 * ks);
#pragma unroll
                for (int nt = 0; nt < 3; ++nt) { const bf16x8 b = *(const GAS bf16x8*)(brow + (size_t)nt * 16 * MD + 32 * ks); acc[nt] = __builtin_amdgcn_mfma_f32_16x16x32_bf16(b, a, acc[nt], 0, 0, 0); }
            }
#pragma unroll
            for (int nt = 0; nt < 3; ++nt)
#pragma unroll
                for (int r = 0; r < 4; ++r) lg[(16 * w + fr) * 49 + 16 * nt + 4 * fq + r] = acc[nt][r];
        }
        __syncthreads();
        if (tid < 64) {
            const LAS float* l = lg + tid * 49; const int tok = row0 + tid;
            float gl[4]; for (int i = 0; i < 4; ++i) gl[i] = l[i] + bg[i];
            int gi = 0; float gm = gl[0];
            for (int i = 1; i < 4; ++i) if (gl[i] > gm) { gm = gl[i]; gi = i; }
            float gs = 0.f; for (int i = 0; i < 4; ++i) gs += __expf(gl[i] - gm);
            const float gprob = 1.f / gs;
            int e1 = 0, e2 = -1; float m1 = -INFINITY, m2 = -INFINITY;
            for (int i = 0; i < 8; ++i) { const float v = l[4 + gi * 8 + i] + be[gi * 8 + i]; if (v > m1) { m2 = m1; e2 = e1; m1 = v; e1 = i; } else if (v > m2) { m2 = v; e2 = i; } }
            const float p2 = __expf(m2 - m1), inv = 1.f / (1.f + p2);
            const int x1 = gi * 8 + e1, x2 = gi * 8 + e2;
            const unsigned pos1 = __hip_atomic_fetch_add(cnt + x1, 1u, RLX_AGENT), pos2 = __hip_atomic_fetch_add(cnt + x2, 1u, RLX_AGENT);
            list[x1 * 16384 + pos1] = tok; glist[x1 * 16384 + pos1] = gprob * inv;
            list[x2 * 16384 + pos2] = tok; glist[x2 * 16384 + pos2] = gprob * p2 * inv;
            tokslot[tok * 2] = (x1 << 16) | (int)pos1; tokslot[tok * 2 + 1] = (x2 << 16) | (int)pos2;
        }
        __syncthreads();
    }
}
template <bool NEXT>
__device__ __forceinline__ void p7_combine(Ctx& F) {
    PHASE_IDS(F);
    const LAS int* tab = (const LAS int*)(F.lds + MOETAB_OFF);
    const int* tokslot = (const int*)(F.ws + WS_TOKSLOT); const bf16* Y = (const bf16*)(F.ws + WS_Y); float* X = F.out;
    bf16* XN = (bf16*)(F.ws + WS_XN); const float* gn = F.in[1] + MD;
    const int w = wave, fr = lane & 15, fq = lane >> 4;
    for (int rb = blockIdx.x; rb < MT / 64; rb += F.G) {
        const int row0 = rb * 64;
        for (int r = 0; r < 8; ++r) {
            const int t = row0 + 8 * w + r;
            const int s0 = tokslot[t * 2], s1 = tokslot[t * 2 + 1];
            const size_t y0 = (size_t)(tab[32 + (s0 >> 16)] + (s0 & 0xffff)), y1 = (size_t)(tab[32 + (s1 >> 16)] + (s1 & 0xffff));
            GAS f32x4* xr = (GAS f32x4*)(X + (size_t)t * MD) + lane;
            const GAS u32x2_t* a = (const GAS u32x2_t*)(Y + y0 * MD) + lane; const GAS u32x2_t* b = (const GAS u32x2_t*)(Y + y1 * MD) + lane;
            f32x4 v[4]; float ss = 0.f;
#pragma unroll
            for (int j = 0; j < 4; ++j) { v[j] = xr[64 * j]; const u32x2_t p = a[64 * j], q = b[64 * j];
                v[j].x += __uint_as_float(p.x << 16) + __uint_as_float(q.x << 16); v[j].y += __uint_as_float(p.x & 0xffff0000u) + __uint_as_float(q.x & 0xffff0000u);
                v[j].z += __uint_as_float(p.y << 16) + __uint_as_float(q.y << 16); v[j].w += __uint_as_float(p.y & 0xffff0000u) + __uint_as_float(q.y & 0xffff0000u);
                xr[64 * j] = v[j]; ss += (v[j].x * v[j].x + v[j].y * v[j].y) + (v[j].z * v[j].z + v[j].w * v[j].w); }
            if constexpr (NEXT) {
                const float rs = rsqrtf(wsum(ss) * (1.f / MD) + 1e-6f);
                GAS unsigned long long* o8 = (GAS unsigned long long*)(XN + (size_t)t * MD) + lane; const GAS f32x4* gr = (const GAS f32x4*)gn + lane;
#pragma unroll
                for (int j = 0; j < 4; ++j) { const f32x4 gg = gr[64 * j]; o8[64 * j] = (unsigned long long)pk2(v[j].x * rs * gg.x, v[j].y * rs * gg.y) | ((unsigned long long)pk2(v[j].z * rs * gg.z, v[j].w * rs * gg.w) << 32); }
            }
        }
        if constexpr (NEXT) {
            wg_self_visible(F);
            if (w < 4) {
                const bf16* Wab = (const bf16*)(F.ws + WS_WAB); float* GB = (float*)(F.ws + WS_GB);
                pg8::f32x4 acc[2] = {{0.f, 0.f, 0.f, 0.f}, {0.f, 0.f, 0.f, 0.f}};
                const bf16* arow = XN + (size_t)(row0 + 16 * w + fr) * MD + 8 * fq; const bf16* brow = Wab + (size_t)fr * MD + 8 * fq;
#pragma unroll 4
                for (int ks = 0; ks < 32; ++ks) {
                    const bf16x8 a = *(const GAS bf16x8*)(arow + 32 * ks);
#pragma unroll
                    for (int nt = 0; nt < 2; ++nt) { const bf16x8 b = *(const GAS bf16x8*)(brow + (size_t)nt * 16 * MD + 32 * ks); acc[nt] = __builtin_amdgcn_mfma_f32_16x16x32_bf16(b, a, acc[nt], 0, 0, 0); }
                }
                const int tok = row0 + 16 * w + fr;
#pragma unroll
                for (int r = 0; r < 4; ++r) { const int c = 4 * fq + r;
                    const float xx = acc[0][r] + F.in[11][c]; const float sp = fmaxf(xx, 0.f) + log1pf(__expf(-fabsf(xx)));
                    GB[(size_t)tok * 32 + c] = -__expf(F.in[10][c]) * sp;
                    GB[(size_t)tok * 32 + 16 + c] = 1.f / (1.f + __expf(-acc[1][r])); }
            }
        }
    }
}

__device__ __forceinline__ void gdn_scan_naive(Ctx& F) {
    PHASE_IDS(F);
    constexpr int TS = 16;
    const int sq = blockIdx.x, b = sq >> 4, h = (sq >> 1) & 7, dir = sq & 1, w = wave;
    LAS float* qs = (LAS float*)(F.lds + RING_OFF);
    LAS float* red = qs + 3 * TS * 128;
    const bf16* pre = (const bf16*)(F.ws + WS_QKVPRE) + (size_t)b * MSEQ * 3072;
    const float* GB = (const float*)(F.ws + WS_GB) + (size_t)b * MSEQ * 32;
    bf16* od = (bf16*)(F.ws + (dir ? WS_OB : WS_OF)) + (size_t)b * MSEQ * MD;
    const float* convw = F.in[9];
    const int wh = tid >> 7, j = tid & 127;
    float cw[4] = {0.f, 0.f, 0.f, 0.f};
    if (tid < 384) {
#pragma unroll
        for (int jj = 0; jj < 4; ++jj) cw[jj] = convw[jj * 3072 + wh * 1024 + h * 128 + j]; }
    LAS float* kspart = red + 2 * TS;
    LAS float* opart = kspart + 2 * 4 * 128;
    const int part = tid >> 7, jc = tid & 127;
    float St[32];
#pragma unroll
    for (int i = 0; i < 32; ++i) St[i] = 0.f;
    for (int tile = 0; tile < MSEQ / TS; ++tile) {
        __syncthreads();
        if (tid < 384) {
            for (int st = 0; st < TS; ++st) {
                const int n = tile * TS + st, t = dir ? MSEQ - 1 - n : n;
                float a = 0.f;
#pragma unroll
                for (int jj = 0; jj < 4; ++jj) { const int tt = t + jj - 2; if (tt >= 0 && tt < MSEQ) a += cw[jj] * bf2f(pre[(size_t)tt * 3072 + wh * 1024 + h * 128 + j]); }
                qs[(wh * TS + st) * 128 + j] = silu_f(a);
            }
        }
        __syncthreads();
        for (int rr = w; rr < 2 * TS; rr += NWAVES) { const int which = rr & 1, st = rr >> 1; const float a0 = qs[(which * TS + st) * 128 + lane], a1 = qs[(which * TS + st) * 128 + lane + 64];
            const float ss = wsum(a0 * a0 + a1 * a1); if (lane == 0) red[which * TS + st] = ss; }
        __syncthreads();
        for (int st = 0; st < TS; ++st) {
            const float qn = rsqrtf(red[st] + 1e-6f) * 0.08838834764831845f, kn = rsqrtf(red[TS + st] + 1e-6f);
            const int n = tile * TS + st, t = dir ? MSEQ - 1 - n : n;
            const float gg = GB[(size_t)t * 32 + dir * 8 + h], beta = GB[(size_t)t * 32 + 16 + dir * 8 + h];
            const float dec = __expf(gg);
            const LAS float* kk = qs + (TS + st) * 128 + 32 * part; const LAS float* qq = qs + st * 128 + 32 * part;
            float ksp = 0.f;
#pragma unroll
            for (int i = 0; i < 32; ++i) ksp += kk[i] * St[i];
            kspart[((st & 1) * 4 + part) * 128 + jc] = ksp;
            __syncthreads();
            const LAS float* kp = kspart + (st & 1) * 4 * 128 + jc;
            const float kS = ((kp[0] + kp[128]) + (kp[256] + kp[384])) * kn * dec;
            const float vn = beta * (qs[(2 * TS + st) * 128 + jc] - kS) * kn;
            float ov = 0.f;
#pragma unroll
            for (int i = 0; i < 32; ++i) { St[i] = dec * St[i] + kk[i] * vn; ov += qq[i] * St[i]; }
            opart[(st * 4 + part) * 128 + jc] = ov * qn;
        }
        __syncthreads();
        for (int e = tid; e < TS * 128; e += NTHR) { const int st = e >> 7, c = e & 127; const LAS float* op = opart + st * 4 * 128 + c;
            const int n = tile * TS + st, t = dir ? MSEQ - 1 - n : n;
            od[(size_t)t * MD + h * 128 + c] = (bf16)f2bf((op[0] + op[128]) + (op[256] + op[384])); }
    }
}
__device__ __forceinline__ void gdn_gate(Ctx& F) {
    PHASE_IDS(F);
    const unsigned* of = (const unsigned*)(F.ws + WS_OF); const unsigned* ob = (const unsigned*)(F.ws + WS_OB); const unsigned* z = (const unsigned*)(F.ws + WS_Z);
    unsigned* on = (unsigned*)(F.ws + WS_ON); const float* og = F.in[12];
    const float g0 = og[2 * lane], g1 = og[2 * lane + 1];
    for (int it = gw; it < MT * 8; it += F.NGW) {
        const size_t idx = (size_t)it * 64 + lane;
        const unsigned a = of[idx], bb = ob[idx], zz = z[idx];
        const float o0 = __uint_as_float(a << 16) + __uint_as_float(bb << 16), o1 = __uint_as_float(a & 0xffff0000u) + __uint_as_float(bb & 0xffff0000u);
        const float rs = rsqrtf(wsum(o0 * o0 + o1 * o1) * (1.f / 128.f) + 1e-6f);
        on[idx] = pk2(o0 * rs * g0 * silu_f(__uint_as_float(zz << 16)), o1 * rs * g1 * silu_f(__uint_as_float(zz & 0xffff0000u)));
    }
}

constexpr size_t WS_HALO = 228 * MiB;
constexpr size_t WS_REC = 233 * MiB;
constexpr int REC_BYTES = 13312;
constexpr int PQT = 0, PKT = 17408, PSC = 34816, PLB = 36864, PLB_STRIDE = 8704;
typedef short v4i16_t __attribute__((ext_vector_type(4)));

__device__ __forceinline__ int tri_off(int i) { const int a = (i - 1) >> 2, r = (i - 1) & 3; return 4 * (a + 1) * (2 * a + r); }
__device__ __forceinline__ int img_off(int i, int j) {
    const int mt = i >> 4, ks = j >> 5, f = mt < 2 ? mt : 2 + (mt - 2) * 2 + ks, cc = j & 31, g = (cc & 15) >> 2, jj = (cc & 3) + ((cc >> 4) << 2);
    return f * 1024 + ((g * 16 + (i & 15)) * 8 + jj) * 2;
}
__device__ __forceinline__ void gdn_prep(Ctx& F) {
    PHASE_IDS(F);
    LAS unsigned char* L = F.lds + RING_OFF;
    bf16* QKV = (bf16*)(F.ws + WS_QKVPRE); const bf16* HALO = (const bf16*)(F.ws + WS_HALO); const float* GB = (const float*)(F.ws + WS_GB);
    unsigned char* REC = F.ws + WS_REC; const float* convw = F.in[9];
    for (int batch = blockIdx.x; batch < 512; batch += F.G) {
        const int b = batch >> 8, h = (batch >> 5) & 7, n0 = (batch & 31) * 4;
#pragma unroll 1
        for (int c4 = 0; c4 < 4; ++c4) {
            const int n = n0 + c4, t0 = n * 64;
            const int tidc = opq(tid), lanec = tidc & 63, g4 = lanec >> 4, l16 = lanec & 15;
            const int rg = tidc / 48, rem = tidc - 48 * rg, which = rem >> 4, c16 = rem & 15;
            const int col = which * 1024 + h * 128 + c16 * 8;
            v4u in[11];
            if (tidc < 384) {
#pragma unroll
                for (int ri = 0; ri < 11; ++ri) { const int lr = 8 * rg - 2 + ri; const bf16* src = nullptr;
                    if (lr >= 0 && lr < 64) src = QKV + ((size_t)(b * MSEQ + t0 + lr) * 3072 + col);
                    else if (lr < 0) { if (n > 0) src = HALO + ((size_t)((b * 128 + n - 1) * 3 + (lr + 3)) * 3072 + col); }
                    else { if (n < 127) src = HALO + ((size_t)((b * 128 + n + 1) * 3) * 3072 + col); }
                    in[ri] = src ? *(const GAS v4u*)src : (v4u){0u, 0u, 0u, 0u}; }
            }
            __syncthreads();
            if (tidc < 384) {
                float cw[4][8];
#pragma unroll
                for (int jj = 0; jj < 4; ++jj) { const GAS f32x4* p = (const GAS f32x4*)(convw + jj * 3072 + col); const f32x4 a = p[0], bq = p[1];
                    cw[jj][0] = a.x; cw[jj][1] = a.y; cw[jj][2] = a.z; cw[jj][3] = a.w; cw[jj][4] = bq.x; cw[jj][5] = bq.y; cw[jj][6] = bq.z; cw[jj][7] = bq.w; }
#pragma unroll
                for (int r = 0; r < 8; ++r) {
                    float o[8];
#pragma unroll
                    for (int c = 0; c < 8; ++c) o[c] = 0.f;
#pragma unroll
                    for (int jj = 0; jj < 4; ++jj) { const v4u x = in[r + jj];
                        o[0] += cw[jj][0] * __uint_as_float(x.x << 16); o[1] += cw[jj][1] * __uint_as_float(x.x & 0xffff0000u);
                        o[2] += cw[jj][2] * __uint_as_float(x.y << 16); o[3] += cw[jj][3] * __uint_as_float(x.y & 0xffff0000u);
                        o[4] += cw[jj][4] * __uint_as_float(x.z << 16); o[5] += cw[jj][5] * __uint_as_float(x.z & 0xffff0000u);
                        o[6] += cw[jj][6] * __uint_as_float(x.w << 16); o[7] += cw[jj][7] * __uint_as_float(x.w & 0xffff0000u); }
                    float ss = 0.f;
#pragma unroll
                    for (int c = 0; c < 8; ++c) { o[c] = silu_f(o[c]); ss += o[c] * o[c]; }
                    ss += __shfl_xor(ss, 1); ss += __shfl_xor(ss, 2); ss += __shfl_xor(ss, 4); ss += __shfl_xor(ss, 8);
                    const float sc = which == 0 ? rsqrtf(ss + 1e-6f) * 0.08838834764831845f : (which == 1 ? rsqrtf(ss + 1e-6f) : 1.f);
                    v4u w; w.x = pk2(o[0] * sc, o[1] * sc); w.y = pk2(o[2] * sc, o[3] * sc); w.z = pk2(o[4] * sc, o[5] * sc); w.w = pk2(o[6] * sc, o[7] * sc);
                    const int lr = 8 * rg + r;
                    *(GAS v4u*)(QKV + ((size_t)(b * MSEQ + t0 + lr) * 3072 + col)) = w;
                    if (which < 2) *(LAS v4u*)(L + (which ? PKT : PQT) + lr * 272 + c16 * 16) = w;
                }
            }
            if (wave < 2) {
                const int dir = wave, lane = lanec, tok = b * MSEQ + t0 + (dir ? 63 - lane : lane);
                const float gv = GB[(size_t)tok * 32 + dir * 8 + h], bv = GB[(size_t)tok * 32 + 16 + dir * 8 + h];
                float x = gv;
#pragma unroll
                for (int o = 1; o < 64; o <<= 1) { const float t = __shfl_up(x, o); if (lane >= o) x += t; }
                const float gl = __shfl(x, 63);
                LAS float* sc = (LAS float*)(L + PSC);
                sc[dir * 64 + lane] = x; sc[128 + dir * 64 + lane] = bv;
                float* rs = (float*)(REC + (size_t)((((b * 8 + h) * 2 + dir) * 128) + n) * REC_BYTES + 12288);
                const float eg = __expf(x);
                rs[lane] = bv * eg; rs[64 + lane] = bv; rs[128 + lane] = eg; rs[192 + lane] = __expf(gl - x);
            }
            __syncthreads();
            {
                const int m = wave >> 2, mt = wave & 3;
                const LAS float* sc = (const LAS float*)(L + PSC);
                bf16x8 afr[4];
#pragma unroll
                for (int ks = 0; ks < 4; ++ks) afr[ks] = *(const LAS bf16x8*)(L + (m ? PQT : PKT) + (16 * mt + l16) * 272 + (32 * ks + 8 * g4) * 2);
                LAS float* Lb0 = (LAS float*)(L + PLB + (c4 * 2) * PLB_STRIDE); LAS float* Lb1 = (LAS float*)(L + PLB + (c4 * 2 + 1) * PLB_STRIDE);
                bf16* im0 = (bf16*)(REC + (size_t)((((b * 8 + h) * 2 + 0) * 128) + n) * REC_BYTES + 6144);
                bf16* im1 = (bf16*)(REC + (size_t)((((b * 8 + h) * 2 + 1) * 128) + n) * REC_BYTES + 6144);
#pragma unroll
                for (int nt = 0; nt < 4; ++nt) {
                    pg8::f32x4 acc = {0.f, 0.f, 0.f, 0.f};
#pragma unroll
                    for (int ks = 0; ks < 4; ++ks) { const bf16x8 bfr = *(const LAS bf16x8*)(L + PKT + (16 * nt + l16) * 272 + (32 * ks + 8 * g4) * 2);
                        acc = __builtin_amdgcn_mfma_f32_16x16x32_bf16(afr[ks], bfr, acc, 0, 0, 0); }
                    const int j = 16 * nt + l16, jp = 63 - j;
                    const float gc0j = sc[j], gc1jp = sc[64 + jp];
#pragma unroll
                    for (int r = 0; r < 4; ++r) { const int i = 16 * mt + 4 * g4 + r, ip = 63 - i; const float val = acc[r];
                        if (m == 0) {
                            if (i > j) Lb0[tri_off(i) + j] = sc[128 + i] * val * __expf(sc[i] - gc0j);
                            else if (i < j) Lb1[tri_off(ip) + jp] = sc[192 + ip] * val * __expf(sc[64 + ip] - gc1jp);
                        } else {
                            if ((j >> 5) <= (i >> 5)) im0[img_off(i, j) >> 1] = (bf16)f2bf(i >= j ? val * __expf(sc[i] - gc0j) : 0.f);
                            if ((jp >> 5) <= (ip >> 5)) im1[img_off(ip, jp) >> 1] = (bf16)f2bf(ip >= jp ? val * __expf(sc[64 + ip] - gc1jp) : 0.f);
                        }
                    }
                }
            }
        }
        __syncthreads();
        {
            const int c4 = wave >> 1, dir = wave & 1, n = n0 + c4, lane = opq(tid) & 63;
            LAS float* Lb = (LAS float*)(L + PLB + wave * PLB_STRIDE);
            float x[64];
#pragma unroll
            for (int i = 0; i < 64; ++i) {
                const int off = tri_off(i);
                int dep = 0; if (i > 0) asm volatile("" : "+v"(dep) : "v"(x[i > 0 ? i - 1 : 0]));
                const LAS float* Lr = Lb + off + dep;
                float a0 = (i == lane) ? 1.f : 0.f, a1 = 0.f, a2 = 0.f, a3 = 0.f;
#pragma unroll
                for (int jb = 0; jb < (i + 3) / 4; ++jb) { const f32x4 l4 = *(const LAS f32x4*)(Lr + 4 * jb);
                    if (4 * jb + 0 < i) a0 -= l4.x * x[4 * jb + 0];
                    if (4 * jb + 1 < i) a1 -= l4.y * x[4 * jb + 1];
                    if (4 * jb + 2 < i) a2 -= l4.z * x[4 * jb + 2];
                    if (4 * jb + 3 < i) a3 -= l4.w * x[4 * jb + 3]; }
                x[i] = (a0 + a1) + (a2 + a3);
            }
            LDS_WAIT(); asm volatile("" ::: "memory");
            LAS bf16* stg = (LAS bf16*)Lb;
            const int cc = lane & 31, gq = (cc & 15) >> 2, jj = (cc & 3) + ((cc >> 4) << 2), ksl = lane >> 5;
#pragma unroll
            for (int i = 0; i < 64; ++i) { const int mt = i >> 4;
                if (ksl <= (i >> 5)) { const int f = mt < 2 ? mt : 2 + (mt - 2) * 2 + ksl; stg[f * 512 + (gq * 16 + (i & 15)) * 8 + jj] = (bf16)f2bf(x[i]); } }
            LDS_WAIT(); asm volatile("" ::: "memory");
            unsigned char* rec = REC + (size_t)((((b * 8 + h) * 2 + dir) * 128) + n) * REC_BYTES;
#pragma unroll
            for (int it = 0; it < 6; ++it) *(GAS v4u*)(rec + (it * 64 + lane) * 16) = *(const LAS v4u*)((LAS unsigned char*)Lb + (it * 64 + lane) * 16);
            LDS_WAIT(); asm volatile("" ::: "memory");
        }
        __syncthreads();
    }
}

constexpr int SKT = 0, SQT = 16384, SVT = 32768, SRC = 36864, SBUF = 50176;
__device__ __forceinline__ void glds16_asm(const void* gsrc, unsigned lds_dst) { unsigned keep;
    asm volatile("s_mov_b32 %0, m0\n\ts_mov_b32 m0, %2\n\ts_nop 0\n\tglobal_load_lds_dwordx4 %1, off\n\ts_mov_b32 m0, %0" : "=&s"(keep) : "v"(gsrc), "s"(lds_dst) : "memory"); }
__device__ __forceinline__ int kswz(int row) { return ((row & 7) << 1) | ((row >> 3) & 1); }
__device__ __forceinline__ void gdn_scan(Ctx& F) {
    PHASE_IDS(F);
    if (blockIdx.x >= 128) return;
    const int xcd = blockIdx.x & 7, idx = blockIdx.x >> 3, sp = idx & 3, sq = xcd * 4 + (idx >> 2), b = sq >> 4, h = (sq >> 1) & 7, dir = sq & 1;
    LAS unsigned char* L = F.lds + RING_OFF;
    const bf16* QKV = (const bf16*)(F.ws + WS_QKVPRE) + (size_t)b * MSEQ * 3072 + h * 128;
    const unsigned char* REC = F.ws + WS_REC + (size_t)(((b * 8 + h) * 2 + dir) * 128) * REC_BYTES;
    bf16* od = (bf16*)(F.ws + (dir ? WS_OB : WS_OF)) + (size_t)b * MSEQ * MD + h * 128 + sp * 32;
    const int g4 = lane >> 4, l16 = lane & 15;
    const unsigned lbase = (unsigned)(size_t)L;
    const char* lp[9]; int ldo[9]; long lstep[9];
#pragma unroll
    for (int k = 0; k < 9; ++k) { const int d = (wave < 2 ? 0 : wave - 2) + 6 * k; const int n0 = dir ? 127 : 0, t0 = n0 * 64;
        if (d < 32) { const int dd = d & 15, row = 4 * dd + g4, G = l16 ^ kswz(row), tok = t0 + (dir ? 63 - row : row);
            lp[k] = (const char*)(QKV + (size_t)tok * 3072 + (d < 16 ? 1024 : 0) + G * 8); lstep[k] = (dir ? -64L : 64L) * 6144; ldo[k] = d < 16 ? SKT + d * 1024 : SQT + (d - 16) * 1024; }
        else if (d < 36) { const int row = 16 * (d - 32) + (lane >> 2), tok = t0 + (dir ? 63 - row : row);
            lp[k] = (const char*)(QKV + (size_t)tok * 3072 + 2048 + sp * 32 + (lane & 3) * 8); lstep[k] = (dir ? -64L : 64L) * 6144; ldo[k] = SVT + (d - 32) * 1024; }
        else { lp[k] = (const char*)(REC + (size_t)n0 * REC_BYTES + (d - 36) * 1024 + lane * 16); lstep[k] = (dir ? -1L : 1L) * REC_BYTES; ldo[k] = SRC + (d - 36) * 1024; } }
    auto issue = [&](int s) {
        if (wave < 2) return;
        const unsigned bo = lbase + (unsigned)((s % 3) * SBUF);
#pragma unroll
        for (int k = 0; k < 9; ++k) { if (k == 8 && wave != 2) break;
            glds16_asm(lp[k], (unsigned)__builtin_amdgcn_readfirstlane((int)(bo + (unsigned)ldo[k]))); lp[k] += lstep[k]; }
    };
    pg8::f32x4 S[8]; bf16x8 Sb[4];
#pragma unroll
    for (int i = 0; i < 8; ++i) S[i] = (pg8::f32x4){0.f, 0.f, 0.f, 0.f};
#pragma unroll
    for (int i = 0; i < 4; ++i) Sb[i] = (bf16x8){0, 0, 0, 0, 0, 0, 0, 0};
    unsigned baseA[4], baseE[4];
    { const int fA = kswz(l16), rl = 4 * g4 + (l16 >> 2), fE = kswz(rl);
#pragma unroll
      for (int k = 0; k < 4; ++k) { baseA[k] = (unsigned)(l16 * 256 + (((4 * k + g4) ^ fA) << 4)); baseE[k] = (unsigned)(rl * 256 + (((4 * k + (l16 & 3)) ^ fE) << 4)); } }
    const unsigned baseV = (unsigned)(SVT + 4 * g4 * 64 + (16 * wave + l16) * 2), baseS = (unsigned)(SRC + 12288 + 16 * g4), baseI = (unsigned)(SRC + lane * 16), baseO = (unsigned)(SVT + lane * 64 + wave * 32);
    issue(0); issue(1);
    if (wave == 2) asm volatile("s_waitcnt vmcnt(9)" ::: "memory"); else if (wave > 2) asm volatile("s_waitcnt vmcnt(8)" ::: "memory");
    __builtin_amdgcn_s_barrier();
    v4u ost0 = {0u, 0u, 0u, 0u}, ost1 = {0u, 0u, 0u, 0u};
    for (int s = 0; s <= 128; ++s) {
        if (wave < 2 && s > 0) { const int n = dir ? 128 - s : s - 1, tok = n * 64 + (dir ? 63 - lane : lane);
            GAS v4u* op = (GAS v4u*)(od + (size_t)tok * MD + 16 * wave); op[0] = ost0; op[1] = ost1; }
        if (s == 128) break;
        if (s + 2 < 128) issue(s + 2);
        if (wave < 2) {
            const LAS unsigned char* buf = L + (s % 3) * SBUF;
            auto pack = [&](const pg8::f32x4& a, const pg8::f32x4& c) -> bf16x8 { v4u t; t.x = pk2(a[0], a[1]); t.y = pk2(a[2], a[3]); t.z = pk2(c[0], c[1]); t.w = pk2(c[2], c[3]); return __builtin_bit_cast(bf16x8, t); };
#define SCAN_F() __builtin_amdgcn_sched_barrier(0)
#define SCAN_LD(FK, FQ, mt) do { _Pragma("unroll") for (int ks = 0; ks < 4; ++ks) { FK[ks] = *(const LAS bf16x8*)(buf + baseA[ks] + SKT + (mt) * 4096); FQ[ks] = *(const LAS bf16x8*)(buf + baseA[ks] + SQT + (mt) * 4096); } } while (0)
#define SCAN_MM(FK, FQ, mt) do { P[mt] = (pg8::f32x4){0.f, 0.f, 0.f, 0.f}; O[mt] = (pg8::f32x4){0.f, 0.f, 0.f, 0.f}; _Pragma("unroll") for (int ks = 0; ks < 4; ++ks) { \
                P[mt] = __builtin_amdgcn_mfma_f32_16x16x32_bf16(FK[ks], Sb[ks], P[mt], 0, 0, 0); O[mt] = __builtin_amdgcn_mfma_f32_16x16x32_bf16(FQ[ks], Sb[ks], O[mt], 0, 0, 0); } } while (0)
#define SCAN_LDE(E, dt) do { _Pragma("unroll") for (int ks = 0; ks < 2; ++ks) { const LAS unsigned char* a0_ = buf + baseE[(dt) >> 1] + SKT + ks * 8192 + ((dt) & 1) * 8; \
                E[2 * ks] = __builtin_amdgcn_ds_read_tr16_b64_v4i16((LAS v4i16_t*)a0_); E[2 * ks + 1] = __builtin_amdgcn_ds_read_tr16_b64_v4i16((LAS v4i16_t*)(a0_ + 4096)); } } while (0)
#define SCAN_MME(E, dt) do { pg8::f32x4 acc_ = S[dt] * dd; _Pragma("unroll") for (int ks = 0; ks < 2; ++ks) { const bf16x8 afr_ = {E[2 * ks][0], E[2 * ks][1], E[2 * ks][2], E[2 * ks][3], E[2 * ks + 1][0], E[2 * ks + 1][1], E[2 * ks + 1][2], E[2 * ks + 1][3]}; \
                acc_ = __builtin_amdgcn_mfma_f32_16x16x32_bf16(afr_, vsb[ks], acc_, 0, 0, 0); } S[dt] = acc_; } while (0)
            pg8::f32x4 P[4], O[4];
            bf16x8 fk[4][4], fqa[2][4], fqb[2][4];
#pragma unroll
            for (int mt = 0; mt < 4; ++mt)
#pragma unroll
                for (int ks = 0; ks < 4; ++ks) fk[mt][ks] = *(const LAS bf16x8*)(buf + baseA[ks] + SKT + mt * 4096);
            SCAN_F();
#pragma unroll
            for (int mt = 0; mt < 2; ++mt)
#pragma unroll
                for (int ks = 0; ks < 4; ++ks) fqa[mt][ks] = *(const LAS bf16x8*)(buf + baseA[ks] + SQT + mt * 4096);
#pragma unroll
            for (int mt = 0; mt < 4; ++mt) { P[mt] = (pg8::f32x4){0.f, 0.f, 0.f, 0.f};
#pragma unroll
                for (int ks = 0; ks < 4; ++ks) P[mt] = __builtin_amdgcn_mfma_f32_16x16x32_bf16(fk[mt][ks], Sb[ks], P[mt], 0, 0, 0); }
            SCAN_F();
            f32x4 cv[4], bv[4]; unsigned short vv[4][4]; bf16x8 Tf[6];
#pragma unroll
            for (int mt = 0; mt < 4; ++mt) { cv[mt] = *(const LAS f32x4*)(buf + baseS + mt * 64); bv[mt] = *(const LAS f32x4*)(buf + baseS + 256 + mt * 64);
#pragma unroll
                for (int r = 0; r < 4; ++r) vv[mt][r] = *(const LAS unsigned short*)(buf + baseV + mt * 1024 + r * 64); }
#pragma unroll
            for (int f = 0; f < 6; ++f) Tf[f] = *(const LAS bf16x8*)(buf + baseI + f * 1024);
#pragma unroll
            for (int mt = 0; mt < 2; ++mt) { O[mt] = (pg8::f32x4){0.f, 0.f, 0.f, 0.f};
#pragma unroll
                for (int ks = 0; ks < 4; ++ks) O[mt] = __builtin_amdgcn_mfma_f32_16x16x32_bf16(fqa[mt][ks], Sb[ks], O[mt], 0, 0, 0); }
            SCAN_F();
            v4i16_t ea[4][4], eb[4][4];
#pragma unroll
            for (int dt = 0; dt < 4; ++dt) SCAN_LDE(ea[dt], dt);
            pg8::f32x4 R[4];
#pragma unroll
            for (int mt = 0; mt < 4; ++mt)
#pragma unroll
                for (int r = 0; r < 4; ++r) R[mt][r] = bv[mt][r] * bf2f(vv[mt][r]) - cv[mt][r] * P[mt][r];
            bf16x8 rb[2] = {pack(R[0], R[1]), pack(R[2], R[3])};
            pg8::f32x4 VN[4];
#pragma unroll
            for (int mt = 0; mt < 4; ++mt) { VN[mt] = (pg8::f32x4){0.f, 0.f, 0.f, 0.f};
#pragma unroll
                for (int ks = 0; ks <= (mt >> 1); ++ks) { const int f = mt < 2 ? mt : 2 + (mt - 2) * 2 + ks; VN[mt] = __builtin_amdgcn_mfma_f32_16x16x32_bf16(Tf[f], rb[ks], VN[mt], 0, 0, 0); } }
            SCAN_F();
            f32x4 egv[4], ekv[4]; bf16x8 If[6];
#pragma unroll
            for (int mt = 0; mt < 2; ++mt)
#pragma unroll
                for (int ks = 0; ks < 4; ++ks) fqb[mt][ks] = *(const LAS bf16x8*)(buf + baseA[ks] + SQT + (mt + 2) * 4096);
#pragma unroll
            for (int mt = 0; mt < 4; ++mt) ekv[mt] = *(const LAS f32x4*)(buf + baseS + 768 + mt * 64);
            const float dd = *(const LAS float*)(buf + SRC + 12288 + 4 * (128 + 63));
            bf16x8 vb[2] = {pack(VN[0], VN[1]), pack(VN[2], VN[3])};
            pg8::f32x4 VS[4];
#pragma unroll
            for (int mt = 0; mt < 4; ++mt)
#pragma unroll
                for (int r = 0; r < 4; ++r) VS[mt][r] = ekv[mt][r] * VN[mt][r];
            bf16x8 vsb[2] = {pack(VS[0], VS[1]), pack(VS[2], VS[3])};
#pragma unroll
            for (int mt = 0; mt < 2; ++mt) { O[mt + 2] = (pg8::f32x4){0.f, 0.f, 0.f, 0.f};
#pragma unroll
                for (int ks = 0; ks < 4; ++ks) O[mt + 2] = __builtin_amdgcn_mfma_f32_16x16x32_bf16(fqb[mt][ks], Sb[ks], O[mt + 2], 0, 0, 0); }
            SCAN_F();
#pragma unroll
            for (int dt = 0; dt < 4; ++dt) SCAN_LDE(eb[dt], dt + 4);
#pragma unroll
            for (int mt = 0; mt < 4; ++mt) egv[mt] = *(const LAS f32x4*)(buf + baseS + 512 + mt * 64);
#pragma unroll
            for (int f = 0; f < 6; ++f) If[f] = *(const LAS bf16x8*)(buf + baseI + 6144 + f * 1024);
#pragma unroll
            for (int dt = 0; dt < 4; ++dt) SCAN_MME(ea[dt], dt);
            SCAN_F();
#pragma unroll
            for (int dt = 0; dt < 4; ++dt) SCAN_MME(eb[dt], dt + 4);
#pragma unroll
            for (int mt = 0; mt < 4; ++mt) { pg8::f32x4 o;
#pragma unroll
                for (int r = 0; r < 4; ++r) o[r] = egv[mt][r] * O[mt][r];
#pragma unroll
                for (int ks = 0; ks <= (mt >> 1); ++ks) { const int f = mt < 2 ? mt : 2 + (mt - 2) * 2 + ks; o = __builtin_amdgcn_mfma_f32_16x16x32_bf16(If[f], vb[ks], o, 0, 0, 0); }
#pragma unroll
                for (int r = 0; r < 4; ++r) *(LAS unsigned short*)((LAS unsigned char*)buf + baseV + mt * 1024 + r * 64) = (unsigned short)f2bf(o[r]); }
#undef SCAN_F
#undef SCAN_LD
#undef SCAN_MM
#undef SCAN_LDE
#undef SCAN_MME
#pragma unroll
            for (int ks = 0; ks < 4; ++ks) Sb[ks] = pack(S[2 * ks], S[2 * ks + 1]);
            asm volatile("s_waitcnt lgkmcnt(0)" ::: "memory");
            ost0 = *(const LAS v4u*)(buf + baseO); ost1 = *(const LAS v4u*)(buf + baseO + 16);
        }
        if (s + 2 < 128 && wave >= 2) { if (wave == 2) asm volatile("s_waitcnt vmcnt(9) lgkmcnt(0)" ::: "memory"); else asm volatile("s_waitcnt vmcnt(8) lgkmcnt(0)" ::: "memory"); }
        else asm volatile("s_waitcnt vmcnt(0) lgkmcnt(0)" ::: "memory");
        __builtin_amdgcn_s_barrier();
    }
}

typedef float f32x16 __attribute__((ext_vector_type(16)));
constexpr int AKT = 0, AVT = 49152;
__device__ __forceinline__ void attn_mfma(Ctx& F) {
    PHASE_IDS(F);
    LAS unsigned char* L = F.lds + RING_OFF;
    const bf16* Q = (const bf16*)(F.ws + WS_Q); const bf16* K = (const bf16*)(F.ws + WS_K); const bf16* V = (const bf16*)(F.ws + WS_V); bf16* AO = (bf16*)(F.ws + WS_AO);
    const float M2 = 8.0f * LOG2E;
    const int r32 = lane & 31, hh = lane >> 5, G4 = lane >> 4, li = lane & 15;
    for (int unit = blockIdx.x; unit < 512; unit += F.G) {
        const int b = unit >> 8, g = (unit >> 6) & 3, n = unit & 63;
#pragma unroll
        for (int k = 0; k < 12; ++k) { const int d = wave + 8 * k, dd = d < 48 ? d : d - 48, row = 8 * dd + (lane >> 3), pos = lane & 7;
            int s = 128 * n - 128 + row; s = s < 0 ? 0 : (s > MSEQ - 1 ? MSEQ - 1 : s);
            const int Gs = d < 48 ? (pos ^ ((row >> 1) & 7)) : (pos ^ (((row >> 1) & 1) << 2));
            const bf16* src = (d < 48 ? K : V) + (size_t)(b * MSEQ + s) * 256 + g * 64 + Gs * 8;
            __builtin_amdgcn_global_load_lds((const unsigned*)src, (LAS unsigned*)(L + (d < 48 ? AKT : AVT) + dd * 1024), 16, 0, 0); }
        asm volatile("s_waitcnt vmcnt(0)" ::: "memory"); __syncthreads();
        const int head = 4 * g + (wave >> 1), qh = wave & 1;
        const float slope2 = exp2f(-8.0f * (float)(head + 1) / 16.0f) * LOG2E;
        const float sinkt = exp2f(F.in[6][head] * LOG2E - M2);
        const float wlo = n == 0 ? 128.f : 0.f, whi = n == 63 ? 256.f : 384.f; const bool edge = (n == 0) || (n == 63);
#pragma unroll 1
        for (int qt = 0; qt < 2; ++qt) {
            const int qi = 64 * qh + 32 * qt + r32; const size_t tok = (size_t)b * MSEQ + 128 * n + qi;
            bf16x8 qf[4];
#pragma unroll
            for (int ks = 0; ks < 4; ++ks) qf[ks] = *(const GAS bf16x8*)(Q + tok * 1024 + head * 64 + 16 * ks + 8 * hh);
            f32x16 O0, O1; float lsum = 0.f;
#pragma unroll
            for (int i = 0; i < 16; ++i) { O0[i] = 0.f; O1[i] = 0.f; }
#pragma unroll 1
            for (int kt9 = 0; kt9 < 9; ++kt9) {
                const int kt = 2 * qh + qt + kt9;
                f32x16 S;
#pragma unroll
                for (int i = 0; i < 16; ++i) S[i] = -M2;
                const int krow = 32 * kt + r32;
#pragma unroll
                for (int ks = 0; ks < 4; ++ks) { const bf16x8 kf = *(const LAS bf16x8*)(L + AKT + krow * 128 + (((2 * ks + hh) ^ ((krow >> 1) & 7)) << 4));
                    S = __builtin_amdgcn_mfma_f32_32x32x16_bf16(kf, qf[ks], S, 0, 0, 0); }
                const float fb = (float)(128 + qi - 32 * kt - 4 * hh);
                float P[16];
                if (kt9 >= 1 && kt9 <= 7 && !edge) {
#pragma unroll
                    for (int r = 0; r < 16; ++r) { const float kk = (float)((r & 3) + 8 * (r >> 2));
                        const float p = __builtin_amdgcn_exp2f(S[r] - slope2 * __builtin_fabsf(fb - kk)); P[r] = p; lsum += p; }
                } else {
                    const float wb = (float)(32 * kt + 4 * hh);
#pragma unroll
                    for (int r = 0; r < 16; ++r) { const float kk = (float)((r & 3) + 8 * (r >> 2)); const float dist = __builtin_fabsf(fb - kk), w = wb + kk;
                        const bool ok = dist <= 128.f && w >= wlo && w < whi;
                        const float p = ok ? __builtin_amdgcn_exp2f(S[r] - slope2 * dist) : 0.f; P[r] = p; lsum += p; }
                }
#pragma unroll
                for (int s = 0; s < 2; ++s) {
                    v4u t; t.x = pk2(P[8 * s], P[8 * s + 1]); t.y = pk2(P[8 * s + 2], P[8 * s + 3]); t.z = pk2(P[8 * s + 4], P[8 * s + 5]); t.w = pk2(P[8 * s + 6], P[8 * s + 7]);
                    const bf16x8 pb = __builtin_bit_cast(bf16x8, t);
                    const int q = li >> 2, p = li & 3, row0 = 32 * kt + 16 * s + 4 * hh + q, row1 = row0 + 8;
#pragma unroll
                    for (int dt = 0; dt < 2; ++dt) { const int Gv = 4 * dt + 2 * (G4 & 1) + (p >> 1);
                        const v4i16_t lo = __builtin_amdgcn_ds_read_tr16_b64_v4i16((LAS v4i16_t*)(L + AVT + row0 * 128 + ((Gv ^ (((row0 >> 1) & 1) << 2)) << 4) + (p & 1) * 8));
                        const v4i16_t hi = __builtin_amdgcn_ds_read_tr16_b64_v4i16((LAS v4i16_t*)(L + AVT + row1 * 128 + ((Gv ^ (((row1 >> 1) & 1) << 2)) << 4) + (p & 1) * 8));
                        const bf16x8 vf = {lo[0], lo[1], lo[2], lo[3], hi[0], hi[1], hi[2], hi[3]};
                        if (dt == 0) O0 = __builtin_amdgcn_mfma_f32_32x32x16_bf16(vf, pb, O0, 0, 0, 0); else O1 = __builtin_amdgcn_mfma_f32_32x32x16_bf16(vf, pb, O1, 0, 0, 0); }
                }
            }
            lsum += __shfl_xor(lsum, 32);
            const float inv = 1.f / (lsum + sinkt);
            bf16* op = AO + tok * 1024 + head * 64 + 4 * hh;
#pragma unroll
            for (int rg = 0; rg < 4; ++rg) {
                u32x2_t a, c; a.x = pk2(O0[4 * rg] * inv, O0[4 * rg + 1] * inv); a.y = pk2(O0[4 * rg + 2] * inv, O0[4 * rg + 3] * inv);
                c.x = pk2(O1[4 * rg] * inv, O1[4 * rg + 1] * inv); c.y = pk2(O1[4 * rg + 2] * inv, O1[4 * rg + 3] * inv);
                *(GAS u32x2_t*)(op + 8 * rg) = a; *(GAS u32x2_t*)(op + 32 + 8 * rg) = c; }
        }
        __syncthreads();
    }
}
struct Args { const float* in[21]; float* out; unsigned char* ws; int mask, rep; };
__global__ void __launch_bounds__(NTHR, 2) mk_fwd(Args args) {
    extern __shared__ __attribute__((aligned(16))) unsigned char lds[];
    Ctx F;
    F.lds = (LAS unsigned char*)lds;
    F.MISC = (volatile LAS unsigned*)(F.lds + MISC_OFF);
    F.G = gridDim.x; { const int bx = blockIdx.x; const int vcu = (F.G % 8 == 0) ? (bx % 8) * (F.G / 8) + bx / 8 : bx; F.gwb = vcu * NWAVES; F.NGW = F.G * NWAVES; }
    F.wv = __builtin_amdgcn_readfirstlane((int)(threadIdx.x >> 6));
    F.ws = args.ws; F.out = args.out; F.ctl = (gu32*)(args.ws + WS_CTL);
#pragma unroll
    for (int i = 0; i < 21; ++i) F.in[i] = args.in[i];
    for (int u = threadIdx.x; u < (LDS_BYTES - LDSCTL_OFF) / 4; u += NTHR) ((LAS unsigned*)(F.lds + LDSCTL_OFF))[u] = 0u;
    __syncthreads();
    XcdBarrier bar = xcd_barrier_post((unsigned*)(F.ctl + CW_BAR), F.MISC + 8);
    const int mask = args.mask;
    const LAS int* tab = (const LAS int*)(F.lds + MOETAB_OFF);
    int redo = 0;
#pragma unroll 1
    for (int ph = 0; ph < 17; ++ph) {
        if (!((mask >> ph) & 1)) continue;
        const int layer = ph >= 13 ? 1 : 0;
        for (int rr = 0, nrep = (args.rep >> ph) & 1; rr <= nrep; ++rr) {
        if (rr) xcd_barrier(bar, F.wv == 0 && lane_id() == 0);
        int sel = ph >= 13 ? ph - 9 : (ph == 12 ? 3 : ph);
        asm volatile("" : "+s"(sel));
        switch (sel) {
        case 0: p0_prologue(F); break;
        case 1: {
            pg8::Gemm g{(const pg8::bf16_t*)(F.ws + WS_XN), (const pg8::bf16_t*)(F.ws + WS_WQKV), MT, 1536, MD}; pg8::StaticOrder S; S.init(MT, 1536, F.G, (int)blockIdx.x);
            pg8::EpiQKV E{(pg8::bf16_t*)(F.ws + WS_Q), (pg8::bf16_t*)(F.ws + WS_K), (pg8::bf16_t*)(F.ws + WS_V), F.in[4], F.in[5], QSCALE};
            pg8::gemm_phase<pg8::EpiQKV, pg8::StaticOrder, true, true>(F.lds + RING_OFF, g, S, E, F.wv * 64 + lane_id());
            if ((int)blockIdx.x >= 128 && F.G == 256) moe_convert(F, 0, ((int)blockIdx.x - 128) * NWAVES + F.wv, 128 * NWAVES, 2);
            else if (F.G != 256) moe_convert(F, 0, F.gwb + F.wv, F.NGW, 2);
        } break;
        case 2: attn_mfma(F); break;
        case 3: {
            pg8::Gemm g{(const pg8::bf16_t*)(F.ws + (ph == 3 ? WS_AO : WS_ON)), (const pg8::bf16_t*)(F.ws + (ph == 3 ? WS_WAO : WS_WGO)), MT, MD, MD}; pg8::StaticOrder S; S.init(MT, MD, F.G, (int)blockIdx.x);
            pg8::EpiResF32 E{ph == 3 ? F.in[0] : F.out, F.out, MD};
            pg8::gemm_phase<pg8::EpiResF32, pg8::StaticOrder, true, true>(F.lds + RING_OFF, g, S, E, F.wv * 64 + lane_id());
            if (ph != 3) moe_convert(F, 1, F.gwb + F.wv, F.NGW, 3);
        } break;
        case 4: p4_router(F, layer); break;
        case 5: {
            moe_tables(F, layer, 2);
            pg8::Gemm g{(const pg8::bf16_t*)(F.ws + WS_XN), (const pg8::bf16_t*)(F.ws + WS_WGU), MT, 512, MD};
            pg8::MoeOrder S{tab, 2, F.G, (int)blockIdx.x, (const int*)(F.ws + WS_LIST), (unsigned)(MD * 2)};
            pg8::EpiGateUp E{(pg8::bf16_t*)(F.ws + WS_H), (const float*)(F.ws + WS_GLIST), tab};
            pg8::gemm_phase<pg8::EpiGateUp, pg8::MoeOrder, true, true, true>(F.lds + RING_OFF, g, S, E, F.wv * 64 + lane_id());
        } break;
        case 6: {
            moe_tables(F, layer, 4);
            pg8::Gemm g{(const pg8::bf16_t*)(F.ws + WS_H), (const pg8::bf16_t*)(F.ws + WS_WD), 40960, 1024, 256};
            pg8::MoeOrder S{tab, 4, F.G, (int)blockIdx.x, (const int*)(F.ws + WS_LIST), 512u};
            pg8::EpiY E{(pg8::bf16_t*)(F.ws + WS_Y)};
            pg8::gemm_phase<pg8::EpiY, pg8::MoeOrder, true, true, false>(F.lds + RING_OFF, g, S, E, F.wv * 64 + lane_id());
        } break;
        case 7: moe_tables(F, layer, 4); if (layer == 0) p7_combine<true>(F); else p7_combine<false>(F); break;
        case 8: {
            pg8::Gemm g{(const pg8::bf16_t*)(F.ws + WS_XN), (const pg8::bf16_t*)(F.ws + WS_WGIN), MT, 4096, MD}; pg8::StaticOrder S; S.init(MT, 4096, F.G, (int)blockIdx.x);
            pg8::EpiGdnIn E{(pg8::bf16_t*)(F.ws + WS_QKVPRE), (pg8::bf16_t*)(F.ws + WS_Z), (pg8::bf16_t*)(F.ws + WS_HALO)};
            pg8::gemm_phase<pg8::EpiGdnIn, pg8::StaticOrder, true, true>(F.lds + RING_OFF, g, S, E, F.wv * 64 + lane_id());
        } break;
        case 9: gdn_prep(F); break;
        case 10: gdn_scan(F); if ((int)blockIdx.x >= 128) moe_convert(F, 1, ((int)blockIdx.x - 128) * NWAVES + F.wv, (F.G - 128) * NWAVES, 4); break;
        default: gdn_gate(F); break;
        }
        }
        if ((mask >> (ph + 1)) != 0) xcd_barrier(bar, F.wv == 0 && lane_id() == 0);
        if (ph == 9 && ((args.rep >> 20) & 1) && !redo) { redo = 1; ph = 7; }
    }
}

#ifndef REP_PROBE
#define REP_PROBE 0
#endif
extern "C" void kernel_launch(void* const* d_in, const int* in_sizes, int n_in, void* d_out, int out_size, void* d_ws, size_t ws_size, hipStream_t stream) {
    static int grid = 0;
    if (grid == 0) {
        int dev = 0, cus = 0;
        if (hipGetDevice(&dev) != hipSuccess || hipDeviceGetAttribute(&cus, hipDeviceAttributeMultiprocessorCount, dev) != hipSuccess) { fprintf(stderr, "kernel_launch: device query failed\n"); grid = -1; return; }
        if (hipFuncSetAttribute((const void*)mk_fwd, hipFuncAttributeMaxDynamicSharedMemorySize, LDS_BYTES) != hipSuccess) { fprintf(stderr, "kernel_launch: hipFuncSetAttribute failed\n"); grid = -1; return; }
        (void)hipGetLastError();
        grid = cus;
        if (ws_size < WS_END) { fprintf(stderr, "kernel_launch: workspace too small\n"); }
    }
    if (grid < 0) return;
    (void)hipMemsetAsync((char*)d_ws + WS_CTL, 0, CTL_ZERO_BYTES, stream);
    Args a{};
    for (int i = 0; i < 21; ++i) a.in[i] = (const float*)d_in[i];
    a.out = (float*)d_out; a.ws = (unsigned char*)d_ws; a.mask = 0x1ffff; a.rep = REP_PROBE;
    hipLaunchKernelGGL(mk_fwd, dim3(grid), dim3(NTHR), LDS_BYTES, stream, a);
}
```
